# Optimizing an MI355X kernel written in HIP

```python
import math
import jax
import jax.numpy as jnp
from jax import lax
import numpy as np

D_MODEL = 2048
BATCH = 2
SEQ = 4096
DEPTH = 4

CTX_LEN = 256
GRID_W = 64
EPS = 1e-6
N_DIR = 2

GLA_HEADS = 4
GLA_DK = 128
GLA_DV = 256
GLA_KEY = GLA_HEADS * GLA_DK
GLA_WIDTH = GLA_HEADS * GLA_DV
GLA_RANK = 16
GLA_TAU = 16.0
GLA_CHUNK = 64

S5_WIDTH = 512
S5_GROUP = 16
S5_GROUPS = S5_WIDTH // S5_GROUP
S5_STATE = 64

HY_WIDTH = 512
HY_ORDER = 2
HY_EMB = 33
HY_BANDS = (HY_EMB - 1) // 2
HY_FFN = 64
HY_SHORT = 3
HY_MIN_DECAY = math.log(1e-2) / 0.3
HY_MAX_DECAY = math.log(1e-2) / 1.5

MIX_WIDTH = GLA_WIDTH + S5_WIDTH + HY_WIDTH
IN_SPLITS = (GLA_KEY, GLA_KEY, GLA_WIDTH, N_DIR * GLA_RANK, S5_WIDTH,
             GLA_WIDTH, S5_WIDTH, 3 * HY_WIDTH, HY_WIDTH)
N_STATE_SPLITS = 5
IN_WIDTH = sum(IN_SPLITS)
STATE_WIDTH = sum(IN_SPLITS[:N_STATE_SPLITS])

kernel_name = "hybrid_gla_s5_hyena_prefix_trunk"


def rmsnorm(x, g):
    xf = x.astype(jnp.float32)
    y = xf * lax.rsqrt(jnp.mean(xf * xf, axis=-1, keepdims=True) + EPS)
    return (y * g.astype(jnp.float32)).astype(x.dtype)


def split_cols(p, sizes):
    idx = np.cumsum(sizes)[:-1].tolist()
    return jnp.split(p, idx, axis=-1)


def grid_transpose(h, a, b):
    return h.reshape(h.shape[0], a, b, h.shape[-1]).transpose(0, 2, 1, 3).reshape(h.shape)


def gla_chunked(q, k, v, g, s0, with_out):
    bn, L, H, dk = q.shape
    n = L // GLA_CHUNK
    C = GLA_CHUNK
    rs = lambda t: t.reshape(bn, n, C, H, t.shape[-1])
    q, k, v, g = rs(q), rs(k), rs(v), rs(g)
    G = jnp.cumsum(g, axis=2)
    G_last = G[:, :, -1:]
    dS = jnp.einsum('bnshk,bnshv->bnhkv', k * jnp.exp(G_last - G), v)
    a = jnp.exp(G_last[:, :, 0])

    def step(S, inp):
        a_n, dS_n = inp
        return a_n[..., None] * S + dS_n, (S if with_out else None)

    S_fin, S_prev = lax.scan(step, s0, (jnp.moveaxis(a, 1, 0), jnp.moveaxis(dS, 1, 0)))
    if not with_out:
        return None, S_fin
    S_prev = jnp.moveaxis(S_prev, 0, 1)
    qg = q * jnp.exp(G)
    att = jnp.einsum('bnthk,bnshk->bnhts', qg, k * jnp.exp(-G))
    att = jnp.where(jnp.tril(jnp.ones((C, C), dtype=bool)), att, 0.0)
    o = jnp.einsum('bnhts,bnshv->bnthv', att, v) + jnp.einsum('bnthk,bnhkv->bnthv', qg, S_prev)
    return o.reshape(bn, L, H, v.shape[-1]), S_fin


def gla_branch(pc, pl, w_gate, b_gate, norm_g, ctx_out):
    f32 = jnp.float32

    def prep(q, k, v, lr):
        bn, L, _ = q.shape
        qh = q.astype(f32).reshape(bn, L, GLA_HEADS, GLA_DK) * (GLA_DK ** -0.5)
        kh = k.astype(f32).reshape(bn, L, GLA_HEADS, GLA_DK)
        vh = v.astype(f32).reshape(bn, L, GLA_HEADS, GLA_DV)
        lr = lr.astype(f32).reshape(bn, L, N_DIR, GLA_RANK)
        z = jnp.einsum('bldr,drk->bldk', lr, w_gate.astype(f32)) + b_gate.astype(f32)
        glog = (jax.nn.log_sigmoid(z) / GLA_TAU).reshape(bn, L, N_DIR, GLA_HEADS, GLA_DK)
        return qh, kh, vh, glog

    flip = lambda t: jnp.flip(t, axis=1)
    qc, kc, vc, gc = prep(*pc)
    ql, kl, vl, gl = prep(*pl)
    zero = jnp.zeros((qc.shape[0], GLA_HEADS, GLA_DK, GLA_DV), f32)
    oc_f, s_f = gla_chunked(qc, kc, vc, gc[:, :, 0], zero, ctx_out)
    oc_b, s_b = gla_chunked(flip(qc), flip(kc), flip(vc), flip(gc[:, :, 1]), zero, ctx_out)
    ol_f, _ = gla_chunked(ql, kl, vl, gl[:, :, 0], s_f, True)
    ol_b, _ = gla_chunked(flip(ql), flip(kl), flip(vl), flip(gl[:, :, 1]), s_b, True)
    yl = ol_f + flip(ol_b) - jnp.sum(ql * kl, -1, keepdims=True) * vl
    out_l = rmsnorm(yl, norm_g).reshape(yl.shape[0], yl.shape[1], GLA_WIDTH)
    if not ctx_out:
        return out_l, None
    yc = oc_f + flip(oc_b) - jnp.sum(qc * kc, -1, keepdims=True) * vc
    out_c = rmsnorm(yc, norm_g).reshape(yc.shape[0], yc.shape[1], GLA_WIDTH)
    return out_l, out_c


def _lin_op(e1, e2):
    a1, b1 = e1
    a2, b2 = e2
    return a1 * a2, a2 * b1 + b2


def s5_scan(bu, lam_bar, s0, reverse):
    if s0 is not None:
        bu = bu.at[:, -1 if reverse else 0].add(lam_bar * s0)
    a = jnp.broadcast_to(lam_bar, bu.shape)
    _, xs = lax.associative_scan(_lin_op, (a, bu), reverse=reverse, axis=1)
    return xs


def s5_branch(uc, ul, lam_re, lam_im, log_step, b_re, b_im, c_re, c_im, d_skip, w_glu, b_glu, ctx_out):
    f32 = jnp.float32
    lam = lax.complex(lam_re.astype(f32), lam_im.astype(f32))
    lam_bar = jnp.exp(lam * jnp.exp(log_step.astype(f32))[..., None])
    b_bar = ((lam_bar - 1.0) / lam)[..., None] * lax.complex(b_re.astype(f32), b_im.astype(f32))
    cmat = lax.complex(c_re.astype(f32), c_im.astype(f32))
    d = d_skip.astype(f32)
    wg = w_glu.astype(f32)
    bg = b_glu.astype(f32)

    def grouped(u):
        u = u.astype(f32)
        return u, u.reshape(u.shape[0], u.shape[1], S5_GROUPS, S5_GROUP)

    def readout(xs, cm):
        y = jnp.einsum('blgp,ghp->blgh', xs, cm).real
        return y.reshape(y.shape[0], y.shape[1], S5_WIDTH)

    def glu(y):
        yg = jax.nn.gelu(y)
        return yg * jax.nn.sigmoid(yg @ wg + bg)

    uc, ucg = grouped(uc)
    ul, ulg = grouped(ul)
    yl = d * ul
    yc = d * uc if ctx_out else None
    for di, rev in enumerate((False, True)):
        xs_c = s5_scan(jnp.einsum('blgh,gph->blgp', ucg, b_bar[di]), lam_bar[di], None, rev)
        s_c = xs_c[:, 0] if rev else xs_c[:, -1]
        xs_l = s5_scan(jnp.einsum('blgh,gph->blgp', ulg, b_bar[di]), lam_bar[di], s_c, rev)
        yl = yl + readout(xs_l, cmat[di])
        if ctx_out:
            yc = yc + readout(xs_c, cmat[di])
    return glu(yl), (glu(yc) if ctx_out else None)


def hyena_spectra(L, w1, b1, f1, w2, b2, f2, w3):
    f32 = jnp.float32
    t = jnp.linspace(0.0, 1.0, L, dtype=f32)[:, None]
    ang = (2.0 * math.pi / L) * jnp.arange(L, dtype=f32)[:, None]
    bands = jnp.linspace(1e-4, HY_BANDS - 1, HY_BANDS, dtype=f32)[None, :]
    feats = jnp.concatenate([t, jnp.cos(bands * ang), -jnp.sin(bands * ang)], axis=-1)
    h = jnp.sin(f1.astype(f32) * (feats @ w1.astype(f32) + b1.astype(f32)))
    h = jnp.sin(f2.astype(f32) * (h @ w2.astype(f32) + b2.astype(f32)))
    h = (h @ w3.astype(f32)).reshape(L, HY_ORDER, N_DIR, HY_WIDTH)
    deltas = jnp.abs(jnp.linspace(HY_MIN_DECAY, HY_MAX_DECAY, HY_WIDTH, dtype=f32))
    h = h * jnp.exp(-t * deltas)[:, None, None, :]
    h_fwd, h_bwd = h[:, :, 0], h[:, :, 1]
    taps = jnp.concatenate([h_fwd, jnp.zeros_like(h_fwd[:1]), h_bwd[:0:-1]], axis=0)
    return jnp.fft.rfft(taps, axis=0)


def short_conv(x, w, b):
    pad = HY_SHORT // 2
    L = x.shape[1]
    xp = jnp.pad(x, ((0, 0), (pad, pad), (0, 0)))
    return sum(xp[:, j:j + L] * w[j] for j in range(HY_SHORT)) + b


def long_conv(u, spec, d):
    L = u.shape[1]
    U = jnp.fft.rfft(u, n=2 * L, axis=1)
    y = jnp.fft.irfft(U * spec[None], n=2 * L, axis=1)[:, :L]
    return y + d * u


def hyena_seq(p, conv_w, conv_b, spec, hy_d):
    f32 = jnp.float32
    s = short_conv(p.astype(f32), conv_w.astype(f32), conv_b.astype(f32))
    v, x1, x2 = jnp.split(s, 3, axis=-1)
    d = hy_d.astype(f32)
    z = x1 * long_conv(v, spec[:, 0], d[0])
    return x2 * long_conv(z, spec[:, 1], d[1])


def setup_inputs(seed: int = 0) -> dict:
    key = jax.random.key(seed)
    ks = iter(jax.random.split(key, 40))
    f32 = jnp.float32
    nrm = lambda shape, s: s * jax.random.normal(next(ks), shape, f32)
    x = nrm((BATCH, SEQ, D_MODEL), 1.0)
    c = nrm((BATCH, D_MODEL), 1.0)
    ctx = nrm((BATCH, CTX_LEN, D_MODEL), 1.0)
    c_ctx = nrm((D_MODEL,), 1.0)
    w_mod = nrm((DEPTH, D_MODEL, 3 * D_MODEL), 0.5 * D_MODEL ** -0.5)
    b_mod = nrm((DEPTH, 3 * D_MODEL), 0.01)
    g_pre = 1.0 + nrm((DEPTH, D_MODEL), 0.01)
    g_post = 1.0 + nrm((DEPTH, D_MODEL), 0.01)
    w_in = nrm((DEPTH, D_MODEL, IN_WIDTH), D_MODEL ** -0.5)
    w_out = nrm((DEPTH, MIX_WIDTH, D_MODEL), MIX_WIDTH ** -0.5)
    gla_w_gate = nrm((DEPTH, N_DIR, GLA_RANK, GLA_KEY), GLA_RANK ** -0.5)
    gla_b_gate = nrm((DEPTH, N_DIR, GLA_KEY), 0.1)
    gla_norm = 1.0 + nrm((DEPTH, GLA_DV), 0.01)
    s5_lam_re = -0.5 + nrm((DEPTH, N_DIR, S5_GROUPS, S5_STATE), 0.01)
    s5_lam_im = math.pi * jnp.arange(S5_STATE, dtype=f32) + nrm((DEPTH, N_DIR, S5_GROUPS, S5_STATE), 0.01)
    s5_log_step = jax.random.uniform(next(ks), (DEPTH, N_DIR, S5_GROUPS), f32, math.log(1e-3), math.log(1e-1))
    s5_b_re = nrm((DEPTH, N_DIR, S5_GROUPS, S5_STATE, S5_GROUP), (2 * S5_GROUP) ** -0.5)
    s5_b_im = nrm((DEPTH, N_DIR, S5_GROUPS, S5_STATE, S5_GROUP), (2 * S5_GROUP) ** -0.5)
    s5_c_re = nrm((DEPTH, N_DIR, S5_GROUPS, S5_GROUP, S5_STATE), S5_STATE ** -0.5)
    s5_c_im = nrm((DEPTH, N_DIR, S5_GROUPS, S5_GROUP, S5_STATE), S5_STATE ** -0.5)
    s5_d = nrm((DEPTH, S5_WIDTH), 1.0)
    s5_w_glu = nrm((DEPTH, S5_WIDTH, S5_WIDTH), S5_WIDTH ** -0.5)
    s5_b_glu = nrm((DEPTH, S5_WIDTH), 0.01)
    hy_conv_w = nrm((DEPTH, HY_SHORT, 3 * HY_WIDTH), HY_SHORT ** -0.5)
    hy_conv_b = nrm((DEPTH, 3 * HY_WIDTH), 0.01)
    hy_w1 = nrm((DEPTH, HY_EMB, HY_FFN), HY_EMB ** -0.5)
    hy_b1 = nrm((DEPTH, HY_FFN), 0.01)
    hy_f1 = 1.0 + nrm((DEPTH, HY_FFN), 0.01)
    hy_w2 = nrm((DEPTH, HY_FFN, HY_FFN), HY_FFN ** -0.5)
    hy_b2 = nrm((DEPTH, HY_FFN), 0.01)
    hy_f2 = 1.0 + nrm((DEPTH, HY_FFN), 0.01)
    hy_w3 = nrm((DEPTH, HY_FFN, HY_ORDER * N_DIR * HY_WIDTH), 0.02)
    hy_d = nrm((DEPTH, HY_ORDER, HY_WIDTH), 1.0)
    return {"x": x, "c": c, "ctx": ctx, "c_ctx": c_ctx, "w_mod": w_mod, "b_mod": b_mod,
            "g_pre": g_pre, "g_post": g_post, "w_in": w_in, "w_out": w_out,
            "gla_w_gate": gla_w_gate, "gla_b_gate": gla_b_gate, "gla_norm": gla_norm,
            "s5_lam_re": s5_lam_re, "s5_lam_im": s5_lam_im, "s5_log_step": s5_log_step,
            "s5_b_re": s5_b_re, "s5_b_im": s5_b_im, "s5_c_re": s5_c_re, "s5_c_im": s5_c_im,
            "s5_d": s5_d, "s5_w_glu": s5_w_glu, "s5_b_glu": s5_b_glu,
            "hy_conv_w": hy_conv_w, "hy_conv_b": hy_conv_b, "hy_w1": hy_w1, "hy_b1": hy_b1,
            "hy_f1": hy_f1, "hy_w2": hy_w2, "hy_b2": hy_b2, "hy_f2": hy_f2, "hy_w3": hy_w3,
            "hy_d": hy_d}


def reference(x, c, ctx, c_ctx, w_mod, b_mod, g_pre, g_post, w_in, w_out,
              gla_w_gate, gla_b_gate, gla_norm,
              s5_lam_re, s5_lam_im, s5_log_step, s5_b_re, s5_b_im, s5_c_re, s5_c_im,
              s5_d, s5_w_glu, s5_b_glu,
              hy_conv_w, hy_conv_b, hy_w1, hy_b1, hy_f1, hy_w2, hy_b2, hy_f2, hy_w3, hy_d):
    f32 = jnp.float32
    L = x.shape[1]
    Lc = ctx.shape[1]
    rows = L // GRID_W
    silu_c = jax.nn.silu(c)
    silu_cc = jax.nn.silu(c_ctx)
    xc = ctx
    for l in range(DEPTH):
        last = l == DEPTH - 1
        ctx_out = not last
        col_major = l % 2 == 1
        shift, scale, gate = jnp.split(silu_c @ w_mod[l] + b_mod[l], 3, axis=-1)
        h = rmsnorm(x, g_pre[l]) * (1 + scale[:, None]) + shift[:, None]
        if col_major:
            h = grid_transpose(h, rows, GRID_W)
        cshift, cscale, cgate = jnp.split(silu_cc @ w_mod[l] + b_mod[l], 3, axis=-1)
        hc = rmsnorm(xc, g_pre[l]) * (1 + cscale) + cshift
        lat = split_cols(h @ w_in[l], IN_SPLITS)
        if last:
            cp = split_cols(hc @ w_in[l][:, :STATE_WIDTH], IN_SPLITS[:N_STATE_SPLITS])
        else:
            cp = split_cols(hc @ w_in[l], IN_SPLITS)
        gla_l, gla_c = gla_branch(cp[:4], lat[:4], gla_w_gate[l], gla_b_gate[l], gla_norm[l], ctx_out)
        s5_l, s5_c = s5_branch(cp[4], lat[4], s5_lam_re[l], s5_lam_im[l], s5_log_step[l],
                               s5_b_re[l], s5_b_im[l], s5_c_re[l], s5_c_im[l],
                               s5_d[l], s5_w_glu[l], s5_b_glu[l], ctx_out)
        hyp = (hy_w1[l], hy_b1[l], hy_f1[l], hy_w2[l], hy_b2[l], hy_f2[l], hy_w3[l])
        hy_l = hyena_seq(lat[7], hy_conv_w[l], hy_conv_b[l], hyena_spectra(L, *hyp), hy_d[l])
        sg = lambda t: jax.nn.silu(t.astype(f32))
        y = jnp.concatenate([gla_l * sg(lat[5]), s5_l * sg(lat[6]), hy_l * sg(lat[8])], axis=-1).astype(x.dtype)
        if col_major:
            y = grid_transpose(y, GRID_W, rows)
        x_new = x + gate[:, None] * rmsnorm(y @ w_out[l], g_post[l])
        if ctx_out:
            hy_c = hyena_seq(cp[7], hy_conv_w[l], hy_conv_b[l], hyena_spectra(Lc, *hyp), hy_d[l])
            yc = jnp.concatenate([gla_c * sg(cp[5]), s5_c * sg(cp[6]), hy_c * sg(cp[8])], axis=-1).astype(xc.dtype)
            xc = xc + cgate * rmsnorm(yc @ w_out[l], g_post[l])
        x = x_new
    return x
```

```cpp
#include <hip/hip_runtime.h>
#include <hip/hip_cooperative_groups.h>
#include <cstdio>
#include <cstdint>
#include <cmath>
namespace pg8 {
#define PG8_LAS __attribute__((address_space(3)))
typedef unsigned short bf16_t;
typedef short bf16x8 __attribute__((ext_vector_type(8)));
typedef float f32x4 __attribute__((ext_vector_type(4)));
typedef unsigned u32x4 __attribute__((ext_vector_type(4)));
constexpr int BM = 256, BK = 64, HALF = 128, HTB = HALF * BK * 2  , STAGE_BYTES = 8 * HTB, NXCD = 8, WGM = 8;

__host__ __device__ __forceinline__ int lds_byte(int r, int c) { const int st = (r >> 4) * 2 + (c >> 5), rr = r & 15, cc = c & 31, ob = rr * 64 + cc * 2; return st * 1024 + (ob ^ (((ob >> 9) & 1) << 5)); }
__host__ __device__ __forceinline__ void stage_rc(int b, int& R, int& C) { const int st = b / 1024, sb = b % 1024, swz = sb ^ (((sb >> 9) & 1) << 5); R = (st >> 1) * 16 + swz / 64; C = (st & 1) * 32 + (swz % 64) / 2; }
__host__ __device__ __forceinline__ int perm32(int rho) { const int n = rho >> 4, i = rho & 15; return 8 * (i >> 2) + 4 * n + (i & 3); }

struct Unit { int pm, pn; };
struct Gemm { const bf16_t* A; const bf16_t* Bt; int M, N, K; };

struct StaticOrder {
    int nM, nN, nwg, G, c;
    __host__ __device__ void init(int M, int N, int G_, int c_) { nM = M / BM; nN = N / BM; nwg = nM * nN; G = G_; c = c_; }
    __host__ __device__ bool next(int i, Unit& u) const {
        const long L = (long)i * G + c; if (L >= nwg) return false;
        int wgid = (int)L; { const int q = nwg / NXCD, r = nwg % NXCD, xcd = wgid % NXCD, off = wgid / NXCD; wgid = (xcd < r ? xcd * (q + 1) : r * (q + 1) + (xcd - r) * q) + off; }
        const int nig = WGM * nN, gid = wgid / nig, fm = gid * WGM, gsz = (nM - fm) < WGM ? (nM - fm) : WGM;
        u.pm = fm + ((wgid % nig) % gsz); u.pn = (wgid % nig) / gsz; return true;
    }
    __device__ __forceinline__ void a_ready(const Unit&) const {}
    __device__ __forceinline__ void done(const Unit&) const {}
};


__device__ __forceinline__ unsigned cvt_pk_bf16(float lo, float hi) { unsigned r; asm volatile("v_cvt_pk_bf16_f32 %0, %1, %2" : "=v"(r) : "v"(lo), "v"(hi)); return r; }
__device__ __forceinline__ float bf2f(unsigned short h) { return __builtin_bit_cast(float, (unsigned)h << 16); }

struct EpiF32 {
    static constexpr bool PERM = false, AFTER_DRAIN = false;
    float* O; int ldc;
    __device__ __forceinline__ void operator()(const f32x4 (&acc)[2][2][4][2], const Unit& u, int wr, int wc, int fr, int fq) const {
        const int row0 = u.pm * BM + wr * 64 + fr, col0 = u.pn * BM + wc * 32 + 4 * fq;
#pragma unroll
        for (int ai = 0; ai < 2; ++ai)
#pragma unroll
            for (int m = 0; m < 4; ++m) { float* rowp = O + (size_t)(row0 + ai * HALF + m * 16) * ldc + col0;
#pragma unroll
                for (int bj = 0; bj < 2; ++bj)
#pragma unroll
                    for (int n = 0; n < 2; ++n) *(f32x4*)(rowp + bj * HALF + n * 16) = acc[ai][bj][m][n]; }
    }
};
struct EpiGlu {
    static constexpr bool PERM = false, AFTER_DRAIN = false;
    const bf16_t* YG; const float* Psg; int ldp; const float* bg; bf16_t* Y; int ldy;
    __device__ __forceinline__ void operator()(const f32x4 (&acc)[2][2][4][2], const Unit& u, int wr, int wc, int fr, int fq) const {
        const int row0 = u.pm * BM + wr * 64 + fr, col0 = u.pn * BM + wc * 32 + 4 * fq;
#pragma unroll
        for (int ai = 0; ai < 2; ++ai)
#pragma unroll
            for (int m = 0; m < 4; ++m) { const size_t row = (size_t)(row0 + ai * HALF + m * 16);
#pragma unroll
                for (int bj = 0; bj < 2; ++bj)
#pragma unroll
                    for (int n = 0; n < 2; ++n) { const int col = col0 + bj * HALF + n * 16;
                        const f32x4 a = acc[ai][bj][m][n]; const f32x4 b = *(const f32x4*)(bg + col); const f32x4 sg = *(const f32x4*)(Psg + row * ldp + col);
                        const uint2 y2 = *(const uint2*)(YG + row * 512 + col);
                        float yv[4] = {bf2f((unsigned short)(y2.x & 0xffff)), bf2f((unsigned short)(y2.x >> 16)), bf2f((unsigned short)(y2.y & 0xffff)), bf2f((unsigned short)(y2.y >> 16))};
                        float o[4];
#pragma unroll
                        for (int e = 0; e < 4; ++e) { const float z = a[e] + b[e]; const float s = 1.f / (1.f + __expf(-z)); const float g = sg[e]; const float sl = g / (1.f + __expf(-g)); o[e] = yv[e] * s * sl; }
                        uint2 w; w.x = cvt_pk_bf16(o[0], o[1]); w.y = cvt_pk_bf16(o[2], o[3]);
                        *(uint2*)(Y + row * ldy + col) = w; } }
    }
};
template <class Epi, class Sched, bool ALIGN_EPI = false, bool SP2 = false>
__device__ __forceinline__ void gemm_phase(PG8_LAS unsigned char* lds, const Gemm g, const Sched& S, const Epi& E) {
    const int tid = threadIdx.x, wid = __builtin_amdgcn_readfirstlane(tid >> 6), lane = tid & 63, wr = wid >> 2, wc = wid & 3, fr = lane & 15, fq = lane >> 4;
    const int K = g.K, nt = K / BK;
    unsigned voffA[2], voffB[2];
#pragma unroll
    for (int i = 0; i < 2; ++i) { int R, C; stage_rc(tid * 16 + i * 8192, R, C); const int Rb = Epi::PERM ? ((R & ~31) + perm32(R & 31)) : R;
        voffA[i] = (unsigned)(R * K + C) * 2u; voffB[i] = (unsigned)(Rb * K + C) * 2u; }
    const size_t kstep = (size_t)(BK * 2);
    const size_t hstep = (size_t)HALF * K * 2;
    const size_t tstep = 2 * hstep;
    const unsigned ldsw = (unsigned)wid * 1024u;
    const int aoff = lds_byte(wr * 64 + fr, fq * 8), boff = lds_byte(wc * 32 + fr, fq * 8);
#define PG8_SA(b, h) (((b) * 2 + (h)) * HTB)
#define PG8_SB(b, h) ((4 + (b) * 2 + (h)) * HTB)
#define PG8_STAGE(bufoff, gbase, voff) do { _Pragma("unroll") for (int _i = 0; _i < 2; ++_i) \
        __builtin_amdgcn_global_load_lds((const unsigned*)((const char*)(gbase) + (voff)[_i]), (PG8_LAS unsigned*)(lds + (bufoff) + ldsw + _i * 8192), 16, 0, 0); } while (0)
#define PG8_LDA(dst, b, h) do { _Pragma("unroll") for (int m = 0; m < 4; ++m) _Pragma("unroll") for (int k = 0; k < 2; ++k) dst[m][k] = *(const PG8_LAS bf16x8*)(lds + PG8_SA(b, h) + aoff + m * 2048 + k * 1024); } while (0)
#define PG8_LDB(dst, b, h) do { _Pragma("unroll") for (int n = 0; n < 2; ++n) _Pragma("unroll") for (int k = 0; k < 2; ++k) dst[n][k] = *(const PG8_LAS bf16x8*)(lds + PG8_SB(b, h) + boff + n * 2048 + k * 1024); } while (0)
#define PG8_MMA(ai, bj, At, Bt) do { __builtin_amdgcn_s_setprio(1); _Pragma("unroll") for (int m = 0; m < 4; ++m) _Pragma("unroll") for (int n = 0; n < 2; ++n) _Pragma("unroll") for (int k = 0; k < 2; ++k) \
        acc[ai][bj][m][n] = __builtin_amdgcn_mfma_f32_16x16x32_bf16(Bt[n][k], At[m][k], acc[ai][bj][m][n], 0, 0, 0); __builtin_amdgcn_s_setprio(0); } while (0)
#define PG8_WAIT_V(n) asm volatile("s_waitcnt vmcnt(" #n ")" ::: "memory")
#define PG8_WAIT_L(n) asm volatile("s_waitcnt lgkmcnt(" #n ")" ::: "memory")
#define PG8_BAR __builtin_amdgcn_s_barrier()
#define PG8_SCHED __builtin_amdgcn_sched_barrier(0)
    Unit cur, nxt; int ui = 0;
    if (!S.next(0, cur)) return;
    f32x4 acc[2][2][4][2];
#pragma unroll
    for (int a = 0; a < 2; ++a)
#pragma unroll
        for (int b = 0; b < 2; ++b)
#pragma unroll
            for (int m = 0; m < 4; ++m)
#pragma unroll
                for (int n = 0; n < 2; ++n) acc[a][b][m][n] = (f32x4){0.f, 0.f, 0.f, 0.f};
    bf16x8 At[4][2], B0[2][2], B1[2][2];
    const char* cA = (const char*)g.A + (size_t)cur.pm * tstep; const char* cB = (const char*)g.Bt + (size_t)cur.pn * tstep;
    S.a_ready(cur);
    if constexpr (SP2) {
        PG8_STAGE(PG8_SB(0, 0), cB, voffB); PG8_STAGE(PG8_SB(0, 1), cB + hstep, voffB); PG8_STAGE(PG8_SA(0, 0), cA, voffA); PG8_STAGE(PG8_SA(0, 1), cA + hstep, voffA);
        if (wr == 1) PG8_BAR;
        PG8_WAIT_V(2); PG8_BAR;
        PG8_STAGE(PG8_SB(1, 0), cB + kstep, voffB); PG8_STAGE(PG8_SA(1, 0), cA + kstep, voffA); PG8_STAGE(PG8_SB(1, 1), cB + hstep + kstep, voffB);
        PG8_WAIT_V(6); PG8_BAR;
    } else {
        PG8_STAGE(PG8_SB(0, 0), cB, voffB); PG8_STAGE(PG8_SA(0, 0), cA, voffA); PG8_STAGE(PG8_SB(0, 1), cB + hstep, voffB); PG8_STAGE(PG8_SA(0, 1), cA + hstep, voffA);
        if (wr == 1) PG8_BAR;
        PG8_WAIT_V(4); PG8_BAR;
        PG8_STAGE(PG8_SB(1, 0), cB + kstep, voffB); PG8_STAGE(PG8_SA(1, 0), cA + kstep, voffA); PG8_STAGE(PG8_SB(1, 1), cB + hstep + kstep, voffB);
        PG8_WAIT_V(6); PG8_BAR;
    }
    for (;;) {
        const bool has_next = S.next(ui + 1, nxt);
        const char* nA = has_next ? (const char*)g.A + (size_t)nxt.pm * tstep : cA; const char* nB = has_next ? (const char*)g.Bt + (size_t)nxt.pn * tstep : cB;
        for (int t = 0; t < nt; t += 2) {
            const bool last = (t == nt - 2);
            const char* a1 = cA + (size_t)(t + 1) * kstep;
            const char* a2 = last ? nA : cA + (size_t)(t + 2) * kstep; const char* b2 = last ? nB : cB + (size_t)(t + 2) * kstep;
            const char* a3 = a2 + kstep; const char* b3 = b2 + kstep;
            if (last && has_next) S.a_ready(nxt);
            if constexpr (SP2) {
            PG8_LDB(B0, 0, 0); PG8_LDB(B1, 0, 1); PG8_SCHED; PG8_LDA(At, 0, 0); PG8_STAGE(PG8_SA(1, 1), a1 + hstep, voffA);
            PG8_WAIT_V(8); PG8_WAIT_L(0); PG8_BAR; PG8_MMA(0, 0, At, B0); PG8_MMA(0, 1, At, B1); PG8_BAR; PG8_SCHED;
            PG8_LDA(At, 0, 1); PG8_STAGE(PG8_SB(0, 0), b2, voffB); PG8_STAGE(PG8_SB(0, 1), b2 + hstep, voffB); PG8_STAGE(PG8_SA(0, 0), a2, voffA);
            PG8_WAIT_V(8); PG8_WAIT_L(0); PG8_BAR; PG8_MMA(1, 0, At, B0); PG8_MMA(1, 1, At, B1); PG8_BAR; PG8_SCHED;
            PG8_LDB(B0, 1, 0); PG8_LDB(B1, 1, 1); PG8_SCHED; PG8_LDA(At, 1, 0); PG8_STAGE(PG8_SA(0, 1), a2 + hstep, voffA);
            PG8_WAIT_V(8); PG8_WAIT_L(0); PG8_BAR; PG8_MMA(0, 0, At, B0); PG8_MMA(0, 1, At, B1); PG8_BAR; PG8_SCHED;
            PG8_LDA(At, 1, 1); PG8_STAGE(PG8_SB(1, 0), b3, voffB); PG8_STAGE(PG8_SB(1, 1), b3 + hstep, voffB); PG8_STAGE(PG8_SA(1, 0), a3, voffA);
            PG8_WAIT_V(8); PG8_WAIT_L(0); PG8_BAR; PG8_MMA(1, 0, At, B0); PG8_MMA(1, 1, At, B1); PG8_BAR; PG8_SCHED;
            } else {
            PG8_LDB(B0, 0, 0); PG8_SCHED; PG8_LDA(At, 0, 0); PG8_STAGE(PG8_SA(1, 1), a1 + hstep, voffA);
            PG8_WAIT_L(8); PG8_BAR; PG8_WAIT_L(0); PG8_MMA(0, 0, At, B0); PG8_BAR; PG8_SCHED;
            PG8_LDB(B1, 0, 1); PG8_STAGE(PG8_SB(0, 0), b2, voffB);
            PG8_BAR; PG8_WAIT_L(0); PG8_MMA(0, 1, At, B1); PG8_BAR;
            PG8_LDA(At, 0, 1); PG8_STAGE(PG8_SA(0, 0), a2, voffA);
            PG8_BAR; PG8_WAIT_L(0); PG8_MMA(1, 0, At, B0); PG8_BAR; PG8_SCHED;
            PG8_STAGE(PG8_SB(0, 1), b2 + hstep, voffB);
            PG8_WAIT_V(6); PG8_BAR; PG8_MMA(1, 1, At, B1); PG8_BAR;
            PG8_LDB(B0, 1, 0); PG8_SCHED; PG8_LDA(At, 1, 0); PG8_STAGE(PG8_SA(0, 1), a2 + hstep, voffA);
            PG8_WAIT_L(8); PG8_BAR; PG8_WAIT_L(0); PG8_MMA(0, 0, At, B0); PG8_BAR; PG8_SCHED;
            PG8_LDB(B1, 1, 1); PG8_STAGE(PG8_SB(1, 0), b3, voffB);
            PG8_BAR; PG8_WAIT_L(0); PG8_MMA(0, 1, At, B1); PG8_BAR;
            PG8_LDA(At, 1, 1); PG8_STAGE(PG8_SA(1, 0), a3, voffA);
            PG8_BAR; PG8_WAIT_L(0); PG8_MMA(1, 0, At, B0); PG8_BAR; PG8_SCHED;
            PG8_STAGE(PG8_SB(1, 1), b3 + hstep, voffB);
            PG8_WAIT_V(6); PG8_BAR; PG8_MMA(1, 1, At, B1); PG8_BAR;
            }
        }
        if constexpr (ALIGN_EPI) { if (wr == 0) PG8_BAR; }
        if constexpr (!Epi::AFTER_DRAIN) { E(acc, cur, wr, wc, fr, fq); S.done(cur); }
        if (!has_next) break;
#pragma unroll
        for (int a = 0; a < 2; ++a)
#pragma unroll
            for (int b = 0; b < 2; ++b)
#pragma unroll
                for (int m = 0; m < 4; ++m)
#pragma unroll
                    for (int n = 0; n < 2; ++n) acc[a][b][m][n] = (f32x4){0.f, 0.f, 0.f, 0.f};
        cur = nxt; cA = nA; cB = nB; ++ui;
        if constexpr (ALIGN_EPI) { if (wr == 1) PG8_BAR; }
    }
    PG8_WAIT_V(0);
    if constexpr (!ALIGN_EPI) { if (wr == 0) PG8_BAR; }
    PG8_BAR;
    if constexpr (Epi::AFTER_DRAIN) { E.fused(acc, cur, wr, wc, fr, fq, lds, wid, lane); S.done(cur); }
#undef PG8_SA
#undef PG8_SB
#undef PG8_STAGE
#undef PG8_LDA
#undef PG8_LDB
#undef PG8_MMA
#undef PG8_WAIT_V
#undef PG8_WAIT_L
#undef PG8_BAR
#undef PG8_SCHED
}
}

using pg8::bf16_t; using pg8::f32x4;
#define LAS __attribute__((address_space(3)))
constexpr int DM = 2048, NB = 2, SEQ = 4096, LCX = 256, DEPTH = 4;
constexpr int NLAT = NB * SEQ;
constexpr int MROWS = NLAT + NB * LCX;
constexpr int NIN = 6176, NINP = 6400;
constexpr int PQ = 0, PK = 512, PV = 1024, PU = 2048, PGG = 2560, PSG = 3584, PHV = 4096, PHG = 5632, PLR = 6144;
constexpr float EPS = 1e-6f;
constexpr int NT = 512;

__host__ __device__ __forceinline__ int in_col_map(int n) {
    if (n < 2048) return n;
    if (n < 6144) return n + 32;
    if (n < 6176) return n - 4096;
    return -1;
}

constexpr size_t al256(size_t x) { return (x + 255) & ~(size_t)255; }
constexpr size_t WS_WIN  = 0;
constexpr size_t WS_WOUT = WS_WIN  + al256((size_t)DEPTH * NINP * DM * 2);
constexpr size_t WS_WGLU = WS_WOUT + al256((size_t)DEPTH * DM * DM * 2);
constexpr size_t WS_MOD  = WS_WGLU + al256((size_t)DEPTH * 512 * 512 * 2);
constexpr size_t WS_H    = WS_MOD  + al256((size_t)DEPTH * 3 * 6144 * 4);
constexpr size_t WS_YCAT = WS_H    + al256((size_t)MROWS * DM * 2);
constexpr size_t WS_P    = WS_YCAT + al256((size_t)MROWS * DM * 2);
constexpr size_t WS_XC   = WS_P    + al256((size_t)MROWS * NINP * 4);
constexpr size_t WS_OG   = WS_XC   + al256((size_t)NB * LCX * DM * 4);
constexpr size_t WS_YS5  = WS_OG   + al256((size_t)2 * MROWS * 1024 * 4);
constexpr size_t WS_YG   = WS_YS5  + al256((size_t)2 * MROWS * 512 * 4);
constexpr size_t WS_HT   = WS_YG   + al256((size_t)MROWS * 512 * 2);
constexpr size_t WS_TP   = WS_HT   + al256((size_t)MROWS * 2048 * 4);
constexpr size_t WS_END  = WS_TP   + al256((size_t)2 * 512 * 2 * SEQ * 4) + al256((size_t)2 * 512 * 2 * LCX * 4);

struct Params {
    const float* in[33];
    float* out;
    unsigned char* ws;
};
enum { I_X = 0, I_C, I_CTX, I_CCTX, I_WMOD, I_BMOD, I_GPRE, I_GPOST, I_WIN, I_WOUT, I_GWG, I_GBG, I_GNORM,
       I_LRE, I_LIM, I_LSTEP, I_BRE, I_BIM, I_CRE, I_CIM, I_S5D, I_WGLU, I_BGLU, I_HCW, I_HCB, I_HW1, I_HB1, I_HF1, I_HW2, I_HB2, I_HF2, I_HW3, I_HD };

__device__ __forceinline__ float wave_sum(float v) {
#pragma unroll
    for (int o = 1; o < 64; o <<= 1) v += __shfl_xor(v, o);
    return v;
}
__device__ __forceinline__ float silu_f(float x) { return x / (1.f + expf(-x)); }
__device__ __forceinline__ float gelu_tanh(float x) { const float u = 0.7978845608028654f * (x + 0.044715f * x * x * x); return 0.5f * x * (1.f + tanhf(u)); }
__device__ __forceinline__ unsigned pk2(float lo, float hi) { return pg8::cvt_pk_bf16(lo, hi); }
__device__ __forceinline__ int permtok(int t) { return ((t & 63) << 6) | (t >> 6); }

template <bool MAPIN>
__device__ __forceinline__ void transpose_item(const float* __restrict__ W, int ldw, int K, bf16_t* __restrict__ WT, int k0, int n0, float* tile) {
    const int tid = threadIdx.x;
#pragma unroll
    for (int j = 0; j < 8; ++j) { const int i = tid + NT * j, kk = i >> 6, nn = i & 63; int oc = n0 + nn; if (MAPIN) oc = in_col_map(oc);
        tile[kk * 65 + nn] = (oc >= 0) ? W[(size_t)(k0 + kk) * ldw + oc] : 0.f; }
    __syncthreads();
    { const int n = tid >> 3, kc = tid & 7; const float* s = tile + (kc * 8) * 65 + n;
      uint4 o; o.x = pk2(s[0], s[65]); o.y = pk2(s[2 * 65], s[3 * 65]); o.z = pk2(s[4 * 65], s[5 * 65]); o.w = pk2(s[6 * 65], s[7 * 65]);
      *(uint4*)(WT + (size_t)(n0 + n) * K + k0 + kc * 8) = o; }
    __syncthreads();
}
constexpr int TI_IN = (DM / 64) * (NINP / 64), TI_OUT = (DM / 64) * (DM / 64), TI_GLU = 8 * 8;
constexpr int N_TITEMS = DEPTH * (TI_IN + TI_OUT + TI_GLU);
__device__ __forceinline__ void phase_weights(const Params& p, int bid, int nb, float* smem) {
    for (int it = bid; it < N_TITEMS; it += nb) {
        int r = it;
        if (r < DEPTH * TI_IN) { const int l = r / TI_IN, q = r % TI_IN, kb = q / (NINP / 64), nbk = q % (NINP / 64);
            transpose_item<true>(p.in[I_WIN] + (size_t)l * DM * NIN, NIN, DM, (bf16_t*)(p.ws + WS_WIN) + (size_t)l * NINP * DM, kb * 64, nbk * 64, smem); continue; }
        r -= DEPTH * TI_IN;
        if (r < DEPTH * TI_OUT) { const int l = r / TI_OUT, q = r % TI_OUT, kb = q / 32, nbk = q % 32;
            transpose_item<false>(p.in[I_WOUT] + (size_t)l * DM * DM, DM, DM, (bf16_t*)(p.ws + WS_WOUT) + (size_t)l * DM * DM, kb * 64, nbk * 64, smem); continue; }
        r -= DEPTH * TI_OUT;
        { const int l = r / TI_GLU, q = r % TI_GLU, kb = q / 8, nbk = q % 8;
            transpose_item<false>(p.in[I_WGLU] + (size_t)l * 512 * 512, 512, 512, (bf16_t*)(p.ws + WS_WGLU) + (size_t)l * 512 * 512, kb * 64, nbk * 64, smem); }
    }
}
constexpr int N_MODITEMS = DEPTH * (6144 / 64);
__device__ __forceinline__ void phase_mod(const Params& p, int bid, int nb, float* smem) {
    const int tid = threadIdx.x; float* sv = smem;   float* red = smem + 3 * 2048;
    bool loaded = false;
    for (int it = bid; it < N_MODITEMS; it += nb) {
        if (!loaded) { for (int i = tid; i < 3 * 2048; i += NT) { const int r = i >> 11, k = i & 2047; const float c = (r < 2) ? p.in[I_C][r * 2048 + k] : p.in[I_CCTX][k]; sv[i] = silu_f(c); } loaded = true; }
        __syncthreads();
        const int l = it / 96, jb = it % 96, cl = tid & 15, kg = tid >> 4;
        const float* w = p.in[I_WMOD] + (size_t)l * DM * 6144 + jb * 64 + cl * 4;
        f32x4 a0 = {0, 0, 0, 0}, a1 = a0, a2 = a0;
#pragma unroll 4
        for (int kk = 0; kk < 64; ++kk) { const int k = kg * 64 + kk; const f32x4 wv = *(const f32x4*)(w + (size_t)k * 6144);
            a0 += wv * sv[k]; a1 += wv * sv[2048 + k]; a2 += wv * sv[4096 + k]; }
        *(f32x4*)(red + (kg * 3 + 0) * 64 + cl * 4) = a0; *(f32x4*)(red + (kg * 3 + 1) * 64 + cl * 4) = a1; *(f32x4*)(red + (kg * 3 + 2) * 64 + cl * 4) = a2;
        __syncthreads();
        if (tid < 192) { const int r = tid >> 6, c = tid & 63; float s = p.in[I_BMOD][l * 6144 + jb * 64 + c];
            for (int g = 0; g < 32; ++g) s += red[(g * 3 + r) * 64 + c];
            ((float*)(p.ws + WS_MOD))[(size_t)(l * 3 + r) * 6144 + jb * 64 + c] = s; }
        __syncthreads();
    }
}
__device__ __forceinline__ void taps_item(const Params& p, int l, int LX, float* TP, int tb, int cb, float* smem) {
    const int tid = threadIdx.x;
    float* feats = smem;
    float* h1 = feats + 64 * 33;
    float* h2 = h1 + 64 * 64;
    float* T = h2 + 64 * 64;
    const float* w1 = p.in[I_HW1] + l * 33 * 64; const float* b1 = p.in[I_HB1] + l * 64; const float* f1 = p.in[I_HF1] + l * 64;
    const float* w2 = p.in[I_HW2] + l * 64 * 64; const float* b2 = p.in[I_HB2] + l * 64; const float* f2 = p.in[I_HF2] + l * 64;
    const float* w3 = p.in[I_HW3] + (size_t)l * 64 * 2048;
#pragma unroll 1
    for (int i = tid; i < 64 * 33; i += NT) { const int tt = i / 33, f = i % 33; const int tau = tb * 64 + tt;
        const float ang = (6.283185307179586f / (float)LX) * (float)tau; float v;
        if (f == 0) v = (float)tau / (float)(LX - 1);
        else { const int bi = (f - 1) & 15; const float band = 1e-4f + (float)bi * ((15.0f - 1e-4f) / 15.0f); const float a = band * ang; v = (f <= 16) ? cosf(a) : -sinf(a); }
        feats[i] = v; }
    __syncthreads();
#pragma unroll 1
    for (int i = tid; i < 64 * 64; i += NT) { const int tt = i >> 6, j = i & 63; float s = b1[j];
#pragma unroll 3
        for (int f = 0; f < 33; ++f) s += feats[tt * 33 + f] * w1[f * 64 + j];
        h1[i] = sinf(f1[j] * s); }
    __syncthreads();
#pragma unroll 1
    for (int i = tid; i < 64 * 64; i += NT) { const int tt = i >> 6, j = i & 63; float s = b2[j];
#pragma unroll 4
        for (int f = 0; f < 64; ++f) s += h1[tt * 64 + f] * w2[f * 64 + j];
        h2[i] = sinf(f2[j] * s); }
    __syncthreads();
    { const int cc = tid & 255, th = tid >> 8, col = cb * 256 + cc; float acc[32];
#pragma unroll
      for (int e = 0; e < 32; ++e) acc[e] = 0.f;
#pragma unroll 1
      for (int i = 0; i < 64; ++i) { const float w = w3[(size_t)i * 2048 + col];
#pragma unroll
          for (int e = 0; e < 32; ++e) acc[e] += w * h2[(th * 32 + e) * 64 + i]; }
      const int c = col & 511; const float delta = fabsf(-15.350567286626973f + (float)c * ((-3.0701134573253945f + 15.350567286626973f) / 511.0f));
#pragma unroll
      for (int e = 0; e < 32; ++e) { const int tau = tb * 64 + th * 32 + e; const float tl = (float)tau / (float)(LX - 1); T[cc * 65 + th * 32 + e] = acc[e] * expf(-tl * delta); } }
    __syncthreads();
    { const int tt = tid & 63, cg = tid >> 6; const int tau = tb * 64 + tt;
#pragma unroll 2
      for (int q = 0; q < 32; ++q) { const int cc = cg * 32 + q, col = cb * 256 + cc; const int o = col >> 10, dir = (col >> 9) & 1, c = col & 511;
          float* dst = TP + (size_t)(o * 512 + c) * (2 * LX);
          if (dir == 0) dst[LX - 1 + tau] = T[cc * 65 + tt];
          else if (tau >= 1) dst[LX - 1 - tau] = T[cc * 65 + tt]; } }
    __syncthreads();
}
constexpr int N_TAPITEMS = (SEQ / 64) * 8 + (LCX / 64) * 8;
__device__ __forceinline__ void phase_taps(const Params& p, int l, int bid, int nb, float* smem) {
    float* TPL = (float*)(p.ws + WS_TP); float* TPC = TPL + (size_t)2 * 512 * 2 * SEQ;
    for (int it = bid; it < N_TAPITEMS; it += nb) {
        if (it < (SEQ / 64) * 8) taps_item(p, l, SEQ, TPL, it >> 3, it & 7, smem);
        else { const int q = it - (SEQ / 64) * 8; taps_item(p, l, LCX, TPC, q >> 3, q & 7, smem); }
    }
}

__device__ __forceinline__ void phase_row(const Params& p, int l, int bid, int nb) {
    const int lane = threadIdx.x & 63, wave = threadIdx.x >> 6;
    const float* MOD = (const float*)(p.ws + WS_MOD); const float* R = (const float*)(p.ws + WS_P);
    float* XC = (float*)(p.ws + WS_XC); bf16_t* H = (bf16_t*)(p.ws + WS_H);
    const int nrows = (l == DEPTH) ? NLAT : MROWS;
    for (int r = bid * 8 + wave; r < nrows; r += nb * 8) {
        const bool lat = r < NLAT; const int b = lat ? (r >> 12) : 0, t = r & 4095, rb = lat ? b : 2;
        const float* xin; float* xout;
        if (lat) { xin = ((l <= 1) ? p.in[I_X] : p.out) + (size_t)r * DM; xout = p.out + (size_t)r * DM; }
        else { xin = ((l <= 1) ? p.in[I_CTX] : XC) + (size_t)(r - NLAT) * DM; xout = XC + (size_t)(r - NLAT) * DM; }
        f32x4 x[8];
#pragma unroll
        for (int j = 0; j < 8; ++j) x[j] = *(const f32x4*)(xin + 4 * lane + 256 * j);
        if (l > 0) {
            const int lp = l - 1; const int rr = (lat && (lp & 1)) ? (b * SEQ + permtok(t)) : r;
            const float* Rr = R + (size_t)rr * DM; f32x4 v[8]; float ss = 0.f;
#pragma unroll
            for (int j = 0; j < 8; ++j) { v[j] = *(const f32x4*)(Rr + 4 * lane + 256 * j); ss += v[j][0] * v[j][0] + v[j][1] * v[j][1] + v[j][2] * v[j][2] + v[j][3] * v[j][3]; }
            const float rs = rsqrtf(wave_sum(ss) * (1.f / DM) + EPS);
            const float* gate = MOD + (size_t)(lp * 3 + rb) * 6144 + 4096; const float* gp = p.in[I_GPOST] + lp * DM;
#pragma unroll
            for (int j = 0; j < 8; ++j) { const f32x4 g = *(const f32x4*)(gate + 4 * lane + 256 * j), w = *(const f32x4*)(gp + 4 * lane + 256 * j);
                x[j] = x[j] + g * (v[j] * rs * w); *(f32x4*)(xout + 4 * lane + 256 * j) = x[j]; }
        }
        if (l < DEPTH) {
            float ss = 0.f;
#pragma unroll
            for (int j = 0; j < 8; ++j) ss += x[j][0] * x[j][0] + x[j][1] * x[j][1] + x[j][2] * x[j][2] + x[j][3] * x[j][3];
            const float rs = rsqrtf(wave_sum(ss) * (1.f / DM) + EPS);
            const float* shift = MOD + (size_t)(l * 3 + rb) * 6144; const float* scale = shift + 2048; const float* gp = p.in[I_GPRE] + l * DM;
            const int hr = (lat && (l & 1)) ? (b * SEQ + permtok(t)) : r;
            bf16_t* hrow = H + (size_t)hr * DM;
#pragma unroll
            for (int j = 0; j < 8; ++j) { const f32x4 sh = *(const f32x4*)(shift + 4 * lane + 256 * j), sc = *(const f32x4*)(scale + 4 * lane + 256 * j), w = *(const f32x4*)(gp + 4 * lane + 256 * j);
                const f32x4 y = (x[j] * rs * w) * (sc + 1.f) + sh; uint2 o; o.x = pk2(y[0], y[1]); o.y = pk2(y[2], y[3]);
                *(uint2*)(hrow + 4 * lane + 256 * j) = o; }
        }
    }
}

constexpr int N_HTITEMS = (MROWS / 64) * 32;
__device__ __forceinline__ void phase_hyT(const Params& p, int bid, int nb, float* tile) {
    const int tid = threadIdx.x; const float* P = (const float*)(p.ws + WS_P); float* HT = (float*)(p.ws + WS_HT); float* HTC = HT + (size_t)NB * 2048 * SEQ;
    for (int it = bid; it < N_HTITEMS; it += nb) {
        const int rb = it >> 5, cb = it & 31, r0 = rb * 64, c0 = cb * 64;
#pragma unroll
        for (int j = 0; j < 8; ++j) { const int i = tid + NT * j, rr = i >> 6, cc = i & 63; tile[cc * 65 + rr] = P[(size_t)(r0 + rr) * NINP + PHV + c0 + cc]; }
        __syncthreads();
        { const int cc = tid >> 3, tq = tid & 7; const float* s = tile + cc * 65 + tq * 8; float* dst;
          if (r0 < NLAT) { const int b = r0 >> 12, t0 = r0 & 4095; dst = HT + ((size_t)(b * 2048 + c0 + cc)) * SEQ + t0 + tq * 8; }
          else { const int q = r0 - NLAT, b = q >> 8, t0 = q & 255; dst = HTC + ((size_t)(b * 2048 + c0 + cc)) * LCX + t0 + tq * 8; }
          f32x4 a = {s[0], s[1], s[2], s[3]}, bq = {s[4], s[5], s[6], s[7]}; *(f32x4*)dst = a; *(f32x4*)(dst + 4) = bq; }
        __syncthreads();
    }
}

__device__ __forceinline__ int seq_row(int b, int dir, int n) {
    if (n < LCX) { const int tc = dir ? (LCX - 1 - n) : n; return NLAT + b * LCX + tc; }
    const int m = n - LCX; const int t = dir ? (SEQ - 1 - m) : m; return b * SEQ + t;
}
__device__ __forceinline__ void phase_gla_naive(const Params& p, int l, int bid, int nb, float* smem) {
    const int tid = threadIdx.x; const float* P = (const float*)(p.ws + WS_P); float* OG = (float*)(p.ws + WS_OG);
    float* sq = smem; float* sk = sq + 8 * 128; float* se = sk + 8 * 128; float* sv = se + 8 * 128; float* so = sv + 8 * 256;
    for (int it = bid; it < 16; it += nb) {
        const int b = it >> 3, dir = (it >> 2) & 1, h = it & 3;
        const int j = tid & 255, half = tid >> 8, kk0 = tid & 127;
        float wg[16];
#pragma unroll
        for (int r = 0; r < 16; ++r) wg[r] = p.in[I_GWG][((size_t)(l * 2 + dir) * 16 + r) * 512 + h * 128 + kk0];
        const float bgk = p.in[I_GBG][(l * 2 + dir) * 512 + h * 128 + kk0];
        float S[64];
#pragma unroll
        for (int k = 0; k < 64; ++k) S[k] = 0.f;
        for (int sb = 0; sb < (SEQ + LCX) / 8; ++sb) {
#pragma unroll
            for (int e = 0; e < 2; ++e) { const int i = (tid >> 7) + 4 * e; const int row = seq_row(b, dir, sb * 8 + i); const float* pr = P + (size_t)row * NINP;
                float z = bgk;
#pragma unroll
                for (int r = 0; r < 16; ++r) z += pr[PLR + dir * 16 + r] * wg[r];
                const float ls = fminf(z, 0.f) - log1pf(expf(-fabsf(z)));
                sq[i * 128 + kk0] = pr[PQ + h * 128 + kk0] * 0.08838834764831845f; sk[i * 128 + kk0] = pr[PK + h * 128 + kk0]; se[i * 128 + kk0] = expf(ls * (1.f / 16.f)); }
#pragma unroll
            for (int e = 0; e < 4; ++e) { const int idx = tid + NT * e, i = idx >> 8, jj = idx & 255; const int row = seq_row(b, dir, sb * 8 + i); sv[i * 256 + jj] = P[(size_t)row * NINP + PV + h * 256 + jj]; }
            __syncthreads();
            float po[8];
#pragma unroll
            for (int i = 0; i < 8; ++i) { const float vj = sv[i * 256 + j]; float o = 0.f;
                const f32x4* q4 = (const f32x4*)(sq + i * 128 + half * 64); const f32x4* k4 = (const f32x4*)(sk + i * 128 + half * 64); const f32x4* e4 = (const f32x4*)(se + i * 128 + half * 64);
#pragma unroll
                for (int k = 0; k < 16; ++k) { const f32x4 qv = q4[k], kv = k4[k], ev = e4[k];
#pragma unroll
                    for (int c = 0; c < 4; ++c) { float s = S[4 * k + c] * ev[c]; if (dir == 0) { s += kv[c] * vj; o += qv[c] * s; } else { o += qv[c] * s; s += kv[c] * vj; } S[4 * k + c] = s; } }
                po[i] = o; }
            if (half == 1) {
#pragma unroll
                for (int i = 0; i < 8; ++i) so[i * 256 + j] = po[i]; }
            __syncthreads();
            if (half == 0) {
#pragma unroll
                for (int i = 0; i < 8; ++i) { const int row = seq_row(b, dir, sb * 8 + i); OG[((size_t)dir * MROWS + row) * 1024 + h * 256 + j] = po[i] + so[i * 256 + j]; } }
            __syncthreads();
        }
    }
}
__device__ __forceinline__ void phase_s5_naive(const Params& p, int l, int bid, int nb, float* smem) {
    const int tid = threadIdx.x, lane = tid & 63, wave = tid >> 6; const float* P = (const float*)(p.ws + WS_P); float* YS = (float*)(p.ws + WS_YS5);
    float2* sC = (float2*)smem + wave * (16 * 64);
    float2* xs = (float2*)smem + 8 * 16 * 64 + wave * (16 * 65);
    for (int wb = bid; wb < 16; wb += nb) {
        const int gw = wb * 8 + wave, b = gw >> 6, dir = (gw >> 5) & 1, g = gw & 31;
        const size_t pg = ((size_t)(l * 2 + dir) * 32 + g);
        const float lr = p.in[I_LRE][pg * 64 + lane], li = p.in[I_LIM][pg * 64 + lane], step = expf(p.in[I_LSTEP][pg]);
        const float em1 = expm1f(lr * step); float sn, cs; sincosf(li * step, &sn, &cs); const float shf = sinf(0.5f * li * step);
        const float lbr = (em1 + 1.f) * cs, lbi = (em1 + 1.f) * sn;
        const float den = lr * lr + li * li, nr = em1 * cs - 2.f * shf * shf, ni = lbi;
        const float cr = (nr * lr + ni * li) / den, ci = (ni * lr - nr * li) / den;
        float Br[16], Bi[16];
#pragma unroll
        for (int hh = 0; hh < 16; ++hh) { const float br = p.in[I_BRE][(pg * 64 + lane) * 16 + hh], bi = p.in[I_BIM][(pg * 64 + lane) * 16 + hh]; Br[hh] = cr * br - ci * bi; Bi[hh] = cr * bi + ci * br; }
        for (int i = lane; i < 16 * 64; i += 64) sC[i] = make_float2(p.in[I_CRE][pg * 1024 + i], p.in[I_CIM][pg * 1024 + i]);
        float xr = 0.f, xi = 0.f;
        for (int blk = 0; blk < (SEQ + LCX) / 16; ++blk) {
            for (int i = 0; i < 16; ++i) { const int row = seq_row(b, dir, blk * 16 + i); const float* u = P + (size_t)row * NINP + PU + g * 16;
                float bur = 0.f, bui = 0.f;
#pragma unroll
                for (int q = 0; q < 4; ++q) { const f32x4 uv = *(const f32x4*)(u + 4 * q);
#pragma unroll
                    for (int c = 0; c < 4; ++c) { bur += Br[4 * q + c] * uv[c]; bui += Bi[4 * q + c] * uv[c]; } }
                const float nxr = lbr * xr - lbi * xi + bur, nxi = lbr * xi + lbi * xr + bui; xr = nxr; xi = nxi;
                xs[i * 65 + lane] = make_float2(xr, xi); }
            __syncthreads();
            { const int tt = lane & 15, hg = lane >> 4; float y[4] = {0.f, 0.f, 0.f, 0.f};
              for (int q = 0; q < 64; ++q) { const float2 xv = xs[tt * 65 + q];
#pragma unroll
                  for (int e = 0; e < 4; ++e) { const float2 c = sC[(hg * 4 + e) * 64 + q]; y[e] += c.x * xv.x - c.y * xv.y; } }
              const int row = seq_row(b, dir, blk * 16 + tt);
              f32x4 o = {y[0], y[1], y[2], y[3]}; *(f32x4*)(YS + ((size_t)dir * MROWS + row) * 512 + g * 16 + hg * 4) = o; }
            __syncthreads();
        }
    }
}
template <int LX, int NTT>
__device__ __forceinline__ void hy_naive_item(const Params& p, int l, const float* TP, float* HTb, int c, float* smem) {
    const int tid = threadIdx.x;
    float* tp = smem; float* vb = tp + 2 * LX; float* zb = vb + 2 * LX;
    const float* cw = p.in[I_HCW] + (size_t)l * 3 * 1536; const float* cb = p.in[I_HCB] + (size_t)l * 1536; const float* hd = p.in[I_HD] + (size_t)l * 2 * 512;
#define SHORTC(dst, chan) do { const float w0 = cw[chan], w1 = cw[1536 + (chan)], w2 = cw[2 * 1536 + (chan)], bb = cb[chan]; \
        for (int i = tid; i < 2 * LX; i += NT) { const int b = i / LX, t = i % LX; const float* s = HTb + ((size_t)(b * 2048 + (chan))) * LX; \
            const float a = (t > 0) ? s[t - 1] : 0.f, m = s[t], n = (t < LX - 1) ? s[t + 1] : 0.f; dst[i] = w0 * a + w1 * m + w2 * n + bb; } } while (0)
    for (int i = tid; i < 2 * LX; i += NT) tp[i] = (i < 2 * LX - 1) ? TP[(size_t)(0 * 512 + c) * (2 * LX) + i] : 0.f;
    SHORTC(vb, c);
    __syncthreads();
    float acc[2][NTT];
#pragma unroll
    for (int e = 0; e < NTT; ++e) { acc[0][e] = 0.f; acc[1][e] = 0.f; }
    for (int s = 0; s < LX; ++s) { const float v0 = vb[s], v1 = vb[LX + s];
#pragma unroll
        for (int e = 0; e < NTT; ++e) { const int t = tid + NT * e; if (t < LX) { const float w = tp[LX - 1 + t - s]; acc[0][e] += w * v0; acc[1][e] += w * v1; } } }
    __syncthreads();
    {
        const int ch = 512 + c; const float w0 = cw[ch], w1 = cw[1536 + ch], w2 = cw[2 * 1536 + ch], bb = cb[ch]; const float d0 = hd[c];
#pragma unroll
        for (int e = 0; e < NTT; ++e) { const int t = tid + NT * e; if (t < LX) {
#pragma unroll
            for (int b = 0; b < 2; ++b) { const float* s = HTb + ((size_t)(b * 2048 + ch)) * LX; const float a = (t > 0) ? s[t - 1] : 0.f, m = s[t], n = (t < LX - 1) ? s[t + 1] : 0.f;
                const float x1 = w0 * a + w1 * m + w2 * n + bb; zb[b * LX + t] = x1 * (acc[b][e] + d0 * vb[b * LX + t]); } } }
    }
    for (int i = tid; i < 2 * LX; i += NT) tp[i] = (i < 2 * LX - 1) ? TP[(size_t)(1 * 512 + c) * (2 * LX) + i] : 0.f;
    __syncthreads();
#pragma unroll
    for (int e = 0; e < NTT; ++e) { acc[0][e] = 0.f; acc[1][e] = 0.f; }
    for (int s = 0; s < LX; ++s) { const float v0 = zb[s], v1 = zb[LX + s];
#pragma unroll
        for (int e = 0; e < NTT; ++e) { const int t = tid + NT * e; if (t < LX) { const float w = tp[LX - 1 + t - s]; acc[0][e] += w * v0; acc[1][e] += w * v1; } } }
    {
        const int ch = 1024 + c; const float w0 = cw[ch], w1 = cw[1536 + ch], w2 = cw[2 * 1536 + ch], bb = cb[ch]; const float d1 = hd[512 + c];
#pragma unroll
        for (int e = 0; e < NTT; ++e) { const int t = tid + NT * e; if (t < LX) {
#pragma unroll
            for (int b = 0; b < 2; ++b) { const float* s = HTb + ((size_t)(b * 2048 + ch)) * LX; const float a = (t > 0) ? s[t - 1] : 0.f, m = s[t], n = (t < LX - 1) ? s[t + 1] : 0.f;
                const float x2 = w0 * a + w1 * m + w2 * n + bb; const float gt = HTb[((size_t)(b * 2048 + 1536 + c)) * LX + t];
                HTb[((size_t)(b * 2048 + c)) * LX + t] = x2 * (acc[b][e] + d1 * zb[b * LX + t]) * silu_f(gt); } } }
    }
    __syncthreads();
#undef SHORTC
}
__device__ __forceinline__ void phase_hy_naive(const Params& p, int l, int bid, int nb, float* smem) {
    float* HT = (float*)(p.ws + WS_HT); float* HTC = HT + (size_t)NB * 2048 * SEQ;
    const float* TPL = (const float*)(p.ws + WS_TP); const float* TPC = TPL + (size_t)2 * 512 * 2 * SEQ;
    for (int it = bid; it < 1024; it += nb) {
        if (it < 512) hy_naive_item<SEQ, 8>(p, l, TPL, HT, it, smem);
        else hy_naive_item<LCX, 1>(p, l, TPC, HTC, it - 512, smem);
    }
}

constexpr int N_POSTT = NB * 8 * (SEQ / 64) + NB * 8 * (LCX / 64);
__device__ __forceinline__ void phase_post(const Params& p, int l, int bid, int nb, float* tile) {
    const int tid = threadIdx.x, lane = tid & 63, wave = tid >> 6;
    const float* P = (const float*)(p.ws + WS_P); const float* OG = (const float*)(p.ws + WS_OG); const float* YS = (const float*)(p.ws + WS_YS5);
    bf16_t* YC = (bf16_t*)(p.ws + WS_YCAT); bf16_t* YG = (bf16_t*)(p.ws + WS_YG);
    const float* gn = p.in[I_GNORM] + l * 256; const float* sd = p.in[I_S5D] + l * 512;
    for (int r = bid * 8 + wave; r < MROWS; r += nb * 8) {
        const float* pr = P + (size_t)r * NINP;
#pragma unroll
        for (int hh = 0; hh < 4; ++hh) { const int col = hh * 256 + 4 * lane;
            const f32x4 o = *(const f32x4*)(OG + (size_t)r * 1024 + col) + *(const f32x4*)(OG + ((size_t)MROWS + r) * 1024 + col);
            const float rs = rsqrtf(wave_sum(o[0] * o[0] + o[1] * o[1] + o[2] * o[2] + o[3] * o[3]) * (1.f / 256.f) + EPS);
            const f32x4 w = *(const f32x4*)(gn + 4 * lane), g = *(const f32x4*)(pr + PGG + col);
            uint2 q; q.x = pk2(o[0] * rs * w[0] * silu_f(g[0]), o[1] * rs * w[1] * silu_f(g[1])); q.y = pk2(o[2] * rs * w[2] * silu_f(g[2]), o[3] * rs * w[3] * silu_f(g[3]));
            *(uint2*)(YC + (size_t)r * DM + col) = q; }
#pragma unroll
        for (int e = 0; e < 2; ++e) { const int col = 4 * lane + 256 * e;
            const f32x4 y = *(const f32x4*)(sd + col) * *(const f32x4*)(pr + PU + col) + *(const f32x4*)(YS + (size_t)r * 512 + col) + *(const f32x4*)(YS + ((size_t)MROWS + r) * 512 + col);
            uint2 q; q.x = pk2(gelu_tanh(y[0]), gelu_tanh(y[1])); q.y = pk2(gelu_tanh(y[2]), gelu_tanh(y[3]));
            *(uint2*)(YG + (size_t)r * 512 + col) = q; }
    }
    const float* HT = (const float*)(p.ws + WS_HT); const float* HTC = HT + (size_t)NB * 2048 * SEQ;
    for (int it = bid; it < N_POSTT; it += nb) {
        const float* src; int LX, b, cb, tb, rbase;
        if (it < NB * 8 * (SEQ / 64)) { LX = SEQ; b = it / (8 * 64); const int q = it % (8 * 64); cb = q >> 6; tb = q & 63; src = HT; rbase = b * SEQ; }
        else { const int i2 = it - NB * 8 * (SEQ / 64); LX = LCX; b = i2 / (8 * 4); const int q = i2 % (8 * 4); cb = q >> 2; tb = q & 3; src = HTC; rbase = NLAT + b * LCX; }
#pragma unroll
        for (int j = 0; j < 8; ++j) { const int i = tid + NT * j, cc = i >> 6, tt = i & 63; tile[tt * 65 + cc] = src[((size_t)(b * 2048 + cb * 64 + cc)) * LX + tb * 64 + tt]; }
        __syncthreads();
        { const int tt = tid >> 3, cq = tid & 7; const float* s = tile + tt * 65 + cq * 8;
          uint4 o; o.x = pk2(s[0], s[1]); o.y = pk2(s[2], s[3]); o.z = pk2(s[4], s[5]); o.w = pk2(s[6], s[7]);
          *(uint4*)(YC + (size_t)(rbase + tb * 64 + tt) * DM + 1536 + cb * 64 + cq * 8) = o; }
        __syncthreads();
    }
}

__device__ __forceinline__ void phase_inproj(const Params& p, int l, int bid, int nb, LAS unsigned char* lds) {
    pg8::Gemm g{(const bf16_t*)(p.ws + WS_H), (const bf16_t*)(p.ws + WS_WIN) + (size_t)l * NINP * DM, MROWS, NINP, DM};
    pg8::StaticOrder S; S.init(MROWS, NINP, nb, bid);
    pg8::EpiF32 E{(float*)(p.ws + WS_P), NINP};
    pg8::gemm_phase<pg8::EpiF32, pg8::StaticOrder, true, true>(lds, g, S, E);
}
__device__ __forceinline__ void phase_glu(const Params& p, int l, int bid, int nb, LAS unsigned char* lds) {
    pg8::Gemm g{(const bf16_t*)(p.ws + WS_YG), (const bf16_t*)(p.ws + WS_WGLU) + (size_t)l * 512 * 512, MROWS, 512, 512};
    pg8::StaticOrder S; S.init(MROWS, 512, nb, bid);
    pg8::EpiGlu E{(const bf16_t*)(p.ws + WS_YG), (const float*)(p.ws + WS_P) + PSG, NINP, p.in[I_BGLU] + l * 512, (bf16_t*)(p.ws + WS_YCAT) + 1024, DM};
    pg8::gemm_phase<pg8::EpiGlu, pg8::StaticOrder, true, true>(lds, g, S, E);
}
__device__ __forceinline__ void phase_outproj(const Params& p, int l, int bid, int nb, LAS unsigned char* lds) {
    pg8::Gemm g{(const bf16_t*)(p.ws + WS_YCAT), (const bf16_t*)(p.ws + WS_WOUT) + (size_t)l * DM * DM, MROWS, DM, DM};
    pg8::StaticOrder S; S.init(MROWS, DM, nb, bid);
    pg8::EpiF32 E{(float*)(p.ws + WS_P), DM};
    pg8::gemm_phase<pg8::EpiF32, pg8::StaticOrder, true, true>(lds, g, S, E);
}

constexpr int LDS_BYTES = 147456;
enum { PH_PRO = 0, PH_TAPS, PH_ROW, PH_INPROJ, PH_HYT, PH_MIX, PH_POST, PH_GLU, PH_OUTPROJ };

template <int PH>
__global__ void __launch_bounds__(NT, 2) k_phase(Params p, int l) {
    extern __shared__ __attribute__((aligned(16))) unsigned char lds[];
    float* smem = (float*)lds; const int bid = blockIdx.x, nb = gridDim.x;
    if (PH == PH_PRO) { phase_weights(p, bid, nb, smem); phase_mod(p, bid, nb, smem); }
    if (PH == PH_TAPS) phase_taps(p, l, bid, nb, smem);
    if (PH == PH_ROW) phase_row(p, l, bid, nb);
    if (PH == PH_INPROJ) phase_inproj(p, l, bid, nb, (LAS unsigned char*)lds);
    if (PH == PH_HYT) phase_hyT(p, bid, nb, smem);
    if (PH == PH_MIX) {
        if (bid < 16) phase_gla_naive(p, l, bid, 16, smem);
        else if (bid < 32) phase_s5_naive(p, l, bid - 16, 16, smem);
        else phase_hy_naive(p, l, bid - 32, nb - 32, smem);
    }
    if (PH == PH_POST) phase_post(p, l, bid, nb, smem);
    if (PH == PH_GLU) phase_glu(p, l, bid, nb, (LAS unsigned char*)lds);
    if (PH == PH_OUTPROJ) phase_outproj(p, l, bid, nb, (LAS unsigned char*)lds);
}

template <int PH> static void launch_phase(const Params& p, int l, int grid, hipStream_t stream) {
    static bool attr = false;
    if (!attr) { (void)hipFuncSetAttribute((const void*)k_phase<PH>, hipFuncAttributeMaxDynamicSharedMemorySize, LDS_BYTES); attr = true; }
    hipLaunchKernelGGL(k_phase<PH>, dim3(grid), dim3(NT), LDS_BYTES, stream, p, l);
}

extern "C" void kernel_launch(void* const* d_in, const int* in_sizes, int n_in, void* d_out, int out_size, void* d_ws, size_t ws_size, hipStream_t stream) {
    if (n_in != 33 || out_size != NLAT * DM || ws_size < WS_END) { fprintf(stderr, "kernel_launch: unexpected problem (n_in %d out %d ws %zu need %zu)\n", n_in, out_size, ws_size, (size_t)WS_END); return; }
    Params p{};
    for (int i = 0; i < 33; ++i) p.in[i] = (const float*)d_in[i];
    p.out = (float*)d_out; p.ws = (unsigned char*)d_ws;
    const int G = 256;
    launch_phase<PH_PRO>(p, 0, G, stream);
    for (int l = 0; l < DEPTH; ++l) {
        launch_phase<PH_TAPS>(p, l, G, stream);
        launch_phase<PH_ROW>(p, l, G, stream);
        launch_phase<PH_INPROJ>(p, l, G, stream);
        launch_phase<PH_HYT>(p, l, G, stream);
        launch_phase<PH_MIX>(p, l, G, stream);
        launch_phase<PH_POST>(p, l, G, stream);
        launch_phase<PH_GLU>(p, l, G, stream);
        launch_phase<PH_OUTPROJ>(p, l, G, stream);
    }
    launch_phase<PH_ROW>(p, DEPTH, G, stream);
}
```

```cpp
#include <hip/hip_runtime.h>
#include <hip/hip_cooperative_groups.h>
#include <cstdio>
#include <cstdint>
#include <cmath>
namespace pg8 {
#define PG8_LAS __attribute__((address_space(3)))
typedef unsigned short bf16_t;
typedef short bf16x8 __attribute__((ext_vector_type(8)));
typedef float f32x4 __attribute__((ext_vector_type(4)));
typedef unsigned u32x4 __attribute__((ext_vector_type(4)));
constexpr int BM = 256, BK = 64, HALF = 128, HTB = HALF * BK * 2  , STAGE_BYTES = 8 * HTB, NXCD = 8, WGM = 8;

__host__ __device__ __forceinline__ int lds_byte(int r, int c) { const int st = (r >> 4) * 2 + (c >> 5), rr = r & 15, cc = c & 31, ob = rr * 64 + cc * 2; return st * 1024 + (ob ^ (((ob >> 9) & 1) << 5)); }
__host__ __device__ __forceinline__ void stage_rc(int b, int& R, int& C) { const int st = b / 1024, sb = b % 1024, swz = sb ^ (((sb >> 9) & 1) << 5); R = (st >> 1) * 16 + swz / 64; C = (st & 1) * 32 + (swz % 64) / 2; }
__host__ __device__ __forceinline__ int perm32(int rho) { const int n = rho >> 4, i = rho & 15; return 8 * (i >> 2) + 4 * n + (i & 3); }

struct Unit { int pm, pn; };
struct Gemm { const bf16_t* A; const bf16_t* Bt; int M, N, K; };

struct StaticOrder {
    int nM, nN, nwg, G, c;
    __host__ __device__ void init(int M, int N, int G_, int c_) { nM = M / BM; nN = N / BM; nwg = nM * nN; G = G_; c = c_; }
    __host__ __device__ bool next(int i, Unit& u) const {
        const long L = (long)i * G + c; if (L >= nwg) return false;
        int wgid = (int)L; { const int q = nwg / NXCD, r = nwg % NXCD, xcd = wgid % NXCD, off = wgid / NXCD; wgid = (xcd < r ? xcd * (q + 1) : r * (q + 1) + (xcd - r) * q) + off; }
        const int nig = WGM * nN, gid = wgid / nig, fm = gid * WGM, gsz = (nM - fm) < WGM ? (nM - fm) : WGM;
        u.pm = fm + ((wgid % nig) % gsz); u.pn = (wgid % nig) / gsz; return true;
    }
    __device__ __forceinline__ void a_ready(const Unit&) const {}
    __device__ __forceinline__ void done(const Unit&) const {}
};


__device__ __forceinline__ unsigned cvt_pk_bf16(float lo, float hi) { unsigned r; asm volatile("v_cvt_pk_bf16_f32 %0, %1, %2" : "=v"(r) : "v"(lo), "v"(hi)); return r; }
__device__ __forceinline__ float bf2f(unsigned short h) { return __builtin_bit_cast(float, (unsigned)h << 16); }

struct EpiF32 {
    static constexpr bool PERM = false, AFTER_DRAIN = false;
    float* O; int ldc;
    __device__ __forceinline__ void operator()(const f32x4 (&acc)[2][2][4][2], const Unit& u, int wr, int wc, int fr, int fq) const {
        const int row0 = u.pm * BM + wr * 64 + fr, col0 = u.pn * BM + wc * 32 + 4 * fq;
#pragma unroll
        for (int ai = 0; ai < 2; ++ai)
#pragma unroll
            for (int m = 0; m < 4; ++m) { float* rowp = O + (size_t)(row0 + ai * HALF + m * 16) * ldc + col0;
#pragma unroll
                for (int bj = 0; bj < 2; ++bj)
#pragma unroll
                    for (int n = 0; n < 2; ++n) *(f32x4*)(rowp + bj * HALF + n * 16) = acc[ai][bj][m][n]; }
    }
};
struct EpiGlu {
    static constexpr bool PERM = false, AFTER_DRAIN = false;
    const bf16_t* YG; const float* Psg; int ldp; const float* bg; bf16_t* Y; int ldy;
    __device__ __forceinline__ void operator()(const f32x4 (&acc)[2][2][4][2], const Unit& u, int wr, int wc, int fr, int fq) const {
        const int row0 = u.pm * BM + wr * 64 + fr, col0 = u.pn * BM + wc * 32 + 4 * fq;
#pragma unroll
        for (int ai = 0; ai < 2; ++ai)
#pragma unroll
            for (int m = 0; m < 4; ++m) { const size_t row = (size_t)(row0 + ai * HALF + m * 16);
#pragma unroll
                for (int bj = 0; bj < 2; ++bj)
#pragma unroll
                    for (int n = 0; n < 2; ++n) { const int col = col0 + bj * HALF + n * 16;
                        const f32x4 a = acc[ai][bj][m][n]; const f32x4 b = *(const f32x4*)(bg + col); const f32x4 sg = *(const f32x4*)(Psg + row * ldp + col);
                        const uint2 y2 = *(const uint2*)(YG + row * 512 + col);
                        float yv[4] = {bf2f((unsigned short)(y2.x & 0xffff)), bf2f((unsigned short)(y2.x >> 16)), bf2f((unsigned short)(y2.y & 0xffff)), bf2f((unsigned short)(y2.y >> 16))};
                        float o[4];
#pragma unroll
                        for (int e = 0; e < 4; ++e) { const float z = a[e] + b[e]; const float s = 1.f / (1.f + __expf(-z)); const float g = sg[e]; const float sl = g / (1.f + __expf(-g)); o[e] = yv[e] * s * sl; }
                        uint2 w; w.x = cvt_pk_bf16(o[0], o[1]); w.y = cvt_pk_bf16(o[2], o[3]);
                        *(uint2*)(Y + row * ldy + col) = w; } }
    }
};
template <class Epi, class Sched, bool ALIGN_EPI = false, bool SP2 = false>
__device__ __forceinline__ void gemm_phase(PG8_LAS unsigned char* lds, const Gemm g, const Sched& S, const Epi& E) {
    int tid_o = threadIdx.x; asm volatile("" : "+v"(tid_o)); const int tid = tid_o, wid = __builtin_amdgcn_readfirstlane(tid >> 6), lane = tid & 63, wr = wid >> 2, wc = wid & 3, fr = lane & 15, fq = lane >> 4;
    const int K = g.K, nt = K / BK;
    unsigned voffA[2], voffB[2];
#pragma unroll
    for (int i = 0; i < 2; ++i) { int R, C; stage_rc(tid * 16 + i * 8192, R, C); const int Rb = Epi::PERM ? ((R & ~31) + perm32(R & 31)) : R;
        voffA[i] = (unsigned)(R * K + C) * 2u; voffB[i] = (unsigned)(Rb * K + C) * 2u; }
    const size_t kstep = (size_t)(BK * 2);
    const size_t hstep = (size_t)HALF * K * 2;
    const size_t tstep = 2 * hstep;
    const unsigned ldsw = (unsigned)wid * 1024u;
    const int aoff = lds_byte(wr * 64 + fr, fq * 8), boff = lds_byte(wc * 32 + fr, fq * 8);
#define PG8_SA(b, h) (((b) * 2 + (h)) * HTB)
#define PG8_SB(b, h) ((4 + (b) * 2 + (h)) * HTB)
#define PG8_STAGE(bufoff, gbase, voff) do { _Pragma("unroll") for (int _i = 0; _i < 2; ++_i) \
        __builtin_amdgcn_global_load_lds((const unsigned*)((const char*)(gbase) + (voff)[_i]), (PG8_LAS unsigned*)(lds + (bufoff) + ldsw + _i * 8192), 16, 0, 0); } while (0)
#define PG8_LDA(dst, b, h) do { _Pragma("unroll") for (int m = 0; m < 4; ++m) _Pragma("unroll") for (int k = 0; k < 2; ++k) dst[m][k] = *(const PG8_LAS bf16x8*)(lds + PG8_SA(b, h) + aoff + m * 2048 + k * 1024); } while (0)
#define PG8_LDB(dst, b, h) do { _Pragma("unroll") for (int n = 0; n < 2; ++n) _Pragma("unroll") for (int k = 0; k < 2; ++k) dst[n][k] = *(const PG8_LAS bf16x8*)(lds + PG8_SB(b, h) + boff + n * 2048 + k * 1024); } while (0)
#define PG8_MMA(ai, bj, At, Bt) do { __builtin_amdgcn_s_setprio(1); _Pragma("unroll") for (int m = 0; m < 4; ++m) _Pragma("unroll") for (int n = 0; n < 2; ++n) _Pragma("unroll") for (int k = 0; k < 2; ++k) \
        acc[ai][bj][m][n] = __builtin_amdgcn_mfma_f32_16x16x32_bf16(Bt[n][k], At[m][k], acc[ai][bj][m][n], 0, 0, 0); __builtin_amdgcn_s_setprio(0); } while (0)
#define PG8_WAIT_V(n) asm volatile("s_waitcnt vmcnt(" #n ")" ::: "memory")
#define PG8_WAIT_L(n) asm volatile("s_waitcnt lgkmcnt(" #n ")" ::: "memory")
#define PG8_BAR __builtin_amdgcn_s_barrier()
#define PG8_SCHED __builtin_amdgcn_sched_barrier(0)
    Unit cur, nxt; int ui = 0;
    if (!S.next(0, cur)) return;
    f32x4 acc[2][2][4][2];
#pragma unroll
    for (int a = 0; a < 2; ++a)
#pragma unroll
        for (int b = 0; b < 2; ++b)
#pragma unroll
            for (int m = 0; m < 4; ++m)
#pragma unroll
                for (int n = 0; n < 2; ++n) acc[a][b][m][n] = (f32x4){0.f, 0.f, 0.f, 0.f};
    bf16x8 At[4][2], B0[2][2], B1[2][2];
    const char* cA = (const char*)g.A + (size_t)cur.pm * tstep; const char* cB = (const char*)g.Bt + (size_t)cur.pn * tstep;
    S.a_ready(cur);
    if constexpr (SP2) {
        PG8_STAGE(PG8_SB(0, 0), cB, voffB); PG8_STAGE(PG8_SB(0, 1), cB + hstep, voffB); PG8_STAGE(PG8_SA(0, 0), cA, voffA); PG8_STAGE(PG8_SA(0, 1), cA + hstep, voffA);
        if (wr == 1) PG8_BAR;
        PG8_WAIT_V(2); PG8_BAR;
        PG8_STAGE(PG8_SB(1, 0), cB + kstep, voffB); PG8_STAGE(PG8_SA(1, 0), cA + kstep, voffA); PG8_STAGE(PG8_SB(1, 1), cB + hstep + kstep, voffB);
        PG8_WAIT_V(6); PG8_BAR;
    } else {
        PG8_STAGE(PG8_SB(0, 0), cB, voffB); PG8_STAGE(PG8_SA(0, 0), cA, voffA); PG8_STAGE(PG8_SB(0, 1), cB + hstep, voffB); PG8_STAGE(PG8_SA(0, 1), cA + hstep, voffA);
        if (wr == 1) PG8_BAR;
        PG8_WAIT_V(4); PG8_BAR;
        PG8_STAGE(PG8_SB(1, 0), cB + kstep, voffB); PG8_STAGE(PG8_SA(1, 0), cA + kstep, voffA); PG8_STAGE(PG8_SB(1, 1), cB + hstep + kstep, voffB);
        PG8_WAIT_V(6); PG8_BAR;
    }
    for (;;) {
        const bool has_next = S.next(ui + 1, nxt);
        const char* nA = has_next ? (const char*)g.A + (size_t)nxt.pm * tstep : cA; const char* nB = has_next ? (const char*)g.Bt + (size_t)nxt.pn * tstep : cB;
        for (int t = 0; t < nt; t += 2) {
            const bool last = (t == nt - 2);
            const char* a1 = cA + (size_t)(t + 1) * kstep;
            const char* a2 = last ? nA : cA + (size_t)(t + 2) * kstep; const char* b2 = last ? nB : cB + (size_t)(t + 2) * kstep;
            const char* a3 = a2 + kstep; const char* b3 = b2 + kstep;
            if (last && has_next) S.a_ready(nxt);
            if constexpr (SP2) {
            PG8_LDB(B0, 0, 0); PG8_LDB(B1, 0, 1); PG8_SCHED; PG8_LDA(At, 0, 0); PG8_STAGE(PG8_SA(1, 1), a1 + hstep, voffA);
            PG8_WAIT_V(8); PG8_WAIT_L(0); PG8_BAR; PG8_MMA(0, 0, At, B0); PG8_MMA(0, 1, At, B1); PG8_BAR; PG8_SCHED;
            PG8_LDA(At, 0, 1); PG8_STAGE(PG8_SB(0, 0), b2, voffB); PG8_STAGE(PG8_SB(0, 1), b2 + hstep, voffB); PG8_STAGE(PG8_SA(0, 0), a2, voffA);
            PG8_WAIT_V(8); PG8_WAIT_L(0); PG8_BAR; PG8_MMA(1, 0, At, B0); PG8_MMA(1, 1, At, B1); PG8_BAR; PG8_SCHED;
            PG8_LDB(B0, 1, 0); PG8_LDB(B1, 1, 1); PG8_SCHED; PG8_LDA(At, 1, 0); PG8_STAGE(PG8_SA(0, 1), a2 + hstep, voffA);
            PG8_WAIT_V(8); PG8_WAIT_L(0); PG8_BAR; PG8_MMA(0, 0, At, B0); PG8_MMA(0, 1, At, B1); PG8_BAR; PG8_SCHED;
            PG8_LDA(At, 1, 1); PG8_STAGE(PG8_SB(1, 0), b3, voffB); PG8_STAGE(PG8_SB(1, 1), b3 + hstep, voffB); PG8_STAGE(PG8_SA(1, 0), a3, voffA);
            PG8_WAIT_V(8); PG8_WAIT_L(0); PG8_BAR; PG8_MMA(1, 0, At, B0); PG8_MMA(1, 1, At, B1); PG8_BAR; PG8_SCHED;
            } else {
            PG8_LDB(B0, 0, 0); PG8_SCHED; PG8_LDA(At, 0, 0); PG8_STAGE(PG8_SA(1, 1), a1 + hstep, voffA);
            PG8_WAIT_L(8); PG8_BAR; PG8_WAIT_L(0); PG8_MMA(0, 0, At, B0); PG8_BAR; PG8_SCHED;
            PG8_LDB(B1, 0, 1); PG8_STAGE(PG8_SB(0, 0), b2, voffB);
            PG8_BAR; PG8_WAIT_L(0); PG8_MMA(0, 1, At, B1); PG8_BAR;
            PG8_LDA(At, 0, 1); PG8_STAGE(PG8_SA(0, 0), a2, voffA);
            PG8_BAR; PG8_WAIT_L(0); PG8_MMA(1, 0, At, B0); PG8_BAR; PG8_SCHED;
            PG8_STAGE(PG8_SB(0, 1), b2 + hstep, voffB);
            PG8_WAIT_V(6); PG8_BAR; PG8_MMA(1, 1, At, B1); PG8_BAR;
            PG8_LDB(B0, 1, 0); PG8_SCHED; PG8_LDA(At, 1, 0); PG8_STAGE(PG8_SA(0, 1), a2 + hstep, voffA);
            PG8_WAIT_L(8); PG8_BAR; PG8_WAIT_L(0); PG8_MMA(0, 0, At, B0); PG8_BAR; PG8_SCHED;
            PG8_LDB(B1, 1, 1); PG8_STAGE(PG8_SB(1, 0), b3, voffB);
            PG8_BAR; PG8_WAIT_L(0); PG8_MMA(0, 1, At, B1); PG8_BAR;
            PG8_LDA(At, 1, 1); PG8_STAGE(PG8_SA(1, 0), a3, voffA);
            PG8_BAR; PG8_WAIT_L(0); PG8_MMA(1, 0, At, B0); PG8_BAR; PG8_SCHED;
            PG8_STAGE(PG8_SB(1, 1), b3 + hstep, voffB);
            PG8_WAIT_V(6); PG8_BAR; PG8_MMA(1, 1, At, B1); PG8_BAR;
            }
        }
        if constexpr (ALIGN_EPI) { if (wr == 0) PG8_BAR; }
        if constexpr (!Epi::AFTER_DRAIN) { E(acc, cur, wr, wc, fr, fq); S.done(cur); }
        if (!has_next) break;
#pragma unroll
        for (int a = 0; a < 2; ++a)
#pragma unroll
            for (int b = 0; b < 2; ++b)
#pragma unroll
                for (int m = 0; m < 4; ++m)
#pragma unroll
                    for (int n = 0; n < 2; ++n) acc[a][b][m][n] = (f32x4){0.f, 0.f, 0.f, 0.f};
        cur = nxt; cA = nA; cB = nB; ++ui;
        if constexpr (ALIGN_EPI) { if (wr == 1) PG8_BAR; }
    }
    PG8_WAIT_V(0);
    if constexpr (!ALIGN_EPI) { if (wr == 0) PG8_BAR; }
    PG8_BAR;
    if constexpr (Epi::AFTER_DRAIN) { E.fused(acc, cur, wr, wc, fr, fq, lds, wid, lane); S.done(cur); }
#undef PG8_SA
#undef PG8_SB
#undef PG8_STAGE
#undef PG8_LDA
#undef PG8_LDB
#undef PG8_MMA
#undef PG8_WAIT_V
#undef PG8_WAIT_L
#undef PG8_BAR
#undef PG8_SCHED
}
}

using pg8::bf16_t; using pg8::f32x4;
#define LAS __attribute__((address_space(3)))
constexpr int DM = 2048, NB = 2, SEQ = 4096, LCX = 256, DEPTH = 4;
constexpr int NLAT = NB * SEQ;
constexpr int MROWS = NLAT + NB * LCX;
constexpr int NIN = 6176, NINP = 6400;
constexpr int PQ = 0, PK = 512, PV = 1024, PU = 2048, PGG = 2560, PSG = 3584, PHV = 4096, PHG = 5632, PLR = 6144;
constexpr float EPS = 1e-6f;
constexpr int NT = 512;

__host__ __device__ __forceinline__ int in_col_map(int n) {
    if (n < 2048) return n;
    if (n < 6144) return n + 32;
    if (n < 6176) return n - 4096;
    return -1;
}

constexpr size_t al256(size_t x) { return (x + 255) & ~(size_t)255; }
constexpr size_t WS_WIN  = 0;
constexpr size_t WS_WOUT = WS_WIN  + al256((size_t)DEPTH * NINP * DM * 2);
constexpr size_t WS_WGLU = WS_WOUT + al256((size_t)DEPTH * DM * DM * 2);
constexpr size_t WS_MOD  = WS_WGLU + al256((size_t)DEPTH * 512 * 512 * 2);
constexpr size_t WS_H    = WS_MOD  + al256((size_t)DEPTH * 3 * 6144 * 4);
constexpr size_t WS_YCAT = WS_H    + al256((size_t)MROWS * DM * 2);
constexpr size_t WS_P    = WS_YCAT + al256((size_t)MROWS * DM * 2);
constexpr size_t WS_XC   = WS_P    + al256((size_t)MROWS * NINP * 4);
constexpr size_t WS_OG   = WS_XC   + al256((size_t)NB * LCX * DM * 4);
constexpr size_t WS_YS5  = WS_OG   + al256((size_t)2 * MROWS * 1024 * 4);
constexpr size_t WS_YG   = WS_YS5  + al256((size_t)2 * MROWS * 512 * 4);
constexpr size_t WS_HT   = WS_YG   + al256((size_t)MROWS * 512 * 2);
constexpr size_t WS_TP   = WS_HT   + al256((size_t)MROWS * 2048 * 4);
constexpr size_t WS_END  = WS_TP   + al256((size_t)2 * 512 * 2 * SEQ * 4) + al256((size_t)2 * 512 * 2 * LCX * 4);

struct Params {
    const float* in[33];
    float* out;
    unsigned char* ws;
};
enum { I_X = 0, I_C, I_CTX, I_CCTX, I_WMOD, I_BMOD, I_GPRE, I_GPOST, I_WIN, I_WOUT, I_GWG, I_GBG, I_GNORM,
       I_LRE, I_LIM, I_LSTEP, I_BRE, I_BIM, I_CRE, I_CIM, I_S5D, I_WGLU, I_BGLU, I_HCW, I_HCB, I_HW1, I_HB1, I_HF1, I_HW2, I_HB2, I_HF2, I_HW3, I_HD };

__device__ __forceinline__ float wave_sum(float v) {
#pragma unroll
    for (int o = 1; o < 64; o <<= 1) v += __shfl_xor(v, o);
    return v;
}
__device__ __forceinline__ float silu_f(float x) { return x / (1.f + expf(-x)); }
__device__ __forceinline__ float gelu_tanh(float x) { const float u = 0.7978845608028654f * (x + 0.044715f * x * x * x); return 0.5f * x * (1.f + tanhf(u)); }
__device__ __forceinline__ unsigned pk2(float lo, float hi) { return pg8::cvt_pk_bf16(lo, hi); }
__device__ __forceinline__ int otid() { int t = threadIdx.x; asm volatile("" : "+v"(t)); return t; }
__device__ __forceinline__ int permtok(int t) { return ((t & 63) << 6) | (t >> 6); }

template <bool MAPIN>
__device__ __forceinline__ void transpose_item(const float* __restrict__ W, int ldw, int K, bf16_t* __restrict__ WT, int k0, int n0, float* tile) {
    const int tid = otid();
#pragma unroll
    for (int j = 0; j < 8; ++j) { const int i = tid + NT * j, kk = i >> 6, nn = i & 63; int oc = n0 + nn; if (MAPIN) oc = in_col_map(oc);
        tile[kk * 65 + nn] = (oc >= 0) ? W[(size_t)(k0 + kk) * ldw + oc] : 0.f; }
    __syncthreads();
    { const int n = tid >> 3, kc = tid & 7; const float* s = tile + (kc * 8) * 65 + n;
      uint4 o; o.x = pk2(s[0], s[65]); o.y = pk2(s[2 * 65], s[3 * 65]); o.z = pk2(s[4 * 65], s[5 * 65]); o.w = pk2(s[6 * 65], s[7 * 65]);
      *(uint4*)(WT + (size_t)(n0 + n) * K + k0 + kc * 8) = o; }
    __syncthreads();
}
constexpr int TI_IN = (DM / 64) * (NINP / 64), TI_OUT = (DM / 64) * (DM / 64), TI_GLU = 8 * 8;
constexpr int N_TITEMS = DEPTH * (TI_IN + TI_OUT + TI_GLU);
__device__ __forceinline__ void phase_weights(const Params& p, int bid, int nb, float* smem) {
    for (int it = bid; it < N_TITEMS; it += nb) {
        int r = it;
        if (r < DEPTH * TI_IN) { const int l = r / TI_IN, q = r % TI_IN, kb = q / (NINP / 64), nbk = q % (NINP / 64);
            transpose_item<true>(p.in[I_WIN] + (size_t)l * DM * NIN, NIN, DM, (bf16_t*)(p.ws + WS_WIN) + (size_t)l * NINP * DM, kb * 64, nbk * 64, smem); continue; }
        r -= DEPTH * TI_IN;
        if (r < DEPTH * TI_OUT) { const int l = r / TI_OUT, q = r % TI_OUT, kb = q / 32, nbk = q % 32;
            transpose_item<false>(p.in[I_WOUT] + (size_t)l * DM * DM, DM, DM, (bf16_t*)(p.ws + WS_WOUT) + (size_t)l * DM * DM, kb * 64, nbk * 64, smem); continue; }
        r -= DEPTH * TI_OUT;
        { const int l = r / TI_GLU, q = r % TI_GLU, kb = q / 8, nbk = q % 8;
            transpose_item<false>(p.in[I_WGLU] + (size_t)l * 512 * 512, 512, 512, (bf16_t*)(p.ws + WS_WGLU) + (size_t)l * 512 * 512, kb * 64, nbk * 64, smem); }
    }
}
constexpr int N_MODITEMS = DEPTH * (6144 / 64);
__device__ __forceinline__ void phase_mod(const Params& p, int bid, int nb, float* smem) {
    const int tid = otid(); float* sv = smem;   float* red = smem + 3 * 2048;
    bool loaded = false;
    for (int it = bid; it < N_MODITEMS; it += nb) {
        if (!loaded) { for (int i = tid; i < 3 * 2048; i += NT) { const int r = i >> 11, k = i & 2047; const float c = (r < 2) ? p.in[I_C][r * 2048 + k] : p.in[I_CCTX][k]; sv[i] = silu_f(c); } loaded = true; }
        __syncthreads();
        const int l = it / 96, jb = it % 96, cl = tid & 15, kg = tid >> 4;
        const float* w = p.in[I_WMOD] + (size_t)l * DM * 6144 + jb * 64 + cl * 4;
        f32x4 a0 = {0, 0, 0, 0}, a1 = a0, a2 = a0;
#pragma unroll 4
        for (int kk = 0; kk < 64; ++kk) { const int k = kg * 64 + kk; const f32x4 wv = *(const f32x4*)(w + (size_t)k * 6144);
            a0 += wv * sv[k]; a1 += wv * sv[2048 + k]; a2 += wv * sv[4096 + k]; }
        *(f32x4*)(red + (kg * 3 + 0) * 64 + cl * 4) = a0; *(f32x4*)(red + (kg * 3 + 1) * 64 + cl * 4) = a1; *(f32x4*)(red + (kg * 3 + 2) * 64 + cl * 4) = a2;
        __syncthreads();
        if (tid < 192) { const int r = tid >> 6, c = tid & 63; float s = p.in[I_BMOD][l * 6144 + jb * 64 + c];
            for (int g = 0; g < 32; ++g) s += red[(g * 3 + r) * 64 + c];
            ((float*)(p.ws + WS_MOD))[(size_t)(l * 3 + r) * 6144 + jb * 64 + c] = s; }
        __syncthreads();
    }
}
__device__ __forceinline__ void taps_item(const Params& p, int l, int LX, float* TP, int tb, int cb, float* smem) {
    const int tid = otid();
    float* feats = smem;
    float* h1 = feats + 64 * 33;
    float* h2 = h1 + 64 * 64;
    float* T = h2 + 64 * 64;
    const float* w1 = p.in[I_HW1] + l * 33 * 64; const float* b1 = p.in[I_HB1] + l * 64; const float* f1 = p.in[I_HF1] + l * 64;
    const float* w2 = p.in[I_HW2] + l * 64 * 64; const float* b2 = p.in[I_HB2] + l * 64; const float* f2 = p.in[I_HF2] + l * 64;
    const float* w3 = p.in[I_HW3] + (size_t)l * 64 * 2048;
#pragma unroll 1
    for (int i = tid; i < 64 * 33; i += NT) { const int tt = i / 33, f = i % 33; const int tau = tb * 64 + tt;
        const float ang = (6.283185307179586f / (float)LX) * (float)tau; float v;
        if (f == 0) v = (float)tau / (float)(LX - 1);
        else { const int bi = (f - 1) & 15; const float band = 1e-4f + (float)bi * ((15.0f - 1e-4f) / 15.0f); const float a = band * ang; v = (f <= 16) ? cosf(a) : -sinf(a); }
        feats[i] = v; }
    __syncthreads();
#pragma unroll 1
    for (int i = tid; i < 64 * 64; i += NT) { const int tt = i >> 6, j = i & 63; float s = b1[j];
#pragma unroll 3
        for (int f = 0; f < 33; ++f) s += feats[tt * 33 + f] * w1[f * 64 + j];
        h1[i] = sinf(f1[j] * s); }
    __syncthreads();
#pragma unroll 1
    for (int i = tid; i < 64 * 64; i += NT) { const int tt = i >> 6, j = i & 63; float s = b2[j];
#pragma unroll 4
        for (int f = 0; f < 64; ++f) s += h1[tt * 64 + f] * w2[f * 64 + j];
        h2[i] = sinf(f2[j] * s); }
    __syncthreads();
    { const int cc = tid & 255, th = tid >> 8, col = cb * 256 + cc; float acc[32];
#pragma unroll
      for (int e = 0; e < 32; ++e) acc[e] = 0.f;
#pragma unroll 1
      for (int i = 0; i < 64; ++i) { const float w = w3[(size_t)i * 2048 + col];
#pragma unroll
          for (int e = 0; e < 32; ++e) acc[e] += w * h2[(th * 32 + e) * 64 + i]; }
      const int c = col & 511; const float delta = fabsf(-15.350567286626973f + (float)c * ((-3.0701134573253945f + 15.350567286626973f) / 511.0f));
#pragma unroll
      for (int e = 0; e < 32; ++e) { const int tau = tb * 64 + th * 32 + e; const float tl = (float)tau / (float)(LX - 1); T[cc * 65 + th * 32 + e] = acc[e] * expf(-tl * delta); } }
    __syncthreads();
    { const int tt = tid & 63, cg = tid >> 6; const int tau = tb * 64 + tt;
#pragma unroll 2
      for (int q = 0; q < 32; ++q) { const int cc = cg * 32 + q, col = cb * 256 + cc; const int o = col >> 10, dir = (col >> 9) & 1, c = col & 511;
          float* dst = TP + (size_t)(o * 512 + c) * (2 * LX);
          if (dir == 0) dst[LX - 1 + tau] = T[cc * 65 + tt];
          else if (tau >= 1) dst[LX - 1 - tau] = T[cc * 65 + tt]; } }
    __syncthreads();
}
constexpr int N_TAPITEMS = (SEQ / 64) * 8 + (LCX / 64) * 8;
__device__ __forceinline__ void phase_taps(const Params& p, int l, int bid, int nb, float* smem) {
    float* TPL = (float*)(p.ws + WS_TP); float* TPC = TPL + (size_t)2 * 512 * 2 * SEQ;
    for (int it = bid; it < N_TAPITEMS; it += nb) {
        if (it < (SEQ / 64) * 8) taps_item(p, l, SEQ, TPL, it >> 3, it & 7, smem);
        else { const int q = it - (SEQ / 64) * 8; taps_item(p, l, LCX, TPC, q >> 3, q & 7, smem); }
    }
}

__device__ __forceinline__ void phase_row(const Params& p, int l, int bid, int nb) {
    const int tid_ = otid(); const int lane = tid_ & 63, wave = tid_ >> 6;
    const float* MOD = (const float*)(p.ws + WS_MOD); const float* R = (const float*)(p.ws + WS_P);
    float* XC = (float*)(p.ws + WS_XC); bf16_t* H = (bf16_t*)(p.ws + WS_H);
    const int nrows = (l == DEPTH) ? NLAT : MROWS;
    for (int r = bid * 8 + wave; r < nrows; r += nb * 8) {
        const bool lat = r < NLAT; const int b = lat ? (r >> 12) : 0, t = r & 4095, rb = lat ? b : 2;
        const float* xin; float* xout;
        if (lat) { xin = ((l <= 1) ? p.in[I_X] : p.out) + (size_t)r * DM; xout = p.out + (size_t)r * DM; }
        else { xin = ((l <= 1) ? p.in[I_CTX] : XC) + (size_t)(r - NLAT) * DM; xout = XC + (size_t)(r - NLAT) * DM; }
        f32x4 x[8];
#pragma unroll
        for (int j = 0; j < 8; ++j) x[j] = *(const f32x4*)(xin + 4 * lane + 256 * j);
        if (l > 0) {
            const int lp = l - 1; const int rr = (lat && (lp & 1)) ? (b * SEQ + permtok(t)) : r;
            const float* Rr = R + (size_t)rr * DM; f32x4 v[8]; float ss = 0.f;
#pragma unroll
            for (int j = 0; j < 8; ++j) { v[j] = *(const f32x4*)(Rr + 4 * lane + 256 * j); ss += v[j][0] * v[j][0] + v[j][1] * v[j][1] + v[j][2] * v[j][2] + v[j][3] * v[j][3]; }
            const float rs = rsqrtf(wave_sum(ss) * (1.f / DM) + EPS);
            const float* gate = MOD + (size_t)(lp * 3 + rb) * 6144 + 4096; const float* gp = p.in[I_GPOST] + lp * DM;
#pragma unroll
            for (int j = 0; j < 8; ++j) { const f32x4 g = *(const f32x4*)(gate + 4 * lane + 256 * j), w = *(const f32x4*)(gp + 4 * lane + 256 * j);
                x[j] = x[j] + g * (v[j] * rs * w); *(f32x4*)(xout + 4 * lane + 256 * j) = x[j]; }
        }
        if (l < DEPTH) {
            float ss = 0.f;
#pragma unroll
            for (int j = 0; j < 8; ++j) ss += x[j][0] * x[j][0] + x[j][1] * x[j][1] + x[j][2] * x[j][2] + x[j][3] * x[j][3];
            const float rs = rsqrtf(wave_sum(ss) * (1.f / DM) + EPS);
            const float* shift = MOD + (size_t)(l * 3 + rb) * 6144; const float* scale = shift + 2048; const float* gp = p.in[I_GPRE] + l * DM;
            const int hr = (lat && (l & 1)) ? (b * SEQ + permtok(t)) : r;
            bf16_t* hrow = H + (size_t)hr * DM;
#pragma unroll
            for (int j = 0; j < 8; ++j) { const f32x4 sh = *(const f32x4*)(shift + 4 * lane + 256 * j), sc = *(const f32x4*)(scale + 4 * lane + 256 * j), w = *(const f32x4*)(gp + 4 * lane + 256 * j);
                const f32x4 y = (x[j] * rs * w) * (sc + 1.f) + sh; uint2 o; o.x = pk2(y[0], y[1]); o.y = pk2(y[2], y[3]);
                *(uint2*)(hrow + 4 * lane + 256 * j) = o; }
        }
    }
}

constexpr int N_HTITEMS = (MROWS / 64) * 32;
__device__ __forceinline__ void phase_hyT(const Params& p, int bid, int nb, float* tile) {
    const int tid = otid(); const float* P = (const float*)(p.ws + WS_P); float* HT = (float*)(p.ws + WS_HT); float* HTC = HT + (size_t)NB * 2048 * SEQ;
    for (int it = bid; it < N_HTITEMS; it += nb) {
        const int rb = it >> 5, cb = it & 31, r0 = rb * 64, c0 = cb * 64;
#pragma unroll
        for (int j = 0; j < 8; ++j) { const int i = tid + NT * j, rr = i >> 6, cc = i & 63; tile[cc * 65 + rr] = P[(size_t)(r0 + rr) * NINP + PHV + c0 + cc]; }
        __syncthreads();
        { const int cc = tid >> 3, tq = tid & 7; const float* s = tile + cc * 65 + tq * 8; float* dst;
          if (r0 < NLAT) { const int b = r0 >> 12, t0 = r0 & 4095; dst = HT + ((size_t)(b * 2048 + c0 + cc)) * SEQ + t0 + tq * 8; }
          else { const int q = r0 - NLAT, b = q >> 8, t0 = q & 255; dst = HTC + ((size_t)(b * 2048 + c0 + cc)) * LCX + t0 + tq * 8; }
          f32x4 a = {s[0], s[1], s[2], s[3]}, bq = {s[4], s[5], s[6], s[7]}; *(f32x4*)dst = a; *(f32x4*)(dst + 4) = bq; }
        __syncthreads();
    }
}

__device__ __forceinline__ int seq_row(int b, int dir, int n) {
    if (n < LCX) { const int tc = dir ? (LCX - 1 - n) : n; return NLAT + b * LCX + tc; }
    const int m = n - LCX; const int t = dir ? (SEQ - 1 - m) : m; return b * SEQ + t;
}
__device__ __forceinline__ void phase_gla_naive(const Params& p, int l, int bid, int nb, float* smem) {
    const int tid = otid(); const float* P = (const float*)(p.ws + WS_P); float* OG = (float*)(p.ws + WS_OG);
    float* sq = smem; float* sk = sq + 8 * 128; float* se = sk + 8 * 128; float* sv = se + 8 * 128; float* so = sv + 8 * 256;
    for (int it = bid; it < 16; it += nb) {
        const int b = it >> 3, dir = (it >> 2) & 1, h = it & 3;
        const int j = tid & 255, half = tid >> 8, kk0 = tid & 127;
        float* swg = so + 16 * 256;
        for (int i = tid; i < 16 * 128; i += NT) swg[i] = p.in[I_GWG][((size_t)(l * 2 + dir) * 16 + (i >> 7)) * 512 + h * 128 + (i & 127)];
        __syncthreads();
        const float bgk = p.in[I_GBG][(l * 2 + dir) * 512 + h * 128 + kk0];
        float S[64];
#pragma unroll
        for (int k = 0; k < 64; ++k) S[k] = 0.f;
        for (int sb = 0; sb < (SEQ + LCX) / 8; ++sb) {
#pragma unroll
            for (int e = 0; e < 2; ++e) { const int i = (tid >> 7) + 4 * e; const int row = seq_row(b, dir, sb * 8 + i); const float* pr = P + (size_t)row * NINP;
                float z = bgk;
#pragma unroll
                for (int r = 0; r < 16; ++r) z += pr[PLR + dir * 16 + r] * swg[r * 128 + kk0];
                const float ls = fminf(z, 0.f) - log1pf(expf(-fabsf(z)));
                sq[i * 128 + kk0] = pr[PQ + h * 128 + kk0] * 0.08838834764831845f; sk[i * 128 + kk0] = pr[PK + h * 128 + kk0]; se[i * 128 + kk0] = expf(ls * (1.f / 16.f)); }
#pragma unroll
            for (int e = 0; e < 4; ++e) { const int idx = tid + NT * e, i = idx >> 8, jj = idx & 255; const int row = seq_row(b, dir, sb * 8 + i); sv[i * 256 + jj] = P[(size_t)row * NINP + PV + h * 256 + jj]; }
            __syncthreads();
#pragma unroll 1
            for (int i = 0; i < 8; ++i) { const float vj = sv[i * 256 + j]; float o = 0.f;
                const f32x4* q4 = (const f32x4*)(sq + i * 128 + half * 64); const f32x4* k4 = (const f32x4*)(sk + i * 128 + half * 64); const f32x4* e4 = (const f32x4*)(se + i * 128 + half * 64);
#pragma unroll
                for (int k = 0; k < 16; ++k) { const f32x4 qv = q4[k], kv = k4[k], ev = e4[k];
#pragma unroll
                    for (int c = 0; c < 4; ++c) { float s = S[4 * k + c] * ev[c]; if (dir == 0) { s += kv[c] * vj; o += qv[c] * s; } else { o += qv[c] * s; s += kv[c] * vj; } S[4 * k + c] = s; } }
                so[(half * 8 + i) * 256 + j] = o; }
            __syncthreads();
            for (int e = tid; e < 8 * 256; e += NT) { const int i = e >> 8, jj = e & 255; const int row = seq_row(b, dir, sb * 8 + i);
                OG[((size_t)dir * MROWS + row) * 1024 + h * 256 + jj] = so[i * 256 + jj] + so[(8 + i) * 256 + jj]; }
            __syncthreads();
        }
    }
}
__device__ __forceinline__ void phase_s5_naive(const Params& p, int l, int bid, int nb, float* smem) {
    const int tid = otid(), lane = tid & 63, wave = tid >> 6; const float* P = (const float*)(p.ws + WS_P); float* YS = (float*)(p.ws + WS_YS5);
    float2* sC = (float2*)smem + wave * (16 * 64);
    float2* xs = (float2*)smem + 8 * 16 * 64 + wave * (16 * 65);
    for (int wb = bid; wb < 16; wb += nb) {
        const int gw = wb * 8 + wave, b = gw >> 6, dir = (gw >> 5) & 1, g = gw & 31;
        const size_t pg = ((size_t)(l * 2 + dir) * 32 + g);
        const float lr = p.in[I_LRE][pg * 64 + lane], li = p.in[I_LIM][pg * 64 + lane], step = expf(p.in[I_LSTEP][pg]);
        const float em1 = expm1f(lr * step); float sn, cs; sincosf(li * step, &sn, &cs); const float shf = sinf(0.5f * li * step);
        const float lbr = (em1 + 1.f) * cs, lbi = (em1 + 1.f) * sn;
        const float den = lr * lr + li * li, nr = em1 * cs - 2.f * shf * shf, ni = lbi;
        const float cr = (nr * lr + ni * li) / den, ci = (ni * lr - nr * li) / den;
        float Br[16], Bi[16];
#pragma unroll
        for (int hh = 0; hh < 16; ++hh) { const float br = p.in[I_BRE][(pg * 64 + lane) * 16 + hh], bi = p.in[I_BIM][(pg * 64 + lane) * 16 + hh]; Br[hh] = cr * br - ci * bi; Bi[hh] = cr * bi + ci * br; }
        for (int i = lane; i < 16 * 64; i += 64) sC[i] = make_float2(p.in[I_CRE][pg * 1024 + i], p.in[I_CIM][pg * 1024 + i]);
        float xr = 0.f, xi = 0.f;
        for (int blk = 0; blk < (SEQ + LCX) / 16; ++blk) {
            for (int i = 0; i < 16; ++i) { const int row = seq_row(b, dir, blk * 16 + i); const float* u = P + (size_t)row * NINP + PU + g * 16;
                float bur = 0.f, bui = 0.f;
#pragma unroll
                for (int q = 0; q < 4; ++q) { const f32x4 uv = *(const f32x4*)(u + 4 * q);
#pragma unroll
                    for (int c = 0; c < 4; ++c) { bur += Br[4 * q + c] * uv[c]; bui += Bi[4 * q + c] * uv[c]; } }
                const float nxr = lbr * xr - lbi * xi + bur, nxi = lbr * xi + lbi * xr + bui; xr = nxr; xi = nxi;
                xs[i * 65 + lane] = make_float2(xr, xi); }
            __syncthreads();
            { const int tt = lane & 15, hg = lane >> 4; float y[4] = {0.f, 0.f, 0.f, 0.f};
              for (int q = 0; q < 64; ++q) { const float2 xv = xs[tt * 65 + q];
#pragma unroll
                  for (int e = 0; e < 4; ++e) { const float2 c = sC[(hg * 4 + e) * 64 + q]; y[e] += c.x * xv.x - c.y * xv.y; } }
              const int row = seq_row(b, dir, blk * 16 + tt);
              f32x4 o = {y[0], y[1], y[2], y[3]}; *(f32x4*)(YS + ((size_t)dir * MROWS + row) * 512 + g * 16 + hg * 4) = o; }
            __syncthreads();
        }
    }
}
template <int LX, int NTT>
__device__ __forceinline__ void hy_naive_item(const Params& p, int l, const float* TP, float* HTb, int c, float* smem) {
    const int tid = otid();
    float* tp = smem; float* vb = tp + 2 * LX; float* zb = vb + 2 * LX;
    const float* cw = p.in[I_HCW] + (size_t)l * 3 * 1536; const float* cb = p.in[I_HCB] + (size_t)l * 1536; const float* hd = p.in[I_HD] + (size_t)l * 2 * 512;
#define SHORTC(dst, chan) do { const float w0 = cw[chan], w1 = cw[1536 + (chan)], w2 = cw[2 * 1536 + (chan)], bb = cb[chan]; \
        for (int i = tid; i < 2 * LX; i += NT) { const int b = i / LX, t = i % LX; const float* s = HTb + ((size_t)(b * 2048 + (chan))) * LX; \
            const float a = (t > 0) ? s[t - 1] : 0.f, m = s[t], n = (t < LX - 1) ? s[t + 1] : 0.f; dst[i] = w0 * a + w1 * m + w2 * n + bb; } } while (0)
    for (int i = tid; i < 2 * LX; i += NT) tp[i] = (i < 2 * LX - 1) ? TP[(size_t)(0 * 512 + c) * (2 * LX) + i] : 0.f;
    SHORTC(vb, c);
    __syncthreads();
    float acc[2][NTT];
#pragma unroll
    for (int e = 0; e < NTT; ++e) { acc[0][e] = 0.f; acc[1][e] = 0.f; }
    for (int s = 0; s < LX; ++s) { const float v0 = vb[s], v1 = vb[LX + s];
#pragma unroll
        for (int e = 0; e < NTT; ++e) { const int t = tid + NT * e; if (t < LX) { const float w = tp[LX - 1 + t - s]; acc[0][e] += w * v0; acc[1][e] += w * v1; } } }
    __syncthreads();
    {
        const int ch = 512 + c; const float w0 = cw[ch], w1 = cw[1536 + ch], w2 = cw[2 * 1536 + ch], bb = cb[ch]; const float d0 = hd[c];
#pragma unroll
        for (int e = 0; e < NTT; ++e) { const int t = tid + NT * e; if (t < LX) {
#pragma unroll
            for (int b = 0; b < 2; ++b) { const float* s = HTb + ((size_t)(b * 2048 + ch)) * LX; const float a = (t > 0) ? s[t - 1] : 0.f, m = s[t], n = (t < LX - 1) ? s[t + 1] : 0.f;
                const float x1 = w0 * a + w1 * m + w2 * n + bb; zb[b * LX + t] = x1 * (acc[b][e] + d0 * vb[b * LX + t]); } } }
    }
    for (int i = tid; i < 2 * LX; i += NT) tp[i] = (i < 2 * LX - 1) ? TP[(size_t)(1 * 512 + c) * (2 * LX) + i] : 0.f;
    __syncthreads();
#pragma unroll
    for (int e = 0; e < NTT; ++e) { acc[0][e] = 0.f; acc[1][e] = 0.f; }
    for (int s = 0; s < LX; ++s) { const float v0 = zb[s], v1 = zb[LX + s];
#pragma unroll
        for (int e = 0; e < NTT; ++e) { const int t = tid + NT * e; if (t < LX) { const float w = tp[LX - 1 + t - s]; acc[0][e] += w * v0; acc[1][e] += w * v1; } } }
    {
        const int ch = 1024 + c; const float w0 = cw[ch], w1 = cw[1536 + ch], w2 = cw[2 * 1536 + ch], bb = cb[ch]; const float d1 = hd[512 + c];
#pragma unroll
        for (int e = 0; e < NTT; ++e) { const int t = tid + NT * e; if (t < LX) {
#pragma unroll
            for (int b = 0; b < 2; ++b) { const float* s = HTb + ((size_t)(b * 2048 + ch)) * LX; const float a = (t > 0) ? s[t - 1] : 0.f, m = s[t], n = (t < LX - 1) ? s[t + 1] : 0.f;
                const float x2 = w0 * a + w1 * m + w2 * n + bb; const float gt = HTb[((size_t)(b * 2048 + 1536 + c)) * LX + t];
                HTb[((size_t)(b * 2048 + c)) * LX + t] = x2 * (acc[b][e] + d1 * zb[b * LX + t]) * silu_f(gt); } } }
    }
    __syncthreads();
#undef SHORTC
}
__device__ __forceinline__ void phase_hy_naive(const Params& p, int l, int bid, int nb, float* smem) {
    float* HT = (float*)(p.ws + WS_HT); float* HTC = HT + (size_t)NB * 2048 * SEQ;
    const float* TPL = (const float*)(p.ws + WS_TP); const float* TPC = TPL + (size_t)2 * 512 * 2 * SEQ;
    for (int it = bid; it < 1024; it += nb) {
        if (it < 512) hy_naive_item<SEQ, 8>(p, l, TPL, HT, it, smem);
        else hy_naive_item<LCX, 1>(p, l, TPC, HTC, it - 512, smem);
    }
}

constexpr int N_POSTT = NB * 8 * (SEQ / 64) + NB * 8 * (LCX / 64);
__device__ __forceinline__ void phase_post(const Params& p, int l, int bid, int nb, float* tile) {
    const int tid = otid(), lane = tid & 63, wave = tid >> 6;
    const float* P = (const float*)(p.ws + WS_P); const float* OG = (const float*)(p.ws + WS_OG); const float* YS = (const float*)(p.ws + WS_YS5);
    bf16_t* YC = (bf16_t*)(p.ws + WS_YCAT); bf16_t* YG = (bf16_t*)(p.ws + WS_YG);
    const float* gn = p.in[I_GNORM] + l * 256; const float* sd = p.in[I_S5D] + l * 512;
    for (int r = bid * 8 + wave; r < MROWS; r += nb * 8) {
        const float* pr = P + (size_t)r * NINP;
#pragma unroll
        for (int hh = 0; hh < 4; ++hh) { const int col = hh * 256 + 4 * lane;
            const f32x4 o = *(const f32x4*)(OG + (size_t)r * 1024 + col) + *(const f32x4*)(OG + ((size_t)MROWS + r) * 1024 + col);
            const float rs = rsqrtf(wave_sum(o[0] * o[0] + o[1] * o[1] + o[2] * o[2] + o[3] * o[3]) * (1.f / 256.f) + EPS);
            const f32x4 w = *(const f32x4*)(gn + 4 * lane), g = *(const f32x4*)(pr + PGG + col);
            uint2 q; q.x = pk2(o[0] * rs * w[0] * silu_f(g[0]), o[1] * rs * w[1] * silu_f(g[1])); q.y = pk2(o[2] * rs * w[2] * silu_f(g[2]), o[3] * rs * w[3] * silu_f(g[3]));
            *(uint2*)(YC + (size_t)r * DM + col) = q; }
#pragma unroll
        for (int e = 0; e < 2; ++e) { const int col = 4 * lane + 256 * e;
            const f32x4 y = *(const f32x4*)(sd + col) * *(const f32x4*)(pr + PU + col) + *(const f32x4*)(YS + (size_t)r * 512 + col) + *(const f32x4*)(YS + ((size_t)MROWS + r) * 512 + col);
            uint2 q; q.x = pk2(gelu_tanh(y[0]), gelu_tanh(y[1])); q.y = pk2(gelu_tanh(y[2]), gelu_tanh(y[3]));
            *(uint2*)(YG + (size_t)r * 512 + col) = q; }
    }
    const float* HT = (const float*)(p.ws + WS_HT); const float* HTC = HT + (size_t)NB * 2048 * SEQ;
    for (int it = bid; it < N_POSTT; it += nb) {
        const float* src; int LX, b, cb, tb, rbase;
        if (it < NB * 8 * (SEQ / 64)) { LX = SEQ; b = it / (8 * 64); const int q = it % (8 * 64); cb = q >> 6; tb = q & 63; src = HT; rbase = b * SEQ; }
        else { const int i2 = it - NB * 8 * (SEQ / 64); LX = LCX; b = i2 / (8 * 4); const int q = i2 % (8 * 4); cb = q >> 2; tb = q & 3; src = HTC; rbase = NLAT + b * LCX; }
#pragma unroll
        for (int j = 0; j < 8; ++j) { const int i = tid + NT * j, cc = i >> 6, tt = i & 63; tile[tt * 65 + cc] = src[((size_t)(b * 2048 + cb * 64 + cc)) * LX + tb * 64 + tt]; }
        __syncthreads();
        { const int tt = tid >> 3, cq = tid & 7; const float* s = tile + tt * 65 + cq * 8;
          uint4 o; o.x = pk2(s[0], s[1]); o.y = pk2(s[2], s[3]); o.z = pk2(s[4], s[5]); o.w = pk2(s[6], s[7]);
          *(uint4*)(YC + (size_t)(rbase + tb * 64 + tt) * DM + 1536 + cb * 64 + cq * 8) = o; }
        __syncthreads();
    }
}

__device__ __forceinline__ void phase_inproj(const Params& p, int l, int bid, int nb, LAS unsigned char* lds) {
    pg8::Gemm g{(const bf16_t*)(p.ws + WS_H), (const bf16_t*)(p.ws + WS_WIN) + (size_t)l * NINP * DM, MROWS, NINP, DM};
    pg8::StaticOrder S; S.init(MROWS, NINP, nb, bid);
    pg8::EpiF32 E{(float*)(p.ws + WS_P), NINP};
    pg8::gemm_phase<pg8::EpiF32, pg8::StaticOrder, true, true>(lds, g, S, E);
}
__device__ __forceinline__ void phase_glu(const Params& p, int l, int bid, int nb, LAS unsigned char* lds) {
    pg8::Gemm g{(const bf16_t*)(p.ws + WS_YG), (const bf16_t*)(p.ws + WS_WGLU) + (size_t)l * 512 * 512, MROWS, 512, 512};
    pg8::StaticOrder S; S.init(MROWS, 512, nb, bid);
    pg8::EpiGlu E{(const bf16_t*)(p.ws + WS_YG), (const float*)(p.ws + WS_P) + PSG, NINP, p.in[I_BGLU] + l * 512, (bf16_t*)(p.ws + WS_YCAT) + 1024, DM};
    pg8::gemm_phase<pg8::EpiGlu, pg8::StaticOrder, true, true>(lds, g, S, E);
}
__device__ __forceinline__ void phase_outproj(const Params& p, int l, int bid, int nb, LAS unsigned char* lds) {
    pg8::Gemm g{(const bf16_t*)(p.ws + WS_YCAT), (const bf16_t*)(p.ws + WS_WOUT) + (size_t)l * DM * DM, MROWS, DM, DM};
    pg8::StaticOrder S; S.init(MROWS, DM, nb, bid);
    pg8::EpiF32 E{(float*)(p.ws + WS_P), DM};
    pg8::gemm_phase<pg8::EpiF32, pg8::StaticOrder, true, true>(lds, g, S, E);
}

constexpr int LDS_BYTES = 147456;
enum { PH_PRO = 0, PH_TAPS, PH_ROW, PH_INPROJ, PH_HYT, PH_MIX, PH_POST, PH_GLU, PH_OUTPROJ };

template <int PH>
__global__ void __launch_bounds__(NT, 2) k_phase(Params p, int l) {
    extern __shared__ __attribute__((aligned(16))) unsigned char lds[];
    float* smem = (float*)lds; const int bid = blockIdx.x, nb = gridDim.x;
    if (PH == PH_PRO) { phase_weights(p, bid, nb, smem); phase_mod(p, bid, nb, smem); }
    if (PH == PH_TAPS) phase_taps(p, l, bid, nb, smem);
    if (PH == PH_ROW) phase_row(p, l, bid, nb);
    if (PH == PH_INPROJ) phase_inproj(p, l, bid, nb, (LAS unsigned char*)lds);
    if (PH == PH_HYT) phase_hyT(p, bid, nb, smem);
    if (PH == PH_MIX) {
        if (bid < 16) phase_gla_naive(p, l, bid, 16, smem);
        else if (bid < 32) phase_s5_naive(p, l, bid - 16, 16, smem);
        else phase_hy_naive(p, l, bid - 32, nb - 32, smem);
    }
    if (PH == PH_POST) phase_post(p, l, bid, nb, smem);
    if (PH == PH_GLU) phase_glu(p, l, bid, nb, (LAS unsigned char*)lds);
    if (PH == PH_OUTPROJ) phase_outproj(p, l, bid, nb, (LAS unsigned char*)lds);
}


namespace cg = cooperative_groups;
__global__ void __launch_bounds__(NT, 2) k_mega(Params p) {
    extern __shared__ __attribute__((aligned(16))) unsigned char lds[];
    cg::grid_group grid = cg::this_grid();
    float* smem = (float*)lds; const int bid = blockIdx.x, nb = gridDim.x;
    phase_weights(p, bid, nb, smem); phase_mod(p, bid, nb, smem); phase_taps(p, 0, bid, nb, smem);
    grid.sync();
#pragma unroll 1
    for (int l0 = 0; l0 < DEPTH; ++l0) {
        int l = l0; asm volatile("" : "+s"(l));
        phase_row(p, l, bid, nb);
        if (l > 0) phase_taps(p, l, bid, nb, smem);
        grid.sync();
        phase_inproj(p, l, bid, nb, (LAS unsigned char*)lds);
        grid.sync();
        phase_hyT(p, bid, nb, smem);
        grid.sync();
        if (bid < 16) phase_gla_naive(p, l, bid, 16, smem);
        else if (bid < 32) phase_s5_naive(p, l, bid - 16, 16, smem);
        else phase_hy_naive(p, l, bid - 32, nb - 32, smem);
        grid.sync();
        phase_post(p, l, bid, nb, smem);
        grid.sync();
        phase_glu(p, l, bid, nb, (LAS unsigned char*)lds);
        grid.sync();
        phase_outproj(p, l, bid, nb, (LAS unsigned char*)lds);
        grid.sync();
    }
    phase_row(p, DEPTH, bid, nb);
}

#ifndef MULTI_LAUNCH
#define MULTI_LAUNCH 0
#endif
template <int PH> static void launch_phase(const Params& p, int l, int grid, hipStream_t stream) {
    static bool attr = false;
    if (!attr) { (void)hipFuncSetAttribute((const void*)k_phase<PH>, hipFuncAttributeMaxDynamicSharedMemorySize, LDS_BYTES); attr = true; }
    hipLaunchKernelGGL(k_phase<PH>, dim3(grid), dim3(NT), LDS_BYTES, stream, p, l);
}

extern "C" void kernel_launch(void* const* d_in, const int* in_sizes, int n_in, void* d_out, int out_size, void* d_ws, size_t ws_size, hipStream_t stream) {
    if (n_in != 33 || out_size != NLAT * DM || ws_size < WS_END) { fprintf(stderr, "kernel_launch: unexpected problem (n_in %d out %d ws %zu need %zu)\n", n_in, out_size, ws_size, (size_t)WS_END); return; }
    Params p{};
    for (int i = 0; i < 33; ++i) p.in[i] = (const float*)d_in[i];
    p.out = (float*)d_out; p.ws = (unsigned char*)d_ws;
#if MULTI_LAUNCH
    const int G = 256;
    launch_phase<PH_PRO>(p, 0, G, stream);
    for (int l = 0; l < DEPTH; ++l) {
        launch_phase<PH_TAPS>(p, l, G, stream);
        launch_phase<PH_ROW>(p, l, G, stream);
        launch_phase<PH_INPROJ>(p, l, G, stream);
        launch_phase<PH_HYT>(p, l, G, stream);
        launch_phase<PH_MIX>(p, l, G, stream);
        launch_phase<PH_POST>(p, l, G, stream);
        launch_phase<PH_GLU>(p, l, G, stream);
        launch_phase<PH_OUTPROJ>(p, l, G, stream);
    }
    launch_phase<PH_ROW>(p, DEPTH, G, stream);
#else
    static int grid_blocks = 0;
    if (!grid_blocks) {
        int dev = 0, cus = 0, per_cu = 0;
        (void)hipGetDevice(&dev);
        (void)hipDeviceGetAttribute(&cus, hipDeviceAttributeMultiprocessorCount, dev);
        (void)hipFuncSetAttribute((const void*)k_mega, hipFuncAttributeMaxDynamicSharedMemorySize, LDS_BYTES);
        (void)hipOccupancyMaxActiveBlocksPerMultiprocessor(&per_cu, (const void*)k_mega, NT, LDS_BYTES);
        if (per_cu < 1) { fprintf(stderr, "kernel_launch: occupancy query says %d blocks per CU\n", per_cu); per_cu = 1; }
        grid_blocks = cus;
        fprintf(stderr, "kernel_launch: cus %d per_cu %d grid %d\n", cus, per_cu, grid_blocks);
    }
    void* args[] = {&p};
    hipError_t e = hipLaunchCooperativeKernel((const void*)k_mega, dim3(grid_blocks), dim3(NT), args, LDS_BYTES, stream);
    if (e != hipSuccess) fprintf(stderr, "cooperative launch failed: %s (grid %d)\n", hipGetErrorString(e), grid_blocks);
#endif
}
```

```cpp
#include <hip/hip_runtime.h>
#include <hip/hip_cooperative_groups.h>
#include <cstdio>
#include <cstdint>
#include <cmath>
namespace pg8 {
#define PG8_LAS __attribute__((address_space(3)))
typedef unsigned short bf16_t;
typedef short bf16x8 __attribute__((ext_vector_type(8)));
typedef float f32x4 __attribute__((ext_vector_type(4)));
typedef unsigned u32x4 __attribute__((ext_vector_type(4)));
constexpr int BM = 256, BK = 64, HALF = 128, HTB = HALF * BK * 2  , STAGE_BYTES = 8 * HTB, NXCD = 8, WGM = 8;

__host__ __device__ __forceinline__ int lds_byte(int r, int c) { const int st = (r >> 4) * 2 + (c >> 5), rr = r & 15, cc = c & 31, ob = rr * 64 + cc * 2; return st * 1024 + (ob ^ (((ob >> 9) & 1) << 5)); }
__host__ __device__ __forceinline__ void stage_rc(int b, int& R, int& C) { const int st = b / 1024, sb = b % 1024, swz = sb ^ (((sb >> 9) & 1) << 5); R = (st >> 1) * 16 + swz / 64; C = (st & 1) * 32 + (swz % 64) / 2; }
__host__ __device__ __forceinline__ int perm32(int rho) { const int n = rho >> 4, i = rho & 15; return 8 * (i >> 2) + 4 * n + (i & 3); }

struct Unit { int pm, pn; };
struct Gemm { const bf16_t* A; const bf16_t* Bt; int M, N, K; };

struct StaticOrder {
    int nM, nN, nwg, G, c;
    __host__ __device__ void init(int M, int N, int G_, int c_) { nM = M / BM; nN = N / BM; nwg = nM * nN; G = G_; c = c_; }
    __host__ __device__ bool next(int i, Unit& u) const {
        const long L = (long)i * G + c; if (L >= nwg) return false;
        int wgid = (int)L; { const int q = nwg / NXCD, r = nwg % NXCD, xcd = wgid % NXCD, off = wgid / NXCD; wgid = (xcd < r ? xcd * (q + 1) : r * (q + 1) + (xcd - r) * q) + off; }
        const int nig = WGM * nN, gid = wgid / nig, fm = gid * WGM, gsz = (nM - fm) < WGM ? (nM - fm) : WGM;
        u.pm = fm + ((wgid % nig) % gsz); u.pn = (wgid % nig) / gsz; return true;
    }
    __device__ __forceinline__ void a_ready(const Unit&) const {}
    __device__ __forceinline__ void done(const Unit&) const {}
};


__device__ __forceinline__ unsigned cvt_pk_bf16(float lo, float hi) { unsigned r; asm volatile("v_cvt_pk_bf16_f32 %0, %1, %2" : "=v"(r) : "v"(lo), "v"(hi)); return r; }
__device__ __forceinline__ float bf2f(unsigned short h) { return __builtin_bit_cast(float, (unsigned)h << 16); }

struct EpiF32 {
    static constexpr bool PERM = false, AFTER_DRAIN = false;
    float* O; int ldc;
    __device__ __forceinline__ void operator()(const f32x4 (&acc)[2][2][4][2], const Unit& u, int wr, int wc, int fr, int fq) const {
        const int row0 = u.pm * BM + wr * 64 + fr, col0 = u.pn * BM + wc * 32 + 4 * fq;
#pragma unroll
        for (int ai = 0; ai < 2; ++ai)
#pragma unroll
            for (int m = 0; m < 4; ++m) { float* rowp = O + (size_t)(row0 + ai * HALF + m * 16) * ldc + col0;
#pragma unroll
                for (int bj = 0; bj < 2; ++bj)
#pragma unroll
                    for (int n = 0; n < 2; ++n) *(f32x4*)(rowp + bj * HALF + n * 16) = acc[ai][bj][m][n]; }
    }
};
struct EpiGlu {
    static constexpr bool PERM = false, AFTER_DRAIN = false;
    const bf16_t* YG; const float* Psg; int ldp; const float* bg; bf16_t* Y; int ldy;
    __device__ __forceinline__ void operator()(const f32x4 (&acc)[2][2][4][2], const Unit& u, int wr, int wc, int fr, int fq) const {
        const int row0 = u.pm * BM + wr * 64 + fr, col0 = u.pn * BM + wc * 32 + 4 * fq;
#pragma unroll
        for (int ai = 0; ai < 2; ++ai)
#pragma unroll
            for (int m = 0; m < 4; ++m) { const size_t row = (size_t)(row0 + ai * HALF + m * 16);
#pragma unroll
                for (int bj = 0; bj < 2; ++bj)
#pragma unroll
                    for (int n = 0; n < 2; ++n) { const int col = col0 + bj * HALF + n * 16;
                        const f32x4 a = acc[ai][bj][m][n]; const f32x4 b = *(const f32x4*)(bg + col); const f32x4 sg = *(const f32x4*)(Psg + row * ldp + col);
                        const uint2 y2 = *(const uint2*)(YG + row * 512 + col);
                        float yv[4] = {bf2f((unsigned short)(y2.x & 0xffff)), bf2f((unsigned short)(y2.x >> 16)), bf2f((unsigned short)(y2.y & 0xffff)), bf2f((unsigned short)(y2.y >> 16))};
                        float o[4];
#pragma unroll
                        for (int e = 0; e < 4; ++e) { const float z = a[e] + b[e]; const float s = 1.f / (1.f + __expf(-z)); const float g = sg[e]; const float sl = g / (1.f + __expf(-g)); o[e] = yv[e] * s * sl; }
                        uint2 w; w.x = cvt_pk_bf16(o[0], o[1]); w.y = cvt_pk_bf16(o[2], o[3]);
                        *(uint2*)(Y + row * ldy + col) = w; } }
    }
};
template <class Epi, class Sched, bool ALIGN_EPI = false, bool SP2 = false>
__device__ __forceinline__ void gemm_phase(PG8_LAS unsigned char* lds, const Gemm g, const Sched& S, const Epi& E) {
    int tid_o = threadIdx.x; asm volatile("" : "+v"(tid_o)); const int tid = tid_o, wid = __builtin_amdgcn_readfirstlane(tid >> 6), lane = tid & 63, wr = wid >> 2, wc = wid & 3, fr = lane & 15, fq = lane >> 4;
    const int K = g.K, nt = K / BK;
    unsigned voffA[2], voffB[2];
#pragma unroll
    for (int i = 0; i < 2; ++i) { int R, C; stage_rc(tid * 16 + i * 8192, R, C); const int Rb = Epi::PERM ? ((R & ~31) + perm32(R & 31)) : R;
        voffA[i] = (unsigned)(R * K + C) * 2u; voffB[i] = (unsigned)(Rb * K + C) * 2u; }
    const size_t kstep = (size_t)(BK * 2);
    const size_t hstep = (size_t)HALF * K * 2;
    const size_t tstep = 2 * hstep;
    const unsigned ldsw = (unsigned)wid * 1024u;
    const int aoff = lds_byte(wr * 64 + fr, fq * 8), boff = lds_byte(wc * 32 + fr, fq * 8);
#define PG8_SA(b, h) (((b) * 2 + (h)) * HTB)
#define PG8_SB(b, h) ((4 + (b) * 2 + (h)) * HTB)
#define PG8_STAGE(bufoff, gbase, voff) do { _Pragma("unroll") for (int _i = 0; _i < 2; ++_i) \
        __builtin_amdgcn_global_load_lds((const unsigned*)((const char*)(gbase) + (voff)[_i]), (PG8_LAS unsigned*)(lds + (bufoff) + ldsw + _i * 8192), 16, 0, 0); } while (0)
#define PG8_LDA(dst, b, h) do { _Pragma("unroll") for (int m = 0; m < 4; ++m) _Pragma("unroll") for (int k = 0; k < 2; ++k) dst[m][k] = *(const PG8_LAS bf16x8*)(lds + PG8_SA(b, h) + aoff + m * 2048 + k * 1024); } while (0)
#define PG8_LDB(dst, b, h) do { _Pragma("unroll") for (int n = 0; n < 2; ++n) _Pragma("unroll") for (int k = 0; k < 2; ++k) dst[n][k] = *(const PG8_LAS bf16x8*)(lds + PG8_SB(b, h) + boff + n * 2048 + k * 1024); } while (0)
#define PG8_MMA(ai, bj, At, Bt) do { __builtin_amdgcn_s_setprio(1); _Pragma("unroll") for (int m = 0; m < 4; ++m) _Pragma("unroll") for (int n = 0; n < 2; ++n) _Pragma("unroll") for (int k = 0; k < 2; ++k) \
        acc[ai][bj][m][n] = __builtin_amdgcn_mfma_f32_16x16x32_bf16(Bt[n][k], At[m][k], acc[ai][bj][m][n], 0, 0, 0); __builtin_amdgcn_s_setprio(0); } while (0)
#define PG8_WAIT_V(n) asm volatile("s_waitcnt vmcnt(" #n ")" ::: "memory")
#define PG8_WAIT_L(n) asm volatile("s_waitcnt lgkmcnt(" #n ")" ::: "memory")
#define PG8_BAR __builtin_amdgcn_s_barrier()
#define PG8_SCHED __builtin_amdgcn_sched_barrier(0)
    Unit cur, nxt; int ui = 0;
    if (!S.next(0, cur)) return;
    f32x4 acc[2][2][4][2];
#pragma unroll
    for (int a = 0; a < 2; ++a)
#pragma unroll
        for (int b = 0; b < 2; ++b)
#pragma unroll
            for (int m = 0; m < 4; ++m)
#pragma unroll
                for (int n = 0; n < 2; ++n) acc[a][b][m][n] = (f32x4){0.f, 0.f, 0.f, 0.f};
    bf16x8 At[4][2], B0[2][2], B1[2][2];
    const char* cA = (const char*)g.A + (size_t)cur.pm * tstep; const char* cB = (const char*)g.Bt + (size_t)cur.pn * tstep;
    S.a_ready(cur);
    if constexpr (SP2) {
        PG8_STAGE(PG8_SB(0, 0), cB, voffB); PG8_STAGE(PG8_SB(0, 1), cB + hstep, voffB); PG8_STAGE(PG8_SA(0, 0), cA, voffA); PG8_STAGE(PG8_SA(0, 1), cA + hstep, voffA);
        if (wr == 1) PG8_BAR;
        PG8_WAIT_V(2); PG8_BAR;
        PG8_STAGE(PG8_SB(1, 0), cB + kstep, voffB); PG8_STAGE(PG8_SA(1, 0), cA + kstep, voffA); PG8_STAGE(PG8_SB(1, 1), cB + hstep + kstep, voffB);
        PG8_WAIT_V(6); PG8_BAR;
    } else {
        PG8_STAGE(PG8_SB(0, 0), cB, voffB); PG8_STAGE(PG8_SA(0, 0), cA, voffA); PG8_STAGE(PG8_SB(0, 1), cB + hstep, voffB); PG8_STAGE(PG8_SA(0, 1), cA + hstep, voffA);
        if (wr == 1) PG8_BAR;
        PG8_WAIT_V(4); PG8_BAR;
        PG8_STAGE(PG8_SB(1, 0), cB + kstep, voffB); PG8_STAGE(PG8_SA(1, 0), cA + kstep, voffA); PG8_STAGE(PG8_SB(1, 1), cB + hstep + kstep, voffB);
        PG8_WAIT_V(6); PG8_BAR;
    }
    for (;;) {
        const bool has_next = S.next(ui + 1, nxt);
        const char* nA = has_next ? (const char*)g.A + (size_t)nxt.pm * tstep : cA; const char* nB = has_next ? (const char*)g.Bt + (size_t)nxt.pn * tstep : cB;
        for (int t = 0; t < nt; t += 2) {
            const bool last = (t == nt - 2);
            const char* a1 = cA + (size_t)(t + 1) * kstep;
            const char* a2 = last ? nA : cA + (size_t)(t + 2) * kstep; const char* b2 = last ? nB : cB + (size_t)(t + 2) * kstep;
            const char* a3 = a2 + kstep; const char* b3 = b2 + kstep;
            if (last && has_next) S.a_ready(nxt);
            if constexpr (SP2) {
            PG8_LDB(B0, 0, 0); PG8_LDB(B1, 0, 1); PG8_SCHED; PG8_LDA(At, 0, 0); PG8_STAGE(PG8_SA(1, 1), a1 + hstep, voffA);
            PG8_WAIT_V(8); PG8_WAIT_L(0); PG8_BAR; PG8_MMA(0, 0, At, B0); PG8_MMA(0, 1, At, B1); PG8_BAR; PG8_SCHED;
            PG8_LDA(At, 0, 1); PG8_STAGE(PG8_SB(0, 0), b2, voffB); PG8_STAGE(PG8_SB(0, 1), b2 + hstep, voffB); PG8_STAGE(PG8_SA(0, 0), a2, voffA);
            PG8_WAIT_V(8); PG8_WAIT_L(0); PG8_BAR; PG8_MMA(1, 0, At, B0); PG8_MMA(1, 1, At, B1); PG8_BAR; PG8_SCHED;
            PG8_LDB(B0, 1, 0); PG8_LDB(B1, 1, 1); PG8_SCHED; PG8_LDA(At, 1, 0); PG8_STAGE(PG8_SA(0, 1), a2 + hstep, voffA);
            PG8_WAIT_V(8); PG8_WAIT_L(0); PG8_BAR; PG8_MMA(0, 0, At, B0); PG8_MMA(0, 1, At, B1); PG8_BAR; PG8_SCHED;
            PG8_LDA(At, 1, 1); PG8_STAGE(PG8_SB(1, 0), b3, voffB); PG8_STAGE(PG8_SB(1, 1), b3 + hstep, voffB); PG8_STAGE(PG8_SA(1, 0), a3, voffA);
            PG8_WAIT_V(8); PG8_WAIT_L(0); PG8_BAR; PG8_MMA(1, 0, At, B0); PG8_MMA(1, 1, At, B1); PG8_BAR; PG8_SCHED;
            } else {
            PG8_LDB(B0, 0, 0); PG8_SCHED; PG8_LDA(At, 0, 0); PG8_STAGE(PG8_SA(1, 1), a1 + hstep, voffA);
            PG8_WAIT_L(8); PG8_BAR; PG8_WAIT_L(0); PG8_MMA(0, 0, At, B0); PG8_BAR; PG8_SCHED;
            PG8_LDB(B1, 0, 1); PG8_STAGE(PG8_SB(0, 0), b2, voffB);
            PG8_BAR; PG8_WAIT_L(0); PG8_MMA(0, 1, At, B1); PG8_BAR;
            PG8_LDA(At, 0, 1); PG8_STAGE(PG8_SA(0, 0), a2, voffA);
            PG8_BAR; PG8_WAIT_L(0); PG8_MMA(1, 0, At, B0); PG8_BAR; PG8_SCHED;
            PG8_STAGE(PG8_SB(0, 1), b2 + hstep, voffB);
            PG8_WAIT_V(6); PG8_BAR; PG8_MMA(1, 1, At, B1); PG8_BAR;
            PG8_LDB(B0, 1, 0); PG8_SCHED; PG8_LDA(At, 1, 0); PG8_STAGE(PG8_SA(0, 1), a2 + hstep, voffA);
            PG8_WAIT_L(8); PG8_BAR; PG8_WAIT_L(0); PG8_MMA(0, 0, At, B0); PG8_BAR; PG8_SCHED;
            PG8_LDB(B1, 1, 1); PG8_STAGE(PG8_SB(1, 0), b3, voffB);
            PG8_BAR; PG8_WAIT_L(0); PG8_MMA(0, 1, At, B1); PG8_BAR;
            PG8_LDA(At, 1, 1); PG8_STAGE(PG8_SA(1, 0), a3, voffA);
            PG8_BAR; PG8_WAIT_L(0); PG8_MMA(1, 0, At, B0); PG8_BAR; PG8_SCHED;
            PG8_STAGE(PG8_SB(1, 1), b3 + hstep, voffB);
            PG8_WAIT_V(6); PG8_BAR; PG8_MMA(1, 1, At, B1); PG8_BAR;
            }
        }
        if constexpr (ALIGN_EPI) { if (wr == 0) PG8_BAR; }
        if constexpr (!Epi::AFTER_DRAIN) { E(acc, cur, wr, wc, fr, fq); S.done(cur); }
        if (!has_next) break;
#pragma unroll
        for (int a = 0; a < 2; ++a)
#pragma unroll
            for (int b = 0; b < 2; ++b)
#pragma unroll
                for (int m = 0; m < 4; ++m)
#pragma unroll
                    for (int n = 0; n < 2; ++n) acc[a][b][m][n] = (f32x4){0.f, 0.f, 0.f, 0.f};
        cur = nxt; cA = nA; cB = nB; ++ui;
        if constexpr (ALIGN_EPI) { if (wr == 1) PG8_BAR; }
    }
    PG8_WAIT_V(0);
    if constexpr (!ALIGN_EPI) { if (wr == 0) PG8_BAR; }
    PG8_BAR;
    if constexpr (Epi::AFTER_DRAIN) { E.fused(acc, cur, wr, wc, fr, fq, lds, wid, lane); S.done(cur); }
#undef PG8_SA
#undef PG8_SB
#undef PG8_STAGE
#undef PG8_LDA
#undef PG8_LDB
#undef PG8_MMA
#undef PG8_WAIT_V
#undef PG8_WAIT_L
#undef PG8_BAR
#undef PG8_SCHED
}
}

using pg8::bf16_t; using pg8::f32x4;
#define LAS __attribute__((address_space(3)))
constexpr int DM = 2048, NB = 2, SEQ = 4096, LCX = 256, DEPTH = 4;
constexpr int NLAT = NB * SEQ;
constexpr int MROWS = NLAT + NB * LCX;
constexpr int NIN = 6176, NINP = 6400;
constexpr int PQ = 0, PK = 512, PV = 1024, PU = 2048, PGG = 2560, PSG = 3584, PHV = 4096, PHG = 5632, PLR = 6144;
constexpr float EPS = 1e-6f;
constexpr int NT = 512;

__host__ __device__ __forceinline__ int in_col_map(int n) {
    if (n < 2048) return n;
    if (n < 6144) return n + 32;
    if (n < 6176) return n - 4096;
    return -1;
}

constexpr size_t al256(size_t x) { return (x + 255) & ~(size_t)255; }
constexpr size_t WS_WIN  = 0;
constexpr size_t WS_WOUT = WS_WIN  + al256((size_t)DEPTH * NINP * DM * 2);
constexpr size_t WS_WGLU = WS_WOUT + al256((size_t)DEPTH * DM * DM * 2);
constexpr size_t WS_MOD  = WS_WGLU + al256((size_t)DEPTH * 512 * 512 * 2);
constexpr size_t WS_H    = WS_MOD  + al256((size_t)DEPTH * 3 * 6144 * 4);
constexpr size_t WS_YCAT = WS_H    + al256((size_t)MROWS * DM * 2);
constexpr size_t WS_P    = WS_YCAT + al256((size_t)MROWS * DM * 2);
constexpr size_t WS_HS   = WS_H;
static_assert((size_t)2 * 512 * 8192 * 8 <= 2 * al256((size_t)MROWS * DM * 2), "spectra alias");
constexpr size_t WS_XC   = WS_P    + al256((size_t)MROWS * NINP * 4);
constexpr size_t WS_OG   = WS_XC   + al256((size_t)NB * LCX * DM * 4);
constexpr size_t WS_YS5  = WS_OG   + al256((size_t)2 * MROWS * 1024 * 4);
constexpr size_t WS_YG   = WS_YS5  + al256((size_t)2 * MROWS * 512 * 4);
constexpr size_t WS_HT   = WS_YG   + al256((size_t)MROWS * 512 * 2);
constexpr size_t WS_TP   = WS_HT   + al256((size_t)MROWS * 2048 * 4);
constexpr size_t WS_GLA  = WS_TP   + al256((size_t)2 * 512 * 2 * SEQ * 4) + al256((size_t)2 * 512 * 2 * LCX * 4);
constexpr size_t WS_END  = WS_GLA  + al256((size_t)80 * 1024 * 1024);

struct Params {
    const float* in[33];
    float* out;
    unsigned char* ws;
};
enum { I_X = 0, I_C, I_CTX, I_CCTX, I_WMOD, I_BMOD, I_GPRE, I_GPOST, I_WIN, I_WOUT, I_GWG, I_GBG, I_GNORM,
       I_LRE, I_LIM, I_LSTEP, I_BRE, I_BIM, I_CRE, I_CIM, I_S5D, I_WGLU, I_BGLU, I_HCW, I_HCB, I_HW1, I_HB1, I_HF1, I_HW2, I_HB2, I_HF2, I_HW3, I_HD };

__device__ __forceinline__ float wave_sum(float v) {
#pragma unroll
    for (int o = 1; o < 64; o <<= 1) v += __shfl_xor(v, o);
    return v;
}
__device__ __forceinline__ float silu_f(float x) { return x / (1.f + expf(-x)); }
__device__ __forceinline__ float gelu_tanh(float x) { const float u = 0.7978845608028654f * (x + 0.044715f * x * x * x); return 0.5f * x * (1.f + tanhf(u)); }
__device__ __forceinline__ unsigned pk2(float lo, float hi) { return pg8::cvt_pk_bf16(lo, hi); }
__device__ __forceinline__ int otid() { int t = threadIdx.x; asm volatile("" : "+v"(t)); return t; }
__device__ __forceinline__ int permtok(int t) { return ((t & 63) << 6) | (t >> 6); }

template <bool MAPIN>
__device__ __forceinline__ void transpose_item(const float* __restrict__ W, int ldw, int K, bf16_t* __restrict__ WT, int k0, int n0, float* tile) {
    const int tid = otid();
#pragma unroll
    for (int j = 0; j < 8; ++j) { const int i = tid + NT * j, kk = i >> 6, nn = i & 63; int oc = n0 + nn; if (MAPIN) oc = in_col_map(oc);
        tile[kk * 65 + nn] = (oc >= 0) ? W[(size_t)(k0 + kk) * ldw + oc] : 0.f; }
    __syncthreads();
    { const int n = tid >> 3, kc = tid & 7; const float* s = tile + (kc * 8) * 65 + n;
      uint4 o; o.x = pk2(s[0], s[65]); o.y = pk2(s[2 * 65], s[3 * 65]); o.z = pk2(s[4 * 65], s[5 * 65]); o.w = pk2(s[6 * 65], s[7 * 65]);
      *(uint4*)(WT + (size_t)(n0 + n) * K + k0 + kc * 8) = o; }
    __syncthreads();
}
constexpr int TI_IN = (DM / 64) * (NINP / 64), TI_OUT = (DM / 64) * (DM / 64), TI_GLU = 8 * 8;
constexpr int N_TITEMS = DEPTH * (TI_IN + TI_OUT + TI_GLU);
__device__ __forceinline__ void phase_weights(const Params& p, int bid, int nb, float* smem) {
    for (int it = bid; it < N_TITEMS; it += nb) {
        int r = it;
        if (r < DEPTH * TI_IN) { const int l = r / TI_IN, q = r % TI_IN, kb = q / (NINP / 64), nbk = q % (NINP / 64);
            transpose_item<true>(p.in[I_WIN] + (size_t)l * DM * NIN, NIN, DM, (bf16_t*)(p.ws + WS_WIN) + (size_t)l * NINP * DM, kb * 64, nbk * 64, smem); continue; }
        r -= DEPTH * TI_IN;
        if (r < DEPTH * TI_OUT) { const int l = r / TI_OUT, q = r % TI_OUT, kb = q / 32, nbk = q % 32;
            transpose_item<false>(p.in[I_WOUT] + (size_t)l * DM * DM, DM, DM, (bf16_t*)(p.ws + WS_WOUT) + (size_t)l * DM * DM, kb * 64, nbk * 64, smem); continue; }
        r -= DEPTH * TI_OUT;
        { const int l = r / TI_GLU, q = r % TI_GLU, kb = q / 8, nbk = q % 8;
            transpose_item<false>(p.in[I_WGLU] + (size_t)l * 512 * 512, 512, 512, (bf16_t*)(p.ws + WS_WGLU) + (size_t)l * 512 * 512, kb * 64, nbk * 64, smem); }
    }
}
constexpr int N_MODITEMS = DEPTH * (6144 / 64);
__device__ __forceinline__ void phase_mod(const Params& p, int bid, int nb, float* smem) {
    const int tid = otid(); float* sv = smem;   float* red = smem + 3 * 2048;
    bool loaded = false;
    for (int it = bid; it < N_MODITEMS; it += nb) {
        if (!loaded) { for (int i = tid; i < 3 * 2048; i += NT) { const int r = i >> 11, k = i & 2047; const float c = (r < 2) ? p.in[I_C][r * 2048 + k] : p.in[I_CCTX][k]; sv[i] = silu_f(c); } loaded = true; }
        __syncthreads();
        const int l = it / 96, jb = it % 96, cl = tid & 15, kg = tid >> 4;
        const float* w = p.in[I_WMOD] + (size_t)l * DM * 6144 + jb * 64 + cl * 4;
        f32x4 a0 = {0, 0, 0, 0}, a1 = a0, a2 = a0;
#pragma unroll 4
        for (int kk = 0; kk < 64; ++kk) { const int k = kg * 64 + kk; const f32x4 wv = *(const f32x4*)(w + (size_t)k * 6144);
            a0 += wv * sv[k]; a1 += wv * sv[2048 + k]; a2 += wv * sv[4096 + k]; }
        *(f32x4*)(red + (kg * 3 + 0) * 64 + cl * 4) = a0; *(f32x4*)(red + (kg * 3 + 1) * 64 + cl * 4) = a1; *(f32x4*)(red + (kg * 3 + 2) * 64 + cl * 4) = a2;
        __syncthreads();
        if (tid < 192) { const int r = tid >> 6, c = tid & 63; float s = p.in[I_BMOD][l * 6144 + jb * 64 + c];
            for (int g = 0; g < 32; ++g) s += red[(g * 3 + r) * 64 + c];
            ((float*)(p.ws + WS_MOD))[(size_t)(l * 3 + r) * 6144 + jb * 64 + c] = s; }
        __syncthreads();
    }
}
__device__ __forceinline__ void taps_item(const Params& p, int l, int LX, float* TP, int tb, int cb, float* smem) {
    const int tid = otid();
    float* feats = smem;
    float* h1 = feats + 64 * 33;
    float* h2 = h1 + 64 * 64;
    float* T = h2 + 64 * 64;
    const float* w1 = p.in[I_HW1] + l * 33 * 64; const float* b1 = p.in[I_HB1] + l * 64; const float* f1 = p.in[I_HF1] + l * 64;
    const float* w2 = p.in[I_HW2] + l * 64 * 64; const float* b2 = p.in[I_HB2] + l * 64; const float* f2 = p.in[I_HF2] + l * 64;
    const float* w3 = p.in[I_HW3] + (size_t)l * 64 * 2048;
#pragma unroll 1
    for (int i = tid; i < 64 * 33; i += NT) { const int tt = i / 33, f = i % 33; const int tau = tb * 64 + tt;
        const float ang = (6.283185307179586f / (float)LX) * (float)tau; float v;
        if (f == 0) v = (float)tau / (float)(LX - 1);
        else { const int bi = (f - 1) & 15; const float band = 1e-4f + (float)bi * ((15.0f - 1e-4f) / 15.0f); const float a = band * ang; v = (f <= 16) ? cosf(a) : -sinf(a); }
        feats[i] = v; }
    __syncthreads();
#pragma unroll 1
    for (int i = tid; i < 64 * 64; i += NT) { const int tt = i >> 6, j = i & 63; float s = b1[j];
#pragma unroll 3
        for (int f = 0; f < 33; ++f) s += feats[tt * 33 + f] * w1[f * 64 + j];
        h1[i] = sinf(f1[j] * s); }
    __syncthreads();
#pragma unroll 1
    for (int i = tid; i < 64 * 64; i += NT) { const int tt = i >> 6, j = i & 63; float s = b2[j];
#pragma unroll 4
        for (int f = 0; f < 64; ++f) s += h1[tt * 64 + f] * w2[f * 64 + j];
        h2[i] = sinf(f2[j] * s); }
    __syncthreads();
    { const int cc = tid & 255, th = tid >> 8, col = cb * 256 + cc; float acc[32];
#pragma unroll
      for (int e = 0; e < 32; ++e) acc[e] = 0.f;
#pragma unroll 1
      for (int i = 0; i < 64; ++i) { const float w = w3[(size_t)i * 2048 + col];
#pragma unroll
          for (int e = 0; e < 32; ++e) acc[e] += w * h2[(th * 32 + e) * 64 + i]; }
      const int c = col & 511; const float delta = fabsf(-15.350567286626973f + (float)c * ((-3.0701134573253945f + 15.350567286626973f) / 511.0f));
#pragma unroll
      for (int e = 0; e < 32; ++e) { const int tau = tb * 64 + th * 32 + e; const float tl = (float)tau / (float)(LX - 1); T[cc * 65 + th * 32 + e] = acc[e] * expf(-tl * delta); } }
    __syncthreads();
    { const int tt = tid & 63, cg = tid >> 6; const int tau = tb * 64 + tt;
#pragma unroll 2
      for (int q = 0; q < 32; ++q) { const int cc = cg * 32 + q, col = cb * 256 + cc; const int o = col >> 10, dir = (col >> 9) & 1, c = col & 511;
          float* dst = TP + (size_t)(o * 512 + c) * (2 * LX);
          if (dir == 0) dst[LX - 1 + tau] = T[cc * 65 + tt];
          else if (tau >= 1) dst[LX - 1 - tau] = T[cc * 65 + tt]; } }
    __syncthreads();
}
constexpr int N_TAPITEMS = (SEQ / 64) * 8 + (LCX / 64) * 8;
__device__ __forceinline__ void phase_taps(const Params& p, int l, int bid, int nb, float* smem) {
    float* TPL = (float*)(p.ws + WS_TP); float* TPC = TPL + (size_t)2 * 512 * 2 * SEQ;
    for (int it = bid; it < N_TAPITEMS; it += nb) {
        if (it < (SEQ / 64) * 8) taps_item(p, l, SEQ, TPL, it >> 3, it & 7, smem);
        else { const int q = it - (SEQ / 64) * 8; taps_item(p, l, LCX, TPC, q >> 3, q & 7, smem); }
    }
}

__device__ __forceinline__ void phase_row(const Params& p, int l, int bid, int nb) {
    const int tid_ = otid(); const int lane = tid_ & 63, wave = tid_ >> 6;
    const float* MOD = (const float*)(p.ws + WS_MOD); const float* R = (const float*)(p.ws + WS_P);
    float* XC = (float*)(p.ws + WS_XC); bf16_t* H = (bf16_t*)(p.ws + WS_H);
    const int nrows = (l == DEPTH) ? NLAT : MROWS;
    for (int r = bid * 8 + wave; r < nrows; r += nb * 8) {
        const bool lat = r < NLAT; const int b = lat ? (r >> 12) : 0, t = r & 4095, rb = lat ? b : 2;
        const float* xin; float* xout;
        if (lat) { xin = ((l <= 1) ? p.in[I_X] : p.out) + (size_t)r * DM; xout = p.out + (size_t)r * DM; }
        else { xin = ((l <= 1) ? p.in[I_CTX] : XC) + (size_t)(r - NLAT) * DM; xout = XC + (size_t)(r - NLAT) * DM; }
        f32x4 x[8];
#pragma unroll
        for (int j = 0; j < 8; ++j) x[j] = *(const f32x4*)(xin + 4 * lane + 256 * j);
        if (l > 0) {
            const int lp = l - 1; const int rr = (lat && (lp & 1)) ? (b * SEQ + permtok(t)) : r;
            const float* Rr = R + (size_t)rr * DM; f32x4 v[8]; float ss = 0.f;
#pragma unroll
            for (int j = 0; j < 8; ++j) { v[j] = *(const f32x4*)(Rr + 4 * lane + 256 * j); ss += v[j][0] * v[j][0] + v[j][1] * v[j][1] + v[j][2] * v[j][2] + v[j][3] * v[j][3]; }
            const float rs = rsqrtf(wave_sum(ss) * (1.f / DM) + EPS);
            const float* gate = MOD + (size_t)(lp * 3 + rb) * 6144 + 4096; const float* gp = p.in[I_GPOST] + lp * DM;
#pragma unroll
            for (int j = 0; j < 8; ++j) { const f32x4 g = *(const f32x4*)(gate + 4 * lane + 256 * j), w = *(const f32x4*)(gp + 4 * lane + 256 * j);
                x[j] = x[j] + g * (v[j] * rs * w); *(f32x4*)(xout + 4 * lane + 256 * j) = x[j]; }
        }
        if (l < DEPTH) {
            float ss = 0.f;
#pragma unroll
            for (int j = 0; j < 8; ++j) ss += x[j][0] * x[j][0] + x[j][1] * x[j][1] + x[j][2] * x[j][2] + x[j][3] * x[j][3];
            const float rs = rsqrtf(wave_sum(ss) * (1.f / DM) + EPS);
            const float* shift = MOD + (size_t)(l * 3 + rb) * 6144; const float* scale = shift + 2048; const float* gp = p.in[I_GPRE] + l * DM;
            const int hr = (lat && (l & 1)) ? (b * SEQ + permtok(t)) : r;
            bf16_t* hrow = H + (size_t)hr * DM;
#pragma unroll
            for (int j = 0; j < 8; ++j) { const f32x4 sh = *(const f32x4*)(shift + 4 * lane + 256 * j), sc = *(const f32x4*)(scale + 4 * lane + 256 * j), w = *(const f32x4*)(gp + 4 * lane + 256 * j);
                const f32x4 y = (x[j] * rs * w) * (sc + 1.f) + sh; uint2 o; o.x = pk2(y[0], y[1]); o.y = pk2(y[2], y[3]);
                *(uint2*)(hrow + 4 * lane + 256 * j) = o; }
        }
    }
}

constexpr int N_HTITEMS = (MROWS / 64) * 32;
__device__ __forceinline__ void phase_hyT(const Params& p, int bid, int nb, float* tile) {
    const int tid = otid(); const float* P = (const float*)(p.ws + WS_P); float* HT = (float*)(p.ws + WS_HT); float* HTC = HT + (size_t)NB * 2048 * SEQ;
    for (int it = bid; it < N_HTITEMS; it += nb) {
        const int rb = it >> 5, cb = it & 31, r0 = rb * 64, c0 = cb * 64;
#pragma unroll
        for (int j = 0; j < 8; ++j) { const int i = tid + NT * j, rr = i >> 6, cc = i & 63; tile[cc * 65 + rr] = P[(size_t)(r0 + rr) * NINP + PHV + c0 + cc]; }
        __syncthreads();
        { const int cc = tid >> 3, tq = tid & 7; const float* s = tile + cc * 65 + tq * 8; float* dst;
          if (r0 < NLAT) { const int b = r0 >> 12, t0 = r0 & 4095; dst = HT + ((size_t)(b * 2048 + c0 + cc)) * SEQ + t0 + tq * 8; }
          else { const int q = r0 - NLAT, b = q >> 8, t0 = q & 255; dst = HTC + ((size_t)(b * 2048 + c0 + cc)) * LCX + t0 + tq * 8; }
          f32x4 a = {s[0], s[1], s[2], s[3]}, bq = {s[4], s[5], s[6], s[7]}; *(f32x4*)dst = a; *(f32x4*)(dst + 4) = bq; }
        __syncthreads();
    }
}

__device__ __forceinline__ int seq_row(int b, int dir, int n) {
    if (n < LCX) { const int tc = dir ? (LCX - 1 - n) : n; return NLAT + b * LCX + tc; }
    const int m = n - LCX; const int t = dir ? (SEQ - 1 - m) : m; return b * SEQ + t;
}
__device__ __forceinline__ void phase_gla_naive(const Params& p, int l, int bid, int nb, float* smem) {
    const int tid = otid(); const float* P = (const float*)(p.ws + WS_P); float* OG = (float*)(p.ws + WS_OG);
    float* sq = smem; float* sk = sq + 8 * 128; float* se = sk + 8 * 128; float* sv = se + 8 * 128; float* so = sv + 8 * 256;
    for (int it = bid; it < 16; it += nb) {
        const int b = it >> 3, dir = (it >> 2) & 1, h = it & 3;
        const int j = tid & 255, half = tid >> 8, kk0 = tid & 127;
        float* swg = so + 16 * 256;
        for (int i = tid; i < 16 * 128; i += NT) swg[i] = p.in[I_GWG][((size_t)(l * 2 + dir) * 16 + (i >> 7)) * 512 + h * 128 + (i & 127)];
        __syncthreads();
        const float bgk = p.in[I_GBG][(l * 2 + dir) * 512 + h * 128 + kk0];
        float S[64];
#pragma unroll
        for (int k = 0; k < 64; ++k) S[k] = 0.f;
        for (int sb = 0; sb < (SEQ + LCX) / 8; ++sb) {
#pragma unroll
            for (int e = 0; e < 2; ++e) { const int i = (tid >> 7) + 4 * e; const int row = seq_row(b, dir, sb * 8 + i); const float* pr = P + (size_t)row * NINP;
                float z = bgk;
#pragma unroll
                for (int r = 0; r < 16; ++r) z += pr[PLR + dir * 16 + r] * swg[r * 128 + kk0];
                const float ls = fminf(z, 0.f) - log1pf(expf(-fabsf(z)));
                sq[i * 128 + kk0] = pr[PQ + h * 128 + kk0] * 0.08838834764831845f; sk[i * 128 + kk0] = pr[PK + h * 128 + kk0]; se[i * 128 + kk0] = expf(ls * (1.f / 16.f)); }
#pragma unroll
            for (int e = 0; e < 4; ++e) { const int idx = tid + NT * e, i = idx >> 8, jj = idx & 255; const int row = seq_row(b, dir, sb * 8 + i); sv[i * 256 + jj] = P[(size_t)row * NINP + PV + h * 256 + jj]; }
            __syncthreads();
#pragma unroll 1
            for (int i = 0; i < 8; ++i) { const float vj = sv[i * 256 + j]; float o = 0.f;
                const f32x4* q4 = (const f32x4*)(sq + i * 128 + half * 64); const f32x4* k4 = (const f32x4*)(sk + i * 128 + half * 64); const f32x4* e4 = (const f32x4*)(se + i * 128 + half * 64);
#pragma unroll
                for (int k = 0; k < 16; ++k) { const f32x4 qv = q4[k], kv = k4[k], ev = e4[k];
#pragma unroll
                    for (int c = 0; c < 4; ++c) { float s = S[4 * k + c] * ev[c]; if (dir == 0) { s += kv[c] * vj; o += qv[c] * s; } else { o += qv[c] * s; s += kv[c] * vj; } S[4 * k + c] = s; } }
                so[(half * 8 + i) * 256 + j] = o; }
            __syncthreads();
            for (int e = tid; e < 8 * 256; e += NT) { const int i = e >> 8, jj = e & 255; const int row = seq_row(b, dir, sb * 8 + i);
                OG[((size_t)dir * MROWS + row) * 1024 + h * 256 + jj] = so[i * 256 + jj] + so[(8 + i) * 256 + jj]; }
            __syncthreads();
        }
    }
}
__device__ __forceinline__ void phase_s5_naive(const Params& p, int l, int bid, int nb, float* smem) {
    const int tid = otid(), lane = tid & 63, wave = tid >> 6; const float* P = (const float*)(p.ws + WS_P); float* YS = (float*)(p.ws + WS_YS5);
    float2* sC = (float2*)smem + wave * (16 * 64);
    float2* xs = (float2*)smem + 8 * 16 * 64 + wave * (16 * 65);
    for (int wb = bid; wb < 16; wb += nb) {
        const int gw = wb * 8 + wave, b = gw >> 6, dir = (gw >> 5) & 1, g = gw & 31;
        const size_t pg = ((size_t)(l * 2 + dir) * 32 + g);
        const float lr = p.in[I_LRE][pg * 64 + lane], li = p.in[I_LIM][pg * 64 + lane], step = expf(p.in[I_LSTEP][pg]);
        const float em1 = expm1f(lr * step); float sn, cs; sincosf(li * step, &sn, &cs); const float shf = sinf(0.5f * li * step);
        const float lbr = (em1 + 1.f) * cs, lbi = (em1 + 1.f) * sn;
        const float den = lr * lr + li * li, nr = em1 * cs - 2.f * shf * shf, ni = lbi;
        const float cr = (nr * lr + ni * li) / den, ci = (ni * lr - nr * li) / den;
        float Br[16], Bi[16];
#pragma unroll
        for (int hh = 0; hh < 16; ++hh) { const float br = p.in[I_BRE][(pg * 64 + lane) * 16 + hh], bi = p.in[I_BIM][(pg * 64 + lane) * 16 + hh]; Br[hh] = cr * br - ci * bi; Bi[hh] = cr * bi + ci * br; }
        for (int i = lane; i < 16 * 64; i += 64) sC[i] = make_float2(p.in[I_CRE][pg * 1024 + i], p.in[I_CIM][pg * 1024 + i]);
        float xr = 0.f, xi = 0.f;
        for (int blk = 0; blk < (SEQ + LCX) / 16; ++blk) {
            for (int i = 0; i < 16; ++i) { const int row = seq_row(b, dir, blk * 16 + i); const float* u = P + (size_t)row * NINP + PU + g * 16;
                float bur = 0.f, bui = 0.f;
#pragma unroll
                for (int q = 0; q < 4; ++q) { const f32x4 uv = *(const f32x4*)(u + 4 * q);
#pragma unroll
                    for (int c = 0; c < 4; ++c) { bur += Br[4 * q + c] * uv[c]; bui += Bi[4 * q + c] * uv[c]; } }
                const float nxr = lbr * xr - lbi * xi + bur, nxi = lbr * xi + lbi * xr + bui; xr = nxr; xi = nxi;
                xs[i * 65 + lane] = make_float2(xr, xi); }
            __syncthreads();
            { const int tt = lane & 15, hg = lane >> 4; float y[4] = {0.f, 0.f, 0.f, 0.f};
              for (int q = 0; q < 64; ++q) { const float2 xv = xs[tt * 65 + q];
#pragma unroll
                  for (int e = 0; e < 4; ++e) { const float2 c = sC[(hg * 4 + e) * 64 + q]; y[e] += c.x * xv.x - c.y * xv.y; } }
              const int row = seq_row(b, dir, blk * 16 + tt);
              f32x4 o = {y[0], y[1], y[2], y[3]}; *(f32x4*)(YS + ((size_t)dir * MROWS + row) * 512 + g * 16 + hg * 4) = o; }
            __syncthreads();
        }
    }
}
template <int LX, int NTT>
__device__ __forceinline__ void hy_naive_item(const Params& p, int l, const float* TP, float* HTb, int c, float* smem) {
    const int tid = otid();
    float* tp = smem; float* vb = tp + 2 * LX; float* zb = vb + 2 * LX;
    const float* cw = p.in[I_HCW] + (size_t)l * 3 * 1536; const float* cb = p.in[I_HCB] + (size_t)l * 1536; const float* hd = p.in[I_HD] + (size_t)l * 2 * 512;
#define SHORTC(dst, chan) do { const float w0 = cw[chan], w1 = cw[1536 + (chan)], w2 = cw[2 * 1536 + (chan)], bb = cb[chan]; \
        for (int i = tid; i < 2 * LX; i += NT) { const int b = i / LX, t = i % LX; const float* s = HTb + ((size_t)(b * 2048 + (chan))) * LX; \
            const float a = (t > 0) ? s[t - 1] : 0.f, m = s[t], n = (t < LX - 1) ? s[t + 1] : 0.f; dst[i] = w0 * a + w1 * m + w2 * n + bb; } } while (0)
    for (int i = tid; i < 2 * LX; i += NT) tp[i] = (i < 2 * LX - 1) ? TP[(size_t)(0 * 512 + c) * (2 * LX) + i] : 0.f;
    SHORTC(vb, c);
    __syncthreads();
    float acc[2][NTT];
#pragma unroll
    for (int e = 0; e < NTT; ++e) { acc[0][e] = 0.f; acc[1][e] = 0.f; }
    for (int s = 0; s < LX; ++s) { const float v0 = vb[s], v1 = vb[LX + s];
#pragma unroll
        for (int e = 0; e < NTT; ++e) { const int t = tid + NT * e; if (t < LX) { const float w = tp[LX - 1 + t - s]; acc[0][e] += w * v0; acc[1][e] += w * v1; } } }
    __syncthreads();
    {
        const int ch = 512 + c; const float w0 = cw[ch], w1 = cw[1536 + ch], w2 = cw[2 * 1536 + ch], bb = cb[ch]; const float d0 = hd[c];
#pragma unroll
        for (int e = 0; e < NTT; ++e) { const int t = tid + NT * e; if (t < LX) {
#pragma unroll
            for (int b = 0; b < 2; ++b) { const float* s = HTb + ((size_t)(b * 2048 + ch)) * LX; const float a = (t > 0) ? s[t - 1] : 0.f, m = s[t], n = (t < LX - 1) ? s[t + 1] : 0.f;
                const float x1 = w0 * a + w1 * m + w2 * n + bb; zb[b * LX + t] = x1 * (acc[b][e] + d0 * vb[b * LX + t]); } } }
    }
    for (int i = tid; i < 2 * LX; i += NT) tp[i] = (i < 2 * LX - 1) ? TP[(size_t)(1 * 512 + c) * (2 * LX) + i] : 0.f;
    __syncthreads();
#pragma unroll
    for (int e = 0; e < NTT; ++e) { acc[0][e] = 0.f; acc[1][e] = 0.f; }
    for (int s = 0; s < LX; ++s) { const float v0 = zb[s], v1 = zb[LX + s];
#pragma unroll
        for (int e = 0; e < NTT; ++e) { const int t = tid + NT * e; if (t < LX) { const float w = tp[LX - 1 + t - s]; acc[0][e] += w * v0; acc[1][e] += w * v1; } } }
    {
        const int ch = 1024 + c; const float w0 = cw[ch], w1 = cw[1536 + ch], w2 = cw[2 * 1536 + ch], bb = cb[ch]; const float d1 = hd[512 + c];
#pragma unroll
        for (int e = 0; e < NTT; ++e) { const int t = tid + NT * e; if (t < LX) {
#pragma unroll
            for (int b = 0; b < 2; ++b) { const float* s = HTb + ((size_t)(b * 2048 + ch)) * LX; const float a = (t > 0) ? s[t - 1] : 0.f, m = s[t], n = (t < LX - 1) ? s[t + 1] : 0.f;
                const float x2 = w0 * a + w1 * m + w2 * n + bb; const float gt = HTb[((size_t)(b * 2048 + 1536 + c)) * LX + t];
                HTb[((size_t)(b * 2048 + c)) * LX + t] = x2 * (acc[b][e] + d1 * zb[b * LX + t]) * silu_f(gt); } } }
    }
    __syncthreads();
#undef SHORTC
}
__device__ __forceinline__ void phase_hy_naive(const Params& p, int l, int bid, int nb, float* smem) {
    float* HT = (float*)(p.ws + WS_HT); float* HTC = HT + (size_t)NB * 2048 * SEQ;
    const float* TPL = (const float*)(p.ws + WS_TP); const float* TPC = TPL + (size_t)2 * 512 * 2 * SEQ;
    for (int it = bid; it < 1024; it += nb) {
        if (it < 512) hy_naive_item<SEQ, 8>(p, l, TPL, HT, it, smem);
        else hy_naive_item<LCX, 1>(p, l, TPC, HTC, it - 512, smem);
    }
}

constexpr int N_POSTT = NB * 8 * (SEQ / 64) + NB * 8 * (LCX / 64);
__device__ __forceinline__ void phase_post(const Params& p, int l, int bid, int nb, float* tile) {
    const int tid = otid(), lane = tid & 63, wave = tid >> 6;
    const float* P = (const float*)(p.ws + WS_P); const float* OG = (const float*)(p.ws + WS_OG); const float* YS = (const float*)(p.ws + WS_YS5);
    bf16_t* YC = (bf16_t*)(p.ws + WS_YCAT); bf16_t* YG = (bf16_t*)(p.ws + WS_YG);
    const float* gn = p.in[I_GNORM] + l * 256; const float* sd = p.in[I_S5D] + l * 512;
    for (int r = bid * 8 + wave; r < MROWS; r += nb * 8) {
        const float* pr = P + (size_t)r * NINP;
#pragma unroll
        for (int hh = 0; hh < 4; ++hh) { const int col = hh * 256 + 4 * lane;
            const f32x4 o = *(const f32x4*)(OG + (size_t)r * 1024 + col) + *(const f32x4*)(OG + ((size_t)MROWS + r) * 1024 + col);
            const float rs = rsqrtf(wave_sum(o[0] * o[0] + o[1] * o[1] + o[2] * o[2] + o[3] * o[3]) * (1.f / 256.f) + EPS);
            const f32x4 w = *(const f32x4*)(gn + 4 * lane), g = *(const f32x4*)(pr + PGG + col);
            uint2 q; q.x = pk2(o[0] * rs * w[0] * silu_f(g[0]), o[1] * rs * w[1] * silu_f(g[1])); q.y = pk2(o[2] * rs * w[2] * silu_f(g[2]), o[3] * rs * w[3] * silu_f(g[3]));
            *(uint2*)(YC + (size_t)r * DM + col) = q; }
#pragma unroll
        for (int e = 0; e < 2; ++e) { const int col = 4 * lane + 256 * e;
            const f32x4 y = *(const f32x4*)(sd + col) * *(const f32x4*)(pr + PU + col) + *(const f32x4*)(YS + (size_t)r * 512 + col) + *(const f32x4*)(YS + ((size_t)MROWS + r) * 512 + col);
            uint2 q; q.x = pk2(gelu_tanh(y[0]), gelu_tanh(y[1])); q.y = pk2(gelu_tanh(y[2]), gelu_tanh(y[3]));
            *(uint2*)(YG + (size_t)r * 512 + col) = q; }
    }
    const float* HT = (const float*)(p.ws + WS_HT); const float* HTC = HT + (size_t)NB * 2048 * SEQ;
    for (int it = bid; it < N_POSTT; it += nb) {
        const float* src; int LX, b, cb, tb, rbase;
        if (it < NB * 8 * (SEQ / 64)) { LX = SEQ; b = it / (8 * 64); const int q = it % (8 * 64); cb = q >> 6; tb = q & 63; src = HT; rbase = b * SEQ; }
        else { const int i2 = it - NB * 8 * (SEQ / 64); LX = LCX; b = i2 / (8 * 4); const int q = i2 % (8 * 4); cb = q >> 2; tb = q & 3; src = HTC; rbase = NLAT + b * LCX; }
#pragma unroll
        for (int j = 0; j < 8; ++j) { const int i = tid + NT * j, cc = i >> 6, tt = i & 63; tile[tt * 65 + cc] = src[((size_t)(b * 2048 + cb * 64 + cc)) * LX + tb * 64 + tt]; }
        __syncthreads();
        { const int tt = tid >> 3, cq = tid & 7; const float* s = tile + tt * 65 + cq * 8;
          uint4 o; o.x = pk2(s[0], s[1]); o.y = pk2(s[2], s[3]); o.z = pk2(s[4], s[5]); o.w = pk2(s[6], s[7]);
          *(uint4*)(YC + (size_t)(rbase + tb * 64 + tt) * DM + 1536 + cb * 64 + cq * 8) = o; }
        __syncthreads();
    }
}

typedef short bf16x8_t __attribute__((ext_vector_type(8)));
constexpr int NCH = 68;
constexpr size_t GLA_QT = 0;
constexpr size_t GLA_KT = GLA_QT + (size_t)2 * MROWS * 512 * 2;
constexpr size_t GLA_KDT = GLA_KT + (size_t)2 * MROWS * 512 * 2;
constexpr size_t GLA_VT = GLA_KDT + (size_t)2 * NB * 4 * NCH * 8192 * 2;
constexpr size_t GLA_AG = GLA_VT + (size_t)NB * 4 * NCH * 16384 * 2;
constexpr size_t GLA_BYTES = GLA_AG + (size_t)2 * NB * 4 * NCH * 128 * 4;
__device__ __forceinline__ int chunk_row0(int b, int ch) { return ch < 4 ? (NLAT + b * LCX + 64 * ch) : (b * SEQ + 64 * (ch - 4)); }

constexpr int N_GLAPREP = NB * 4 * NCH;
__device__ __forceinline__ void gla_prep_item(const Params& p, int l, int it, float* smem) {
    const int tid = otid(); const int b = it / (4 * NCH), h = (it / NCH) & 3, ch = it % NCH; const int row0 = chunk_row0(b, ch);
    const float* P = (const float*)(p.ws + WS_P); unsigned char* GB = p.ws + WS_GLA;
    float* lrs = smem;
    float* tot = lrs + 64 * 32;
    float* vtile = tot + 2 * 4 * 128;
    for (int i = tid; i < 64 * 32; i += NT) lrs[i] = P[(size_t)(row0 + (i >> 5)) * NINP + PLR + (i & 31)];
#pragma unroll 1
    for (int j = 0; j < 32; ++j) { const int i = tid + NT * j, r = i >> 8, v = i & 255; vtile[r * 257 + v] = P[(size_t)(row0 + r) * NINP + PV + h * 256 + v]; }
    __syncthreads();
    const int k = tid & 127, seg = tid >> 7;
    float G[2][16];
#pragma unroll
    for (int dir = 0; dir < 2; ++dir) {
        float wg[16];
#pragma unroll
        for (int r = 0; r < 16; ++r) wg[r] = p.in[I_GWG][((size_t)(l * 2 + dir) * 16 + r) * 512 + h * 128 + k];
        const float bias = p.in[I_GBG][(l * 2 + dir) * 512 + h * 128 + k];
#pragma unroll
        for (int e = 0; e < 16; ++e) { const float* lr = lrs + (16 * seg + e) * 32 + dir * 16; float z = bias;
#pragma unroll
            for (int r = 0; r < 16; ++r) z += lr[r] * wg[r];
            G[dir][e] = (fminf(z, 0.f) - log1pf(expf(-fabsf(z)))) * (1.f / 16.f); }
        if (dir == 0) {
#pragma unroll
            for (int e = 1; e < 16; ++e) G[0][e] += G[0][e - 1];
            tot[(0 * 4 + seg) * 128 + k] = G[0][15];
        } else {
#pragma unroll
            for (int e = 14; e >= 0; --e) G[1][e] += G[1][e + 1];
            tot[(1 * 4 + seg) * 128 + k] = G[1][0];
        }
    }
    __syncthreads();
#pragma unroll
    for (int dir = 0; dir < 2; ++dir) {
        float off = 0.f, glast = 0.f;
#pragma unroll
        for (int s = 0; s < 4; ++s) { const float t = tot[(dir * 4 + s) * 128 + k]; glast += t; if (dir == 0 ? (s < seg) : (s > seg)) off += t; }
        bf16_t* QT = (bf16_t*)(GB + GLA_QT) + ((size_t)dir * MROWS + row0) * 512 + h * 128 + k;
        bf16_t* KT = (bf16_t*)(GB + GLA_KT) + ((size_t)dir * MROWS + row0) * 512 + h * 128 + k;
        unsigned kd[8];
#pragma unroll
        for (int e = 0; e < 16; e += 2) { float kdv[2];
#pragma unroll
            for (int u = 0; u < 2; ++u) { const int i = 16 * seg + e + u; const float g = G[dir][e + u] + off;
                const float q = P[(size_t)(row0 + i) * NINP + PQ + h * 128 + k] * 0.08838834764831845f, kk = P[(size_t)(row0 + i) * NINP + PK + h * 128 + k];
                QT[(size_t)i * 512] = (bf16_t)(pk2(q * expf(g), 0.f) & 0xffff); KT[(size_t)i * 512] = (bf16_t)(pk2(kk * expf(-g), 0.f) & 0xffff);
                kdv[u] = kk * expf(glast - g); }
            kd[e >> 1] = pk2(kdv[0], kdv[1]); }
        bf16_t* KD = (bf16_t*)(GB + GLA_KDT) + ((((size_t)dir * NB + b) * 4 + h) * NCH + ch) * 8192 + k * 64 + 16 * seg;
        *(uint4*)KD = make_uint4(kd[0], kd[1], kd[2], kd[3]); *(uint4*)(KD + 8) = make_uint4(kd[4], kd[5], kd[6], kd[7]);
        if (seg == 0) ((float*)(GB + GLA_AG))[((((size_t)dir * NB + b) * 4 + h) * NCH + ch) * 128 + k] = expf(glast);
    }
    {
        const int v = tid >> 1, hf = tid & 1; bf16_t* VT = (bf16_t*)(GB + GLA_VT) + (((size_t)b * 4 + h) * NCH + ch) * 16384 + v * 64 + 32 * hf;
#pragma unroll
        for (int c = 0; c < 4; ++c) { const float* s = vtile + (32 * hf + 8 * c) * 257 + v;
            *(uint4*)(VT + 8 * c) = make_uint4(pk2(s[0], s[257]), pk2(s[2 * 257], s[3 * 257]), pk2(s[4 * 257], s[5 * 257]), pk2(s[6 * 257], s[7 * 257])); }
    }
    __syncthreads();
}

constexpr int GQP = 136, GVP = 72;
__device__ __forceinline__ bf16x8_t ldfrag(const bf16_t* base, int pitch, int row0, int k0, int lane) {
    return *(const bf16x8_t*)(base + (row0 + (lane & 15)) * pitch + k0 + (lane >> 4) * 8);
}
__device__ __forceinline__ void gla_seq_item(const Params& p, int it, bf16_t* lds) {
    const int tid = otid(), lane = tid & 63, w = tid >> 6;
    const int b = it >> 5, dir = (it >> 4) & 1, h = (it >> 2) & 3, vs = it & 3;
    unsigned char* GB = p.ws + WS_GLA; float* OG = (float*)(p.ws + WS_OG);
    bf16_t* Qs = lds; bf16_t* Ks = Qs + 64 * GQP; bf16_t* STs = Ks + 64 * GQP; bf16_t* KdTs = STs + 64 * GQP; bf16_t* VTs = KdTs + 128 * GVP; bf16_t* Ps = VTs + 64 * GVP;
    const bf16_t* QTg = (const bf16_t*)(GB + GLA_QT) + (size_t)dir * MROWS * 512 + h * 128;
    const bf16_t* KTg = (const bf16_t*)(GB + GLA_KT) + (size_t)dir * MROWS * 512 + h * 128;
    const bf16_t* KDg = (const bf16_t*)(GB + GLA_KDT) + (((size_t)dir * NB + b) * 4 + h) * NCH * 8192;
    const bf16_t* VTg = (const bf16_t*)(GB + GLA_VT) + ((size_t)b * 4 + h) * NCH * 16384 + vs * 64 * 64;
    const float* AGg = (const float*)(GB + GLA_AG) + (((size_t)dir * NB + b) * 4 + h) * NCH * 128;
    f32x4 S[4];
#pragma unroll
    for (int i = 0; i < 4; ++i) S[i] = (f32x4){0.f, 0.f, 0.f, 0.f};
    uint4 rq0, rq1, rk0, rk1, rd0, rd1, rv; f32x4 an;
#define GLA_LOAD(cs_) do { const int ch_ = dir ? ((cs_) < 4 ? 3 - (cs_) : 71 - (cs_)) : (cs_); const int r0_ = chunk_row0(b, ch_); const int e0_ = tid, e1_ = tid + NT; \
        rq0 = *(const uint4*)(QTg + (size_t)(r0_ + (e0_ >> 4)) * 512 + (e0_ & 15) * 8); rq1 = *(const uint4*)(QTg + (size_t)(r0_ + (e1_ >> 4)) * 512 + (e1_ & 15) * 8); \
        rk0 = *(const uint4*)(KTg + (size_t)(r0_ + (e0_ >> 4)) * 512 + (e0_ & 15) * 8); rk1 = *(const uint4*)(KTg + (size_t)(r0_ + (e1_ >> 4)) * 512 + (e1_ & 15) * 8); \
        rd0 = *(const uint4*)(KDg + (size_t)ch_ * 8192 + e0_ * 8); rd1 = *(const uint4*)(KDg + (size_t)ch_ * 8192 + e1_ * 8); \
        rv = *(const uint4*)(VTg + (size_t)ch_ * 16384 + tid * 8); an = *(const f32x4*)(AGg + ch_ * 128 + 16 * w + (lane >> 4) * 4); } while (0)
    GLA_LOAD(0);
#pragma unroll 1
    for (int cs = 0; cs < NCH; ++cs) {
        const int ch = dir ? (cs < 4 ? 3 - cs : 71 - cs) : cs; const int r0 = chunk_row0(b, ch);
        { const int e0 = tid, e1 = tid + NT;
            *(uint4*)(Qs + (e0 >> 4) * GQP + (e0 & 15) * 8) = rq0; *(uint4*)(Qs + (e1 >> 4) * GQP + (e1 & 15) * 8) = rq1;
            *(uint4*)(Ks + (e0 >> 4) * GQP + (e0 & 15) * 8) = rk0; *(uint4*)(Ks + (e1 >> 4) * GQP + (e1 & 15) * 8) = rk1;
            *(uint4*)(KdTs + (e0 >> 3) * GVP + (e0 & 7) * 8) = rd0; *(uint4*)(KdTs + (e1 >> 3) * GVP + (e1 & 7) * 8) = rd1; }
        *(uint4*)(VTs + (tid >> 3) * GVP + (tid & 7) * 8) = rv;
        const f32x4 ac = an;
#pragma unroll
        for (int vt = 0; vt < 4; ++vt) *(uint2*)(STs + (16 * vt + (lane & 15)) * GQP + 16 * w + (lane >> 4) * 4) = make_uint2(pk2(S[vt][0], S[vt][1]), pk2(S[vt][2], S[vt][3]));
        __syncthreads();
        if (cs + 1 < NCH) GLA_LOAD(cs + 1);
        const int st = w & 3, tt0 = 2 * (w >> 2);
        {
            f32x4 c0 = {0.f, 0.f, 0.f, 0.f}, c1 = c0;
#pragma unroll
            for (int ks = 0; ks < 4; ++ks) { const bf16x8_t a = ldfrag(Ks, GQP, 16 * st, 32 * ks, lane);
                c0 = __builtin_amdgcn_mfma_f32_16x16x32_bf16(a, ldfrag(Qs, GQP, 16 * tt0, 32 * ks, lane), c0, 0, 0, 0);
                c1 = __builtin_amdgcn_mfma_f32_16x16x32_bf16(a, ldfrag(Qs, GQP, 16 * tt0 + 16, 32 * ks, lane), c1, 0, 0, 0); }
            const int s0 = 16 * st + (lane >> 4) * 4;
#pragma unroll
            for (int u = 0; u < 2; ++u) { const f32x4 c = u ? c1 : c0; const int t = 16 * (tt0 + u) + (lane & 15); float m[4];
#pragma unroll
                for (int r = 0; r < 4; ++r) { const bool keep = dir ? (s0 + r > t) : (s0 + r <= t); m[r] = keep ? c[r] : 0.f; }
                *(uint2*)(Ps + t * GVP + s0) = make_uint2(pk2(m[0], m[1]), pk2(m[2], m[3])); }
        }
        f32x4 o0 = {0.f, 0.f, 0.f, 0.f}, o1 = o0;
#pragma unroll
        for (int ks = 0; ks < 4; ++ks) { const bf16x8_t a = ldfrag(STs, GQP, 16 * st, 32 * ks, lane);
            o0 = __builtin_amdgcn_mfma_f32_16x16x32_bf16(a, ldfrag(Qs, GQP, 16 * tt0, 32 * ks, lane), o0, 0, 0, 0);
            o1 = __builtin_amdgcn_mfma_f32_16x16x32_bf16(a, ldfrag(Qs, GQP, 16 * tt0 + 16, 32 * ks, lane), o1, 0, 0, 0); }
#pragma unroll
        for (int vt = 0; vt < 4; ++vt) { S[vt][0] *= ac[0]; S[vt][1] *= ac[1]; S[vt][2] *= ac[2]; S[vt][3] *= ac[3]; }
#pragma unroll
        for (int ks = 0; ks < 2; ++ks) { const bf16x8_t a = ldfrag(KdTs, GVP, 16 * w, 32 * ks, lane);
#pragma unroll
            for (int vt = 0; vt < 4; ++vt) S[vt] = __builtin_amdgcn_mfma_f32_16x16x32_bf16(a, ldfrag(VTs, GVP, 16 * vt, 32 * ks, lane), S[vt], 0, 0, 0); }
        __syncthreads();
#pragma unroll
        for (int ks = 0; ks < 2; ++ks) { const bf16x8_t a = ldfrag(VTs, GVP, 16 * st, 32 * ks, lane);
            o0 = __builtin_amdgcn_mfma_f32_16x16x32_bf16(a, ldfrag(Ps, GVP, 16 * tt0, 32 * ks, lane), o0, 0, 0, 0);
            o1 = __builtin_amdgcn_mfma_f32_16x16x32_bf16(a, ldfrag(Ps, GVP, 16 * tt0 + 16, 32 * ks, lane), o1, 0, 0, 0); }
        { float* og = OG + ((size_t)dir * MROWS + r0 + 16 * tt0 + (lane & 15)) * 1024 + h * 256 + vs * 64 + 16 * st + (lane >> 4) * 4;
          *(f32x4*)og = o0; *(f32x4*)(og + 16 * 1024) = o1; }
        __syncthreads();
    }
#undef GLA_LOAD
}
#ifndef FFT_HD
#define FFT_HD __device__ __forceinline__
#endif
#define PADI(i) ((i) + ((i) >> 5))
constexpr int FFT_N = 8192, FFT_BUF = FFT_N + FFT_N / 32, FFT_TW = 2048 + 512 + 128 + 32 + 8;
struct __attribute__((aligned(8))) cf { float x, y; };
FFT_HD cf cmul(cf a, cf b) { return cf{a.x * b.x - a.y * b.y, a.x * b.y + a.y * b.x}; }
FFT_HD cf cmulc(cf a, cf b) { return cf{a.x * b.x + a.y * b.y, a.y * b.x - a.x * b.y}; }
FFT_HD cf cadd(cf a, cf b) { return cf{a.x + b.x, a.y + b.y}; }
FFT_HD cf csub(cf a, cf b) { return cf{a.x - b.x, a.y - b.y}; }
FFT_HD int fft_twoff(int s) { return s == 0 ? 0 : s == 1 ? 2048 : s == 2 ? 2560 : s == 3 ? 2688 : 2720; }
template <bool INV> FFT_HD void fft_stage4(cf* buf, const cf* tw, int s, int tid) {
    const int lq = 11 - 2 * s, q4 = 1 << lq; const cf* t = tw + fft_twoff(s);
#pragma unroll
    for (int e = 0; e < 4; ++e) {
        const int bf = tid + 512 * e, blk = bf >> lq, j = bf & (q4 - 1), base = (blk << (lq + 2)) + j;
        const int i0 = PADI(base), i1 = PADI(base + q4), i2 = PADI(base + 2 * q4), i3 = PADI(base + 3 * q4);
        const cf w1 = t[j], w2 = cmul(w1, w1), w3 = cmul(w2, w1);
        cf x0 = buf[i0], x1 = buf[i1], x2 = buf[i2], x3 = buf[i3];
        if (INV) { x1 = cmulc(x1, w1); x2 = cmulc(x2, w2); x3 = cmulc(x3, w3); }
        const cf a = cadd(x0, x2), b = csub(x0, x2), c = cadd(x1, x3), d = csub(x1, x3);
        cf y0 = cadd(a, c), y2 = csub(a, c), y1, y3;
        if (!INV) { y1 = cf{b.x + d.y, b.y - d.x}; y3 = cf{b.x - d.y, b.y + d.x}; y1 = cmul(y1, w1); y2 = cmul(y2, w2); y3 = cmul(y3, w3); }
        else      { y1 = cf{b.x - d.y, b.y + d.x}; y3 = cf{b.x + d.y, b.y - d.x}; }
        buf[i0] = y0; buf[i1] = y1; buf[i2] = y2; buf[i3] = y3;
    }
}
template <bool INV> FFT_HD void fft_last8(cf* buf, int tid) {
    const float h = 0.70710678118654752f;
    const cf w[2][4] = {{{1.f, 0.f}, {1.f, 0.f}, {1.f, 0.f}, {1.f, 0.f}}, {{1.f, 0.f}, {h, -h}, {0.f, -1.f}, {-h, -h}}};
#pragma unroll
    for (int e = 0; e < 2; ++e) {
        const int base = PADI((tid + 512 * e) * 8); cf x[8];
#pragma unroll
        for (int i = 0; i < 8; ++i) x[i] = buf[base + i];
        if (!INV) {
#pragma unroll
            for (int j = 0; j < 2; ++j) { const cf a = cadd(x[j], x[j + 4]), b = csub(x[j], x[j + 4]), c = cadd(x[j + 2], x[j + 6]), d = csub(x[j + 2], x[j + 6]);
                x[j] = cadd(a, c); x[j + 2] = cmul(cf{b.x + d.y, b.y - d.x}, w[j][1]); x[j + 4] = cmul(csub(a, c), w[j][2]); x[j + 6] = cmul(cf{b.x - d.y, b.y + d.x}, w[j][3]); }
#pragma unroll
            for (int m = 0; m < 4; ++m) { const cf a = x[2 * m], b = x[2 * m + 1]; x[2 * m] = cadd(a, b); x[2 * m + 1] = csub(a, b); }
        } else {
#pragma unroll
            for (int m = 0; m < 4; ++m) { const cf a = x[2 * m], b = x[2 * m + 1]; x[2 * m] = cadd(a, b); x[2 * m + 1] = csub(a, b); }
#pragma unroll
            for (int j = 0; j < 2; ++j) { const cf u0 = x[j], u1 = cmulc(x[j + 2], w[j][1]), u2 = cmulc(x[j + 4], w[j][2]), u3 = cmulc(x[j + 6], w[j][3]);
                const cf a = cadd(u0, u2), b = csub(u0, u2), c = cadd(u1, u3), d = csub(u1, u3);
                x[j] = cadd(a, c); x[j + 4] = csub(a, c); x[j + 2] = cf{b.x - d.y, b.y + d.x}; x[j + 6] = cf{b.x + d.y, b.y - d.x}; }
        }
#pragma unroll
        for (int i = 0; i < 8; ++i) buf[base + i] = x[i];
    }
}

constexpr int HY_TW_OFF = 24576;
__device__ __forceinline__ void hy_twiddles(float* smem) {
    cf* tw = (cf*)(smem + HY_TW_OFF); const int tid = otid();
    for (int i = tid; i < FFT_TW; i += NT) { int s = 0, j = i; if (i >= 2720) { s = 4; j = i - 2720; } else if (i >= 2688) { s = 3; j = i - 2688; } else if (i >= 2560) { s = 2; j = i - 2560; } else if (i >= 2048) { s = 1; j = i - 2048; }
        const int Ls = 8192 >> (2 * s); float sn, cs; sincospif(-2.0f * (float)j / (float)Ls, &sn, &cs); tw[i] = cf{cs, sn}; }
    __syncthreads();
}
template <bool INV> __device__ __forceinline__ void hy_fft(cf* buf, const cf* tw, int tid) {
    if (!INV) {
#pragma unroll 1
        for (int s = 0; s < 5; ++s) { fft_stage4<false>(buf, tw, s, tid); __syncthreads(); }
        fft_last8<false>(buf, tid); __syncthreads();
    } else {
        fft_last8<true>(buf, tid); __syncthreads();
#pragma unroll 1
        for (int s = 4; s >= 0; --s) { fft_stage4<true>(buf, tw, s, tid); __syncthreads(); }
    }
}
__device__ __forceinline__ void hy_spec_item(const Params& p, int it, float* smem) {
    const int tid = otid(); cf* buf = (cf*)smem; const cf* tw = (const cf*)(smem + HY_TW_OFF);
    const float* src = (const float*)(p.ws + WS_TP) + (size_t)it * 8192; cf* HS = (cf*)(p.ws + WS_HS) + (size_t)it * 8192;
#pragma unroll 4
    for (int e = 0; e < 16; ++e) { const int j = tid + NT * e, idx = (j + 4095) & 8191; buf[PADI(j)] = cf{idx == 8191 ? 0.f : src[idx], 0.f}; }
    __syncthreads();
    hy_fft<false>(buf, tw, tid);
#pragma unroll 4
    for (int e = 0; e < 16; ++e) { const int i = tid + NT * e; const cf v = buf[PADI(i)]; HS[i] = cf{v.x * (1.f / 8192.f), v.y * (1.f / 8192.f)}; }
    __syncthreads();
}
__device__ __forceinline__ float hy_short(const float* s, int t, float w0, float w1, float w2, float bb) {
    const float a = (t > 0) ? s[t - 1] : 0.f, m = s[t], n = (t < SEQ - 1) ? s[t + 1] : 0.f; return w0 * a + w1 * m + w2 * n + bb;
}
__device__ __forceinline__ void hy_fft_item(const Params& p, int l, int c, float* smem) {
    const int tid = otid(); cf* buf = (cf*)smem; const cf* tw = (const cf*)(smem + HY_TW_OFF);
    float* HT = (float*)(p.ws + WS_HT); const cf* HS = (const cf*)(p.ws + WS_HS);
    const float* cw = p.in[I_HCW] + (size_t)l * 3 * 1536; const float* cb = p.in[I_HCB] + (size_t)l * 1536; const float* hd = p.in[I_HD] + (size_t)l * 2 * 512;
    float v0[8], v1[8];
    { const float w0 = cw[c], w1 = cw[1536 + c], w2 = cw[2 * 1536 + c], bb = cb[c]; const float* s0 = HT + (size_t)c * SEQ; const float* s1 = HT + (size_t)(2048 + c) * SEQ;
#pragma unroll
      for (int e = 0; e < 8; ++e) { const int t = tid + NT * e; v0[e] = hy_short(s0, t, w0, w1, w2, bb); v1[e] = hy_short(s1, t, w0, w1, w2, bb);
          buf[PADI(t)] = cf{v0[e], v1[e]}; buf[PADI(4096 + t)] = cf{0.f, 0.f}; } }
    __syncthreads();
    hy_fft<false>(buf, tw, tid);
    { const cf* H = HS + (size_t)c * 8192;
#pragma unroll 4
      for (int e = 0; e < 16; ++e) { const int i = tid + NT * e; buf[PADI(i)] = cmul(buf[PADI(i)], H[i]); } }
    __syncthreads();
    hy_fft<true>(buf, tw, tid);
    float z0[8], z1[8];
    { const int ch = 512 + c; const float w0 = cw[ch], w1 = cw[1536 + ch], w2 = cw[2 * 1536 + ch], bb = cb[ch]; const float d0 = hd[c];
      const float* s0 = HT + (size_t)ch * SEQ; const float* s1 = HT + (size_t)(2048 + ch) * SEQ;
#pragma unroll
      for (int e = 0; e < 8; ++e) { const int t = tid + NT * e; const cf y = buf[PADI(t)];
          z0[e] = hy_short(s0, t, w0, w1, w2, bb) * (y.x + d0 * v0[e]); z1[e] = hy_short(s1, t, w0, w1, w2, bb) * (y.y + d0 * v1[e]); } }
    __syncthreads();
#pragma unroll
    for (int e = 0; e < 8; ++e) { const int t = tid + NT * e; buf[PADI(t)] = cf{z0[e], z1[e]}; buf[PADI(4096 + t)] = cf{0.f, 0.f}; }
    __syncthreads();
    hy_fft<false>(buf, tw, tid);
    { const cf* H = HS + (size_t)(512 + c) * 8192;
#pragma unroll 4
      for (int e = 0; e < 16; ++e) { const int i = tid + NT * e; buf[PADI(i)] = cmul(buf[PADI(i)], H[i]); } }
    __syncthreads();
    hy_fft<true>(buf, tw, tid);
    { const int ch = 1024 + c; const float w0 = cw[ch], w1 = cw[1536 + ch], w2 = cw[2 * 1536 + ch], bb = cb[ch]; const float d1 = hd[512 + c];
      const float* s0 = HT + (size_t)ch * SEQ; const float* s1 = HT + (size_t)(2048 + ch) * SEQ;
      const float* g0 = HT + (size_t)(1536 + c) * SEQ; const float* g1 = HT + (size_t)(2048 + 1536 + c) * SEQ;
#pragma unroll
      for (int e = 0; e < 8; ++e) { const int t = tid + NT * e; const cf y = buf[PADI(t)];
          HT[(size_t)c * SEQ + t] = hy_short(s0, t, w0, w1, w2, bb) * (y.x + d1 * z0[e]) * silu_f(g0[t]);
          HT[(size_t)(2048 + c) * SEQ + t] = hy_short(s1, t, w0, w1, w2, bb) * (y.y + d1 * z1[e]) * silu_f(g1[t]); } }
    __syncthreads();
}

__device__ __forceinline__ void phase_inproj(const Params& p, int l, int bid, int nb, LAS unsigned char* lds) {
    pg8::Gemm g{(const bf16_t*)(p.ws + WS_H), (const bf16_t*)(p.ws + WS_WIN) + (size_t)l * NINP * DM, MROWS, NINP, DM};
    pg8::StaticOrder S; S.init(MROWS, NINP, nb, bid);
    pg8::EpiF32 E{(float*)(p.ws + WS_P), NINP};
    pg8::gemm_phase<pg8::EpiF32, pg8::StaticOrder, true, true>(lds, g, S, E);
}
__device__ __forceinline__ void phase_glu(const Params& p, int l, int bid, int nb, LAS unsigned char* lds) {
    pg8::Gemm g{(const bf16_t*)(p.ws + WS_YG), (const bf16_t*)(p.ws + WS_WGLU) + (size_t)l * 512 * 512, MROWS, 512, 512};
    pg8::StaticOrder S; S.init(MROWS, 512, nb, bid);
    pg8::EpiGlu E{(const bf16_t*)(p.ws + WS_YG), (const float*)(p.ws + WS_P) + PSG, NINP, p.in[I_BGLU] + l * 512, (bf16_t*)(p.ws + WS_YCAT) + 1024, DM};
    pg8::gemm_phase<pg8::EpiGlu, pg8::StaticOrder, true, true>(lds, g, S, E);
}
__device__ __forceinline__ void phase_outproj(const Params& p, int l, int bid, int nb, LAS unsigned char* lds) {
    pg8::Gemm g{(const bf16_t*)(p.ws + WS_YCAT), (const bf16_t*)(p.ws + WS_WOUT) + (size_t)l * DM * DM, MROWS, DM, DM};
    pg8::StaticOrder S; S.init(MROWS, DM, nb, bid);
    pg8::EpiF32 E{(float*)(p.ws + WS_P), DM};
    pg8::gemm_phase<pg8::EpiF32, pg8::StaticOrder, true, true>(lds, g, S, E);
}

static_assert(GLA_BYTES <= (size_t)80 * 1024 * 1024, "GLA workspace");
constexpr int LDS_BYTES = 147456;
enum { PH_PRO = 0, PH_TAPS, PH_ROW, PH_INPROJ, PH_HYT, PH_MIX, PH_POST, PH_GLU, PH_OUTPROJ };

template <int PH>
__global__ void __launch_bounds__(NT, 2) k_phase(Params p, int l) {
    extern __shared__ __attribute__((aligned(16))) unsigned char lds[];
    float* smem = (float*)lds; const int bid = blockIdx.x, nb = gridDim.x;
    if (PH == PH_PRO) { phase_weights(p, bid, nb, smem); phase_mod(p, bid, nb, smem); }
    if (PH == PH_TAPS) phase_taps(p, l, bid, nb, smem);
    if (PH == PH_ROW) phase_row(p, l, bid, nb);
    if (PH == PH_INPROJ) phase_inproj(p, l, bid, nb, (LAS unsigned char*)lds);
    if (PH == PH_HYT) phase_hyT(p, bid, nb, smem);
    if (PH == PH_MIX) {
        if (bid < 16) phase_gla_naive(p, l, bid, 16, smem);
        else if (bid < 32) phase_s5_naive(p, l, bid - 16, 16, smem);
        else phase_hy_naive(p, l, bid - 32, nb - 32, smem);
    }
    if (PH == PH_POST) phase_post(p, l, bid, nb, smem);
    if (PH == PH_GLU) phase_glu(p, l, bid, nb, (LAS unsigned char*)lds);
    if (PH == PH_OUTPROJ) phase_outproj(p, l, bid, nb, (LAS unsigned char*)lds);
}


namespace cg = cooperative_groups;
__global__ void __launch_bounds__(NT, 2) k_mega(Params p) {
    extern __shared__ __attribute__((aligned(16))) unsigned char lds[];
    cg::grid_group grid = cg::this_grid();
    float* smem = (float*)lds; const int bid = blockIdx.x, nb = gridDim.x;
    phase_weights(p, bid, nb, smem); phase_mod(p, bid, nb, smem); phase_taps(p, 0, bid, nb, smem);
    grid.sync();
#pragma unroll 1
    for (int l0 = 0; l0 < DEPTH; ++l0) {
        int l = l0; asm volatile("" : "+s"(l));
        phase_row(p, l, bid, nb);
        if (l > 0) phase_taps(p, l, bid, nb, smem);
        grid.sync();
        phase_inproj(p, l, bid, nb, (LAS unsigned char*)lds);
        grid.sync();
        phase_hyT(p, bid, nb, smem);
        for (int it = bid; it < N_GLAPREP; it += nb) gla_prep_item(p, l, it, smem);
        hy_twiddles(smem);
        for (int it = bid; it < 1024; it += nb) hy_spec_item(p, it, smem);
        grid.sync();
        if (bid < 64) gla_seq_item(p, bid, (bf16_t*)lds);
        else if (bid < 80) phase_s5_naive(p, l, bid - 64, 16, smem);
        else { hy_twiddles(smem);
            for (int c = bid - 80; c < 512; c += nb - 80) hy_fft_item(p, l, c, smem);
            float* HTC = (float*)(p.ws + WS_HT) + (size_t)NB * 2048 * SEQ; const float* TPC = (const float*)(p.ws + WS_TP) + (size_t)2 * 512 * 2 * SEQ;
            for (int c = bid - 80; c < 512; c += nb - 80) hy_naive_item<LCX, 1>(p, l, TPC, HTC, c, smem); }
        grid.sync();
        phase_post(p, l, bid, nb, smem);
        grid.sync();
        phase_glu(p, l, bid, nb, (LAS unsigned char*)lds);
        grid.sync();
        phase_outproj(p, l, bid, nb, (LAS unsigned char*)lds);
        grid.sync();
    }
    phase_row(p, DEPTH, bid, nb);
}

#ifndef MULTI_LAUNCH
#define MULTI_LAUNCH 0
#endif
template <int PH> static void launch_phase(const Params& p, int l, int grid, hipStream_t stream) {
    static bool attr = false;
    if (!attr) { (void)hipFuncSetAttribute((const void*)k_phase<PH>, hipFuncAttributeMaxDynamicSharedMemorySize, LDS_BYTES); attr = true; }
    hipLaunchKernelGGL(k_phase<PH>, dim3(grid), dim3(NT), LDS_BYTES, stream, p, l);
}

extern "C" void kernel_launch(void* const* d_in, const int* in_sizes, int n_in, void* d_out, int out_size, void* d_ws, size_t ws_size, hipStream_t stream) {
    if (n_in != 33 || out_size != NLAT * DM || ws_size < WS_END) { fprintf(stderr, "kernel_launch: unexpected problem (n_in %d out %d ws %zu need %zu)\n", n_in, out_size, ws_size, (size_t)WS_END); return; }
    Params p{};
    for (int i = 0; i < 33; ++i) p.in[i] = (const float*)d_in[i];
    p.out = (float*)d_out; p.ws = (unsigned char*)d_ws;
#if MULTI_LAUNCH
    const int G = 256;
    launch_phase<PH_PRO>(p, 0, G, stream);
    for (int l = 0; l < DEPTH; ++l) {
        launch_phase<PH_TAPS>(p, l, G, stream);
        launch_phase<PH_ROW>(p, l, G, stream);
        launch_phase<PH_INPROJ>(p, l, G, stream);
        launch_phase<PH_HYT>(p, l, G, stream);
        launch_phase<PH_MIX>(p, l, G, stream);
        launch_phase<PH_POST>(p, l, G, stream);
        launch_phase<PH_GLU>(p, l, G, stream);
        launch_phase<PH_OUTPROJ>(p, l, G, stream);
    }
    launch_phase<PH_ROW>(p, DEPTH, G, stream);
#else
    static int grid_blocks = 0;
    if (!grid_blocks) {
        int dev = 0, cus = 0, per_cu = 0;
        (void)hipGetDevice(&dev);
        (void)hipDeviceGetAttribute(&cus, hipDeviceAttributeMultiprocessorCount, dev);
        (void)hipFuncSetAttribute((const void*)k_mega, hipFuncAttributeMaxDynamicSharedMemorySize, LDS_BYTES);
        (void)hipOccupancyMaxActiveBlocksPerMultiprocessor(&per_cu, (const void*)k_mega, NT, LDS_BYTES);
        if (per_cu < 1) { fprintf(stderr, "kernel_launch: occupancy query says %d blocks per CU\n", per_cu); per_cu = 1; }
        grid_blocks = cus;
        fprintf(stderr, "kernel_launch: cus %d per_cu %d grid %d\n", cus, per_cu, grid_blocks);
    }
    void* args[] = {&p};
    hipError_t e = hipLaunchCooperativeKernel((const void*)k_mega, dim3(grid_blocks), dim3(NT), args, LDS_BYTES, stream);
    if (e != hipSuccess) fprintf(stderr, "cooperative launch failed: %s (grid %d)\n", hipGetErrorString(e), grid_blocks);
#endif
}
```

```cpp
#include <hip/hip_runtime.h>
#include <hip/hip_cooperative_groups.h>
#include <cstdio>
#include <cstdint>
#include <cmath>
namespace pg8 {
#define PG8_LAS __attribute__((address_space(3)))
typedef unsigned short bf16_t;
typedef short bf16x8 __attribute__((ext_vector_type(8)));
typedef float f32x4 __attribute__((ext_vector_type(4)));
typedef unsigned u32x4 __attribute__((ext_vector_type(4)));
constexpr int BM = 256, BK = 64, HALF = 128, HTB = HALF * BK * 2  , STAGE_BYTES = 8 * HTB, NXCD = 8, WGM = 8;

__host__ __device__ __forceinline__ int lds_byte(int r, int c) { const int st = (r >> 4) * 2 + (c >> 5), rr = r & 15, cc = c & 31, ob = rr * 64 + cc * 2; return st * 1024 + (ob ^ (((ob >> 9) & 1) << 5)); }
__host__ __device__ __forceinline__ void stage_rc(int b, int& R, int& C) { const int st = b / 1024, sb = b % 1024, swz = sb ^ (((sb >> 9) & 1) << 5); R = (st >> 1) * 16 + swz / 64; C = (st & 1) * 32 + (swz % 64) / 2; }
__host__ __device__ __forceinline__ int perm32(int rho) { const int n = rho >> 4, i = rho & 15; return 8 * (i >> 2) + 4 * n + (i & 3); }

struct Unit { int pm, pn; };
struct Gemm { const bf16_t* A; const bf16_t* Bt; int M, N, K; };

struct StaticOrder {
    int nM, nN, nwg, G, c;
    __host__ __device__ void init(int M, int N, int G_, int c_) { nM = M / BM; nN = N / BM; nwg = nM * nN; G = G_; c = c_; }
    __host__ __device__ bool next(int i, Unit& u) const {
        const long L = (long)i * G + c; if (L >= nwg) return false;
        int wgid = (int)L; { const int q = nwg / NXCD, r = nwg % NXCD, xcd = wgid % NXCD, off = wgid / NXCD; wgid = (xcd < r ? xcd * (q + 1) : r * (q + 1) + (xcd - r) * q) + off; }
        const int nig = WGM * nN, gid = wgid / nig, fm = gid * WGM, gsz = (nM - fm) < WGM ? (nM - fm) : WGM;
        u.pm = fm + ((wgid % nig) % gsz); u.pn = (wgid % nig) / gsz; return true;
    }
    __device__ __forceinline__ void a_ready(const Unit&) const {}
    __device__ __forceinline__ void done(const Unit&) const {}
};


__device__ __forceinline__ unsigned cvt_pk_bf16(float lo, float hi) { unsigned r; asm volatile("v_cvt_pk_bf16_f32 %0, %1, %2" : "=v"(r) : "v"(lo), "v"(hi)); return r; }
__device__ __forceinline__ float bf2f(unsigned short h) { return __builtin_bit_cast(float, (unsigned)h << 16); }

struct EpiF32 {
    static constexpr bool PERM = false, AFTER_DRAIN = false;
    float* O; int ldc;
    __device__ __forceinline__ void operator()(const f32x4 (&acc)[2][2][4][2], const Unit& u, int wr, int wc, int fr, int fq) const {
        const int row0 = u.pm * BM + wr * 64 + fr, col0 = u.pn * BM + wc * 32 + 4 * fq;
#pragma unroll
        for (int ai = 0; ai < 2; ++ai)
#pragma unroll
            for (int m = 0; m < 4; ++m) { float* rowp = O + (size_t)(row0 + ai * HALF + m * 16) * ldc + col0;
#pragma unroll
                for (int bj = 0; bj < 2; ++bj)
#pragma unroll
                    for (int n = 0; n < 2; ++n) *(f32x4*)(rowp + bj * HALF + n * 16) = acc[ai][bj][m][n]; }
    }
};
struct EpiGlu {
    static constexpr bool PERM = false, AFTER_DRAIN = false;
    const bf16_t* YG; const float* Psg; int ldp; const float* bg; bf16_t* Y; int ldy;
    __device__ __forceinline__ void operator()(const f32x4 (&acc)[2][2][4][2], const Unit& u, int wr, int wc, int fr, int fq) const {
        const int row0 = u.pm * BM + wr * 64 + fr, col0 = u.pn * BM + wc * 32 + 4 * fq;
#pragma unroll
        for (int ai = 0; ai < 2; ++ai)
#pragma unroll
            for (int m = 0; m < 4; ++m) { const size_t row = (size_t)(row0 + ai * HALF + m * 16);
#pragma unroll
                for (int bj = 0; bj < 2; ++bj)
#pragma unroll
                    for (int n = 0; n < 2; ++n) { const int col = col0 + bj * HALF + n * 16;
                        const f32x4 a = acc[ai][bj][m][n]; const f32x4 b = *(const f32x4*)(bg + col); const f32x4 sg = *(const f32x4*)(Psg + row * ldp + col);
                        const uint2 y2 = *(const uint2*)(YG + row * 512 + col);
                        float yv[4] = {bf2f((unsigned short)(y2.x & 0xffff)), bf2f((unsigned short)(y2.x >> 16)), bf2f((unsigned short)(y2.y & 0xffff)), bf2f((unsigned short)(y2.y >> 16))};
                        float o[4];
#pragma unroll
                        for (int e = 0; e < 4; ++e) { const float z = a[e] + b[e]; const float s = 1.f / (1.f + __expf(-z)); const float g = sg[e]; const float sl = g / (1.f + __expf(-g)); o[e] = yv[e] * s * sl; }
                        uint2 w; w.x = cvt_pk_bf16(o[0], o[1]); w.y = cvt_pk_bf16(o[2], o[3]);
                        *(uint2*)(Y + row * ldy + col) = w; } }
    }
};
template <class Epi, class Sched, bool ALIGN_EPI = false, bool SP2 = false>
__device__ __forceinline__ void gemm_phase(PG8_LAS unsigned char* lds, const Gemm g, const Sched& S, const Epi& E) {
    int tid_o = threadIdx.x; asm volatile("" : "+v"(tid_o)); const int tid = tid_o, wid = __builtin_amdgcn_readfirstlane(tid >> 6), lane = tid & 63, wr = wid >> 2, wc = wid & 3, fr = lane & 15, fq = lane >> 4;
    const int K = g.K, nt = K / BK;
    unsigned voffA[2], voffB[2];
#pragma unroll
    for (int i = 0; i < 2; ++i) { int R, C; stage_rc(tid * 16 + i * 8192, R, C); const int Rb = Epi::PERM ? ((R & ~31) + perm32(R & 31)) : R;
        voffA[i] = (unsigned)(R * K + C) * 2u; voffB[i] = (unsigned)(Rb * K + C) * 2u; }
    const size_t kstep = (size_t)(BK * 2);
    const size_t hstep = (size_t)HALF * K * 2;
    const size_t tstep = 2 * hstep;
    const unsigned ldsw = (unsigned)wid * 1024u;
    const int aoff = lds_byte(wr * 64 + fr, fq * 8), boff = lds_byte(wc * 32 + fr, fq * 8);
#define PG8_SA(b, h) (((b) * 2 + (h)) * HTB)
#define PG8_SB(b, h) ((4 + (b) * 2 + (h)) * HTB)
#define PG8_STAGE(bufoff, gbase, voff) do { _Pragma("unroll") for (int _i = 0; _i < 2; ++_i) \
        __builtin_amdgcn_global_load_lds((const unsigned*)((const char*)(gbase) + (voff)[_i]), (PG8_LAS unsigned*)(lds + (bufoff) + ldsw + _i * 8192), 16, 0, 0); } while (0)
#define PG8_LDA(dst, b, h) do { _Pragma("unroll") for (int m = 0; m < 4; ++m) _Pragma("unroll") for (int k = 0; k < 2; ++k) dst[m][k] = *(const PG8_LAS bf16x8*)(lds + PG8_SA(b, h) + aoff + m * 2048 + k * 1024); } while (0)
#define PG8_LDB(dst, b, h) do { _Pragma("unroll") for (int n = 0; n < 2; ++n) _Pragma("unroll") for (int k = 0; k < 2; ++k) dst[n][k] = *(const PG8_LAS bf16x8*)(lds + PG8_SB(b, h) + boff + n * 2048 + k * 1024); } while (0)
#define PG8_MMA(ai, bj, At, Bt) do { __builtin_amdgcn_s_setprio(1); _Pragma("unroll") for (int m = 0; m < 4; ++m) _Pragma("unroll") for (int n = 0; n < 2; ++n) _Pragma("unroll") for (int k = 0; k < 2; ++k) \
        acc[ai][bj][m][n] = __builtin_amdgcn_mfma_f32_16x16x32_bf16(Bt[n][k], At[m][k], acc[ai][bj][m][n], 0, 0, 0); __builtin_amdgcn_s_setprio(0); } while (0)
#define PG8_WAIT_V(n) asm volatile("s_waitcnt vmcnt(" #n ")" ::: "memory")
#define PG8_WAIT_L(n) asm volatile("s_waitcnt lgkmcnt(" #n ")" ::: "memory")
#define PG8_BAR __builtin_amdgcn_s_barrier()
#define PG8_SCHED __builtin_amdgcn_sched_barrier(0)
    Unit cur, nxt; int ui = 0;
    if (!S.next(0, cur)) return;
    f32x4 acc[2][2][4][2];
#pragma unroll
    for (int a = 0; a < 2; ++a)
#pragma unroll
        for (int b = 0; b < 2; ++b)
#pragma unroll
            for (int m = 0; m < 4; ++m)
#pragma unroll
                for (int n = 0; n < 2; ++n) acc[a][b][m][n] = (f32x4){0.f, 0.f, 0.f, 0.f};
    bf16x8 At[4][2], B0[2][2], B1[2][2];
    const char* cA = (const char*)g.A + (size_t)cur.pm * tstep; const char* cB = (const char*)g.Bt + (size_t)cur.pn * tstep;
    S.a_ready(cur);
    if constexpr (SP2) {
        PG8_STAGE(PG8_SB(0, 0), cB, voffB); PG8_STAGE(PG8_SB(0, 1), cB + hstep, voffB); PG8_STAGE(PG8_SA(0, 0), cA, voffA); PG8_STAGE(PG8_SA(0, 1), cA + hstep, voffA);
        if (wr == 1) PG8_BAR;
        PG8_WAIT_V(2); PG8_BAR;
        PG8_STAGE(PG8_SB(1, 0), cB + kstep, voffB); PG8_STAGE(PG8_SA(1, 0), cA + kstep, voffA); PG8_STAGE(PG8_SB(1, 1), cB + hstep + kstep, voffB);
        PG8_WAIT_V(6); PG8_BAR;
    } else {
        PG8_STAGE(PG8_SB(0, 0), cB, voffB); PG8_STAGE(PG8_SA(0, 0), cA, voffA); PG8_STAGE(PG8_SB(0, 1), cB + hstep, voffB); PG8_STAGE(PG8_SA(0, 1), cA + hstep, voffA);
        if (wr == 1) PG8_BAR;
        PG8_WAIT_V(4); PG8_BAR;
        PG8_STAGE(PG8_SB(1, 0), cB + kstep, voffB); PG8_STAGE(PG8_SA(1, 0), cA + kstep, voffA); PG8_STAGE(PG8_SB(1, 1), cB + hstep + kstep, voffB);
        PG8_WAIT_V(6); PG8_BAR;
    }
    for (;;) {
        const bool has_next = S.next(ui + 1, nxt);
        const char* nA = has_next ? (const char*)g.A + (size_t)nxt.pm * tstep : cA; const char* nB = has_next ? (const char*)g.Bt + (size_t)nxt.pn * tstep : cB;
        for (int t = 0; t < nt; t += 2) {
            const bool last = (t == nt - 2);
            const char* a1 = cA + (size_t)(t + 1) * kstep;
            const char* a2 = last ? nA : cA + (size_t)(t + 2) * kstep; const char* b2 = last ? nB : cB + (size_t)(t + 2) * kstep;
            const char* a3 = a2 + kstep; const char* b3 = b2 + kstep;
            if (last && has_next) S.a_ready(nxt);
            if constexpr (SP2) {
            PG8_LDB(B0, 0, 0); PG8_LDB(B1, 0, 1); PG8_SCHED; PG8_LDA(At, 0, 0); PG8_STAGE(PG8_SA(1, 1), a1 + hstep, voffA);
            PG8_WAIT_V(8); PG8_WAIT_L(0); PG8_BAR; PG8_MMA(0, 0, At, B0); PG8_MMA(0, 1, At, B1); PG8_BAR; PG8_SCHED;
            PG8_LDA(At, 0, 1); PG8_STAGE(PG8_SB(0, 0), b2, voffB); PG8_STAGE(PG8_SB(0, 1), b2 + hstep, voffB); PG8_STAGE(PG8_SA(0, 0), a2, voffA);
            PG8_WAIT_V(8); PG8_WAIT_L(0); PG8_BAR; PG8_MMA(1, 0, At, B0); PG8_MMA(1, 1, At, B1); PG8_BAR; PG8_SCHED;
            PG8_LDB(B0, 1, 0); PG8_LDB(B1, 1, 1); PG8_SCHED; PG8_LDA(At, 1, 0); PG8_STAGE(PG8_SA(0, 1), a2 + hstep, voffA);
            PG8_WAIT_V(8); PG8_WAIT_L(0); PG8_BAR; PG8_MMA(0, 0, At, B0); PG8_MMA(0, 1, At, B1); PG8_BAR; PG8_SCHED;
            PG8_LDA(At, 1, 1); PG8_STAGE(PG8_SB(1, 0), b3, voffB); PG8_STAGE(PG8_SB(1, 1), b3 + hstep, voffB); PG8_STAGE(PG8_SA(1, 0), a3, voffA);
            PG8_WAIT_V(8); PG8_WAIT_L(0); PG8_BAR; PG8_MMA(1, 0, At, B0); PG8_MMA(1, 1, At, B1); PG8_BAR; PG8_SCHED;
            } else {
            PG8_LDB(B0, 0, 0); PG8_SCHED; PG8_LDA(At, 0, 0); PG8_STAGE(PG8_SA(1, 1), a1 + hstep, voffA);
            PG8_WAIT_L(8); PG8_BAR; PG8_WAIT_L(0); PG8_MMA(0, 0, At, B0); PG8_BAR; PG8_SCHED;
            PG8_LDB(B1, 0, 1); PG8_STAGE(PG8_SB(0, 0), b2, voffB);
            PG8_BAR; PG8_WAIT_L(0); PG8_MMA(0, 1, At, B1); PG8_BAR;
            PG8_LDA(At, 0, 1); PG8_STAGE(PG8_SA(0, 0), a2, voffA);
            PG8_BAR; PG8_WAIT_L(0); PG8_MMA(1, 0, At, B0); PG8_BAR; PG8_SCHED;
            PG8_STAGE(PG8_SB(0, 1), b2 + hstep, voffB);
            PG8_WAIT_V(6); PG8_BAR; PG8_MMA(1, 1, At, B1); PG8_BAR;
            PG8_LDB(B0, 1, 0); PG8_SCHED; PG8_LDA(At, 1, 0); PG8_STAGE(PG8_SA(0, 1), a2 + hstep, voffA);
            PG8_WAIT_L(8); PG8_BAR; PG8_WAIT_L(0); PG8_MMA(0, 0, At, B0); PG8_BAR; PG8_SCHED;
            PG8_LDB(B1, 1, 1); PG8_STAGE(PG8_SB(1, 0), b3, voffB);
            PG8_BAR; PG8_WAIT_L(0); PG8_MMA(0, 1, At, B1); PG8_BAR;
            PG8_LDA(At, 1, 1); PG8_STAGE(PG8_SA(1, 0), a3, voffA);
            PG8_BAR; PG8_WAIT_L(0); PG8_MMA(1, 0, At, B0); PG8_BAR; PG8_SCHED;
            PG8_STAGE(PG8_SB(1, 1), b3 + hstep, voffB);
            PG8_WAIT_V(6); PG8_BAR; PG8_MMA(1, 1, At, B1); PG8_BAR;
            }
        }
        if constexpr (ALIGN_EPI) { if (wr == 0) PG8_BAR; }
        if constexpr (!Epi::AFTER_DRAIN) { E(acc, cur, wr, wc, fr, fq); S.done(cur); }
        if (!has_next) break;
#pragma unroll
        for (int a = 0; a < 2; ++a)
#pragma unroll
            for (int b = 0; b < 2; ++b)
#pragma unroll
                for (int m = 0; m < 4; ++m)
#pragma unroll
                    for (int n = 0; n < 2; ++n) acc[a][b][m][n] = (f32x4){0.f, 0.f, 0.f, 0.f};
        cur = nxt; cA = nA; cB = nB; ++ui;
        if constexpr (ALIGN_EPI) { if (wr == 1) PG8_BAR; }
    }
    PG8_WAIT_V(0);
    if constexpr (!ALIGN_EPI) { if (wr == 0) PG8_BAR; }
    PG8_BAR;
    if constexpr (Epi::AFTER_DRAIN) { E.fused(acc, cur, wr, wc, fr, fq, lds, wid, lane); S.done(cur); }
#undef PG8_SA
#undef PG8_SB
#undef PG8_STAGE
#undef PG8_LDA
#undef PG8_LDB
#undef PG8_MMA
#undef PG8_WAIT_V
#undef PG8_WAIT_L
#undef PG8_BAR
#undef PG8_SCHED
}
}

using pg8::bf16_t; using pg8::f32x4;
#define LAS __attribute__((address_space(3)))
constexpr int DM = 2048, NB = 2, SEQ = 4096, LCX = 256, DEPTH = 4;
constexpr int NLAT = NB * SEQ;
constexpr int MROWS = NLAT + NB * LCX;
constexpr int NIN = 6176, NINP = 6400;
constexpr int PQ = 0, PK = 512, PV = 1024, PU = 2048, PGG = 2560, PSG = 3584, PHV = 4096, PHG = 5632, PLR = 6144;
constexpr float EPS = 1e-6f;
constexpr int NT = 512;

__host__ __device__ __forceinline__ int in_col_map(int n) {
    if (n < 2048) return n;
    if (n < 6144) return n + 32;
    if (n < 6176) return n - 4096;
    return -1;
}

constexpr size_t al256(size_t x) { return (x + 255) & ~(size_t)255; }
constexpr size_t WS_WIN  = 0;
constexpr size_t WS_WOUT = WS_WIN  + al256((size_t)DEPTH * NINP * DM * 2);
constexpr size_t WS_WGLU = WS_WOUT + al256((size_t)DEPTH * DM * DM * 2);
constexpr size_t WS_MOD  = WS_WGLU + al256((size_t)DEPTH * 512 * 512 * 2);
constexpr size_t WS_H    = WS_MOD  + al256((size_t)DEPTH * 3 * 6144 * 4);
constexpr size_t WS_YCAT = WS_H    + al256((size_t)MROWS * DM * 2);
constexpr size_t WS_P    = WS_YCAT + al256((size_t)MROWS * DM * 2);
constexpr size_t WS_HS   = WS_H;
static_assert((size_t)2 * 512 * 8192 * 8 <= 2 * al256((size_t)MROWS * DM * 2), "spectra alias");
constexpr size_t WS_XC   = WS_P    + al256((size_t)MROWS * NINP * 4);
constexpr size_t WS_OG   = WS_XC   + al256((size_t)NB * LCX * DM * 4);
constexpr size_t WS_YS5  = WS_OG   + al256((size_t)2 * MROWS * 1024 * 4);
constexpr size_t WS_YG   = WS_YS5  + al256((size_t)2 * MROWS * 512 * 4);
constexpr size_t WS_HT   = WS_YG   + al256((size_t)MROWS * 512 * 2);
constexpr size_t WS_TP   = WS_HT   + al256((size_t)MROWS * 2048 * 4);
constexpr size_t WS_GLA  = WS_TP   + al256((size_t)2 * 512 * 2 * SEQ * 4) + al256((size_t)2 * 512 * 2 * LCX * 4);
constexpr size_t WS_S5W  = WS_GLA  + al256((size_t)80 * 1024 * 1024);
constexpr size_t WS_END  = WS_S5W  + al256((size_t)24 * 1024 * 1024);

struct Params {
    const float* in[33];
    float* out;
    unsigned char* ws;
};
enum { I_X = 0, I_C, I_CTX, I_CCTX, I_WMOD, I_BMOD, I_GPRE, I_GPOST, I_WIN, I_WOUT, I_GWG, I_GBG, I_GNORM,
       I_LRE, I_LIM, I_LSTEP, I_BRE, I_BIM, I_CRE, I_CIM, I_S5D, I_WGLU, I_BGLU, I_HCW, I_HCB, I_HW1, I_HB1, I_HF1, I_HW2, I_HB2, I_HF2, I_HW3, I_HD };

__device__ __forceinline__ float wave_sum(float v) {
#pragma unroll
    for (int o = 1; o < 64; o <<= 1) v += __shfl_xor(v, o);
    return v;
}
__device__ __forceinline__ float silu_f(float x) { return x / (1.f + expf(-x)); }
__device__ __forceinline__ float gelu_tanh(float x) { const float u = 0.7978845608028654f * (x + 0.044715f * x * x * x); return 0.5f * x * (1.f + tanhf(u)); }
__device__ __forceinline__ unsigned pk2(float lo, float hi) { return pg8::cvt_pk_bf16(lo, hi); }
__device__ __forceinline__ int otid() { int t = threadIdx.x; asm volatile("" : "+v"(t)); return t; }
__device__ __forceinline__ int permtok(int t) { return ((t & 63) << 6) | (t >> 6); }

template <bool MAPIN>
__device__ __forceinline__ void transpose_item(const float* __restrict__ W, int ldw, int K, bf16_t* __restrict__ WT, int k0, int n0, float* tile) {
    const int tid = otid();
#pragma unroll
    for (int j = 0; j < 8; ++j) { const int i = tid + NT * j, kk = i >> 6, nn = i & 63; int oc = n0 + nn; if (MAPIN) oc = in_col_map(oc);
        tile[kk * 65 + nn] = (oc >= 0) ? W[(size_t)(k0 + kk) * ldw + oc] : 0.f; }
    __syncthreads();
    { const int n = tid >> 3, kc = tid & 7; const float* s = tile + (kc * 8) * 65 + n;
      uint4 o; o.x = pk2(s[0], s[65]); o.y = pk2(s[2 * 65], s[3 * 65]); o.z = pk2(s[4 * 65], s[5 * 65]); o.w = pk2(s[6 * 65], s[7 * 65]);
      *(uint4*)(WT + (size_t)(n0 + n) * K + k0 + kc * 8) = o; }
    __syncthreads();
}
constexpr int TI_IN = (DM / 64) * (NINP / 64), TI_OUT = (DM / 64) * (DM / 64), TI_GLU = 8 * 8;
constexpr int N_TITEMS = DEPTH * (TI_IN + TI_OUT + TI_GLU);
__device__ __forceinline__ void phase_weights(const Params& p, int bid, int nb, float* smem) {
    for (int it = bid; it < N_TITEMS; it += nb) {
        int r = it;
        if (r < DEPTH * TI_IN) { const int l = r / TI_IN, q = r % TI_IN, kb = q / (NINP / 64), nbk = q % (NINP / 64);
            transpose_item<true>(p.in[I_WIN] + (size_t)l * DM * NIN, NIN, DM, (bf16_t*)(p.ws + WS_WIN) + (size_t)l * NINP * DM, kb * 64, nbk * 64, smem); continue; }
        r -= DEPTH * TI_IN;
        if (r < DEPTH * TI_OUT) { const int l = r / TI_OUT, q = r % TI_OUT, kb = q / 32, nbk = q % 32;
            transpose_item<false>(p.in[I_WOUT] + (size_t)l * DM * DM, DM, DM, (bf16_t*)(p.ws + WS_WOUT) + (size_t)l * DM * DM, kb * 64, nbk * 64, smem); continue; }
        r -= DEPTH * TI_OUT;
        { const int l = r / TI_GLU, q = r % TI_GLU, kb = q / 8, nbk = q % 8;
            transpose_item<false>(p.in[I_WGLU] + (size_t)l * 512 * 512, 512, 512, (bf16_t*)(p.ws + WS_WGLU) + (size_t)l * 512 * 512, kb * 64, nbk * 64, smem); }
    }
}
constexpr int N_MODITEMS = DEPTH * (6144 / 64);
__device__ __forceinline__ void phase_mod(const Params& p, int bid, int nb, float* smem) {
    const int tid = otid(); float* sv = smem;   float* red = smem + 3 * 2048;
    bool loaded = false;
    for (int it = bid; it < N_MODITEMS; it += nb) {
        if (!loaded) { for (int i = tid; i < 3 * 2048; i += NT) { const int r = i >> 11, k = i & 2047; const float c = (r < 2) ? p.in[I_C][r * 2048 + k] : p.in[I_CCTX][k]; sv[i] = silu_f(c); } loaded = true; }
        __syncthreads();
        const int l = it / 96, jb = it % 96, cl = tid & 15, kg = tid >> 4;
        const float* w = p.in[I_WMOD] + (size_t)l * DM * 6144 + jb * 64 + cl * 4;
        f32x4 a0 = {0, 0, 0, 0}, a1 = a0, a2 = a0;
#pragma unroll 4
        for (int kk = 0; kk < 64; ++kk) { const int k = kg * 64 + kk; const f32x4 wv = *(const f32x4*)(w + (size_t)k * 6144);
            a0 += wv * sv[k]; a1 += wv * sv[2048 + k]; a2 += wv * sv[4096 + k]; }
        *(f32x4*)(red + (kg * 3 + 0) * 64 + cl * 4) = a0; *(f32x4*)(red + (kg * 3 + 1) * 64 + cl * 4) = a1; *(f32x4*)(red + (kg * 3 + 2) * 64 + cl * 4) = a2;
        __syncthreads();
        if (tid < 192) { const int r = tid >> 6, c = tid & 63; float s = p.in[I_BMOD][l * 6144 + jb * 64 + c];
            for (int g = 0; g < 32; ++g) s += red[(g * 3 + r) * 64 + c];
            ((float*)(p.ws + WS_MOD))[(size_t)(l * 3 + r) * 6144 + jb * 64 + c] = s; }
        __syncthreads();
    }
}
__device__ __forceinline__ void taps_item(const Params& p, int l, int LX, float* TP, int tb, int cb, float* smem) {
    const int tid = otid();
    float* feats = smem;
    float* h1 = feats + 64 * 33;
    float* h2 = h1 + 64 * 64;
    float* T = h2 + 64 * 64;
    const float* w1 = p.in[I_HW1] + l * 33 * 64; const float* b1 = p.in[I_HB1] + l * 64; const float* f1 = p.in[I_HF1] + l * 64;
    const float* w2 = p.in[I_HW2] + l * 64 * 64; const float* b2 = p.in[I_HB2] + l * 64; const float* f2 = p.in[I_HF2] + l * 64;
    const float* w3 = p.in[I_HW3] + (size_t)l * 64 * 2048;
#pragma unroll 1
    for (int i = tid; i < 64 * 33; i += NT) { const int tt = i / 33, f = i % 33; const int tau = tb * 64 + tt;
        const float ang = (6.283185307179586f / (float)LX) * (float)tau; float v;
        if (f == 0) v = (float)tau / (float)(LX - 1);
        else { const int bi = (f - 1) & 15; const float band = 1e-4f + (float)bi * ((15.0f - 1e-4f) / 15.0f); const float a = band * ang; v = (f <= 16) ? cosf(a) : -sinf(a); }
        feats[i] = v; }
    __syncthreads();
#pragma unroll 1
    for (int i = tid; i < 64 * 64; i += NT) { const int tt = i >> 6, j = i & 63; float s = b1[j];
#pragma unroll 3
        for (int f = 0; f < 33; ++f) s += feats[tt * 33 + f] * w1[f * 64 + j];
        h1[i] = sinf(f1[j] * s); }
    __syncthreads();
#pragma unroll 1
    for (int i = tid; i < 64 * 64; i += NT) { const int tt = i >> 6, j = i & 63; float s = b2[j];
#pragma unroll 4
        for (int f = 0; f < 64; ++f) s += h1[tt * 64 + f] * w2[f * 64 + j];
        h2[i] = sinf(f2[j] * s); }
    __syncthreads();
    { const int cc = tid & 255, th = tid >> 8, col = cb * 256 + cc; float acc[32];
#pragma unroll
      for (int e = 0; e < 32; ++e) acc[e] = 0.f;
#pragma unroll 1
      for (int i = 0; i < 64; ++i) { const float w = w3[(size_t)i * 2048 + col];
#pragma unroll
          for (int e = 0; e < 32; ++e) acc[e] += w * h2[(th * 32 + e) * 64 + i]; }
      const int c = col & 511; const float delta = fabsf(-15.350567286626973f + (float)c * ((-3.0701134573253945f + 15.350567286626973f) / 511.0f));
#pragma unroll
      for (int e = 0; e < 32; ++e) { const int tau = tb * 64 + th * 32 + e; const float tl = (float)tau / (float)(LX - 1); T[cc * 65 + th * 32 + e] = acc[e] * expf(-tl * delta); } }
    __syncthreads();
    { const int tt = tid & 63, cg = tid >> 6; const int tau = tb * 64 + tt;
#pragma unroll 2
      for (int q = 0; q < 32; ++q) { const int cc = cg * 32 + q, col = cb * 256 + cc; const int o = col >> 10, dir = (col >> 9) & 1, c = col & 511;
          float* dst = TP + (size_t)(o * 512 + c) * (2 * LX);
          if (dir == 0) dst[LX - 1 + tau] = T[cc * 65 + tt];
          else if (tau >= 1) dst[LX - 1 - tau] = T[cc * 65 + tt]; } }
    __syncthreads();
}
constexpr int N_TAPITEMS = (SEQ / 64) * 8 + (LCX / 64) * 8;
__device__ __forceinline__ void phase_taps(const Params& p, int l, int bid, int nb, float* smem) {
    float* TPL = (float*)(p.ws + WS_TP); float* TPC = TPL + (size_t)2 * 512 * 2 * SEQ;
    for (int it = bid; it < N_TAPITEMS; it += nb) {
        if (it < (SEQ / 64) * 8) taps_item(p, l, SEQ, TPL, it >> 3, it & 7, smem);
        else { const int q = it - (SEQ / 64) * 8; taps_item(p, l, LCX, TPC, q >> 3, q & 7, smem); }
    }
}

__device__ __forceinline__ void phase_row(const Params& p, int l, int bid, int nb) {
    const int tid_ = otid(); const int lane = tid_ & 63, wave = tid_ >> 6;
    const float* MOD = (const float*)(p.ws + WS_MOD); const float* R = (const float*)(p.ws + WS_P);
    float* XC = (float*)(p.ws + WS_XC); bf16_t* H = (bf16_t*)(p.ws + WS_H);
    const int nrows = (l == DEPTH) ? NLAT : MROWS;
    for (int r = bid * 8 + wave; r < nrows; r += nb * 8) {
        const bool lat = r < NLAT; const int b = lat ? (r >> 12) : 0, t = r & 4095, rb = lat ? b : 2;
        const float* xin; float* xout;
        if (lat) { xin = ((l <= 1) ? p.in[I_X] : p.out) + (size_t)r * DM; xout = p.out + (size_t)r * DM; }
        else { xin = ((l <= 1) ? p.in[I_CTX] : XC) + (size_t)(r - NLAT) * DM; xout = XC + (size_t)(r - NLAT) * DM; }
        f32x4 x[8];
#pragma unroll
        for (int j = 0; j < 8; ++j) x[j] = *(const f32x4*)(xin + 4 * lane + 256 * j);
        if (l > 0) {
            const int lp = l - 1; const int rr = (lat && (lp & 1)) ? (b * SEQ + permtok(t)) : r;
            const float* Rr = R + (size_t)rr * DM; f32x4 v[8]; float ss = 0.f;
#pragma unroll
            for (int j = 0; j < 8; ++j) { v[j] = *(const f32x4*)(Rr + 4 * lane + 256 * j); ss += v[j][0] * v[j][0] + v[j][1] * v[j][1] + v[j][2] * v[j][2] + v[j][3] * v[j][3]; }
            const float rs = rsqrtf(wave_sum(ss) * (1.f / DM) + EPS);
            const float* gate = MOD + (size_t)(lp * 3 + rb) * 6144 + 4096; const float* gp = p.in[I_GPOST] + lp * DM;
#pragma unroll
            for (int j = 0; j < 8; ++j) { const f32x4 g = *(const f32x4*)(gate + 4 * lane + 256 * j), w = *(const f32x4*)(gp + 4 * lane + 256 * j);
                x[j] = x[j] + g * (v[j] * rs * w); *(f32x4*)(xout + 4 * lane + 256 * j) = x[j]; }
        }
        if (l < DEPTH) {
            float ss = 0.f;
#pragma unroll
            for (int j = 0; j < 8; ++j) ss += x[j][0] * x[j][0] + x[j][1] * x[j][1] + x[j][2] * x[j][2] + x[j][3] * x[j][3];
            const float rs = rsqrtf(wave_sum(ss) * (1.f / DM) + EPS);
            const float* shift = MOD + (size_t)(l * 3 + rb) * 6144; const float* scale = shift + 2048; const float* gp = p.in[I_GPRE] + l * DM;
            const int hr = (lat && (l & 1)) ? (b * SEQ + permtok(t)) : r;
            bf16_t* hrow = H + (size_t)hr * DM;
#pragma unroll
            for (int j = 0; j < 8; ++j) { const f32x4 sh = *(const f32x4*)(shift + 4 * lane + 256 * j), sc = *(const f32x4*)(scale + 4 * lane + 256 * j), w = *(const f32x4*)(gp + 4 * lane + 256 * j);
                const f32x4 y = (x[j] * rs * w) * (sc + 1.f) + sh; uint2 o; o.x = pk2(y[0], y[1]); o.y = pk2(y[2], y[3]);
                *(uint2*)(hrow + 4 * lane + 256 * j) = o; }
        }
    }
}

constexpr int N_HTITEMS = (MROWS / 64) * 32;
__device__ __forceinline__ void phase_hyT(const Params& p, int bid, int nb, float* tile) {
    const int tid = otid(); const float* P = (const float*)(p.ws + WS_P); float* HT = (float*)(p.ws + WS_HT); float* HTC = HT + (size_t)NB * 2048 * SEQ;
    for (int it = bid; it < N_HTITEMS; it += nb) {
        const int rb = it >> 5, cb = it & 31, r0 = rb * 64, c0 = cb * 64;
#pragma unroll
        for (int j = 0; j < 8; ++j) { const int i = tid + NT * j, rr = i >> 6, cc = i & 63; tile[cc * 65 + rr] = P[(size_t)(r0 + rr) * NINP + PHV + c0 + cc]; }
        __syncthreads();
        { const int cc = tid >> 3, tq = tid & 7; const float* s = tile + cc * 65 + tq * 8; float* dst;
          if (r0 < NLAT) { const int b = r0 >> 12, t0 = r0 & 4095; dst = HT + ((size_t)(b * 2048 + c0 + cc)) * SEQ + t0 + tq * 8; }
          else { const int q = r0 - NLAT, b = q >> 8, t0 = q & 255; dst = HTC + ((size_t)(b * 2048 + c0 + cc)) * LCX + t0 + tq * 8; }
          f32x4 a = {s[0], s[1], s[2], s[3]}, bq = {s[4], s[5], s[6], s[7]}; *(f32x4*)dst = a; *(f32x4*)(dst + 4) = bq; }
        __syncthreads();
    }
}

__device__ __forceinline__ int seq_row(int b, int dir, int n) {
    if (n < LCX) { const int tc = dir ? (LCX - 1 - n) : n; return NLAT + b * LCX + tc; }
    const int m = n - LCX; const int t = dir ? (SEQ - 1 - m) : m; return b * SEQ + t;
}
__device__ __forceinline__ void phase_gla_naive(const Params& p, int l, int bid, int nb, float* smem) {
    const int tid = otid(); const float* P = (const float*)(p.ws + WS_P); float* OG = (float*)(p.ws + WS_OG);
    float* sq = smem; float* sk = sq + 8 * 128; float* se = sk + 8 * 128; float* sv = se + 8 * 128; float* so = sv + 8 * 256;
    for (int it = bid; it < 16; it += nb) {
        const int b = it >> 3, dir = (it >> 2) & 1, h = it & 3;
        const int j = tid & 255, half = tid >> 8, kk0 = tid & 127;
        float* swg = so + 16 * 256;
        for (int i = tid; i < 16 * 128; i += NT) swg[i] = p.in[I_GWG][((size_t)(l * 2 + dir) * 16 + (i >> 7)) * 512 + h * 128 + (i & 127)];
        __syncthreads();
        const float bgk = p.in[I_GBG][(l * 2 + dir) * 512 + h * 128 + kk0];
        float S[64];
#pragma unroll
        for (int k = 0; k < 64; ++k) S[k] = 0.f;
        for (int sb = 0; sb < (SEQ + LCX) / 8; ++sb) {
#pragma unroll
            for (int e = 0; e < 2; ++e) { const int i = (tid >> 7) + 4 * e; const int row = seq_row(b, dir, sb * 8 + i); const float* pr = P + (size_t)row * NINP;
                float z = bgk;
#pragma unroll
                for (int r = 0; r < 16; ++r) z += pr[PLR + dir * 16 + r] * swg[r * 128 + kk0];
                const float ls = fminf(z, 0.f) - log1pf(expf(-fabsf(z)));
                sq[i * 128 + kk0] = pr[PQ + h * 128 + kk0] * 0.08838834764831845f; sk[i * 128 + kk0] = pr[PK + h * 128 + kk0]; se[i * 128 + kk0] = expf(ls * (1.f / 16.f)); }
#pragma unroll
            for (int e = 0; e < 4; ++e) { const int idx = tid + NT * e, i = idx >> 8, jj = idx & 255; const int row = seq_row(b, dir, sb * 8 + i); sv[i * 256 + jj] = P[(size_t)row * NINP + PV + h * 256 + jj]; }
            __syncthreads();
#pragma unroll 1
            for (int i = 0; i < 8; ++i) { const float vj = sv[i * 256 + j]; float o = 0.f;
                const f32x4* q4 = (const f32x4*)(sq + i * 128 + half * 64); const f32x4* k4 = (const f32x4*)(sk + i * 128 + half * 64); const f32x4* e4 = (const f32x4*)(se + i * 128 + half * 64);
#pragma unroll
                for (int k = 0; k < 16; ++k) { const f32x4 qv = q4[k], kv = k4[k], ev = e4[k];
#pragma unroll
                    for (int c = 0; c < 4; ++c) { float s = S[4 * k + c] * ev[c]; if (dir == 0) { s += kv[c] * vj; o += qv[c] * s; } else { o += qv[c] * s; s += kv[c] * vj; } S[4 * k + c] = s; } }
                so[(half * 8 + i) * 256 + j] = o; }
            __syncthreads();
            for (int e = tid; e < 8 * 256; e += NT) { const int i = e >> 8, jj = e & 255; const int row = seq_row(b, dir, sb * 8 + i);
                OG[((size_t)dir * MROWS + row) * 1024 + h * 256 + jj] = so[i * 256 + jj] + so[(8 + i) * 256 + jj]; }
            __syncthreads();
        }
    }
}
__device__ __forceinline__ void phase_s5_naive(const Params& p, int l, int bid, int nb, float* smem) {
    const int tid = otid(), lane = tid & 63, wave = tid >> 6; const float* P = (const float*)(p.ws + WS_P); float* YS = (float*)(p.ws + WS_YS5);
    float2* sC = (float2*)smem + wave * (16 * 64);
    float2* xs = (float2*)smem + 8 * 16 * 64 + wave * (16 * 65);
    for (int wb = bid; wb < 16; wb += nb) {
        const int gw = wb * 8 + wave, b = gw >> 6, dir = (gw >> 5) & 1, g = gw & 31;
        const size_t pg = ((size_t)(l * 2 + dir) * 32 + g);
        const float lr = p.in[I_LRE][pg * 64 + lane], li = p.in[I_LIM][pg * 64 + lane], step = expf(p.in[I_LSTEP][pg]);
        const float em1 = expm1f(lr * step); float sn, cs; sincosf(li * step, &sn, &cs); const float shf = sinf(0.5f * li * step);
        const float lbr = (em1 + 1.f) * cs, lbi = (em1 + 1.f) * sn;
        const float den = lr * lr + li * li, nr = em1 * cs - 2.f * shf * shf, ni = lbi;
        const float cr = (nr * lr + ni * li) / den, ci = (ni * lr - nr * li) / den;
        float Br[16], Bi[16];
#pragma unroll
        for (int hh = 0; hh < 16; ++hh) { const float br = p.in[I_BRE][(pg * 64 + lane) * 16 + hh], bi = p.in[I_BIM][(pg * 64 + lane) * 16 + hh]; Br[hh] = cr * br - ci * bi; Bi[hh] = cr * bi + ci * br; }
        for (int i = lane; i < 16 * 64; i += 64) sC[i] = make_float2(p.in[I_CRE][pg * 1024 + i], p.in[I_CIM][pg * 1024 + i]);
        float xr = 0.f, xi = 0.f;
        for (int blk = 0; blk < (SEQ + LCX) / 16; ++blk) {
            for (int i = 0; i < 16; ++i) { const int row = seq_row(b, dir, blk * 16 + i); const float* u = P + (size_t)row * NINP + PU + g * 16;
                float bur = 0.f, bui = 0.f;
#pragma unroll
                for (int q = 0; q < 4; ++q) { const f32x4 uv = *(const f32x4*)(u + 4 * q);
#pragma unroll
                    for (int c = 0; c < 4; ++c) { bur += Br[4 * q + c] * uv[c]; bui += Bi[4 * q + c] * uv[c]; } }
                const float nxr = lbr * xr - lbi * xi + bur, nxi = lbr * xi + lbi * xr + bui; xr = nxr; xi = nxi;
                xs[i * 65 + lane] = make_float2(xr, xi); }
            __syncthreads();
            { const int tt = lane & 15, hg = lane >> 4; float y[4] = {0.f, 0.f, 0.f, 0.f};
              for (int q = 0; q < 64; ++q) { const float2 xv = xs[tt * 65 + q];
#pragma unroll
                  for (int e = 0; e < 4; ++e) { const float2 c = sC[(hg * 4 + e) * 64 + q]; y[e] += c.x * xv.x - c.y * xv.y; } }
              const int row = seq_row(b, dir, blk * 16 + tt);
              f32x4 o = {y[0], y[1], y[2], y[3]}; *(f32x4*)(YS + ((size_t)dir * MROWS + row) * 512 + g * 16 + hg * 4) = o; }
            __syncthreads();
        }
    }
}
template <int LX, int NTT>
__device__ __forceinline__ void hy_naive_item(const Params& p, int l, const float* TP, float* HTb, int c, float* smem) {
    const int tid = otid();
    float* tp = smem; float* vb = tp + 2 * LX; float* zb = vb + 2 * LX;
    const float* cw = p.in[I_HCW] + (size_t)l * 3 * 1536; const float* cb = p.in[I_HCB] + (size_t)l * 1536; const float* hd = p.in[I_HD] + (size_t)l * 2 * 512;
#define SHORTC(dst, chan) do { const float w0 = cw[chan], w1 = cw[1536 + (chan)], w2 = cw[2 * 1536 + (chan)], bb = cb[chan]; \
        for (int i = tid; i < 2 * LX; i += NT) { const int b = i / LX, t = i % LX; const float* s = HTb + ((size_t)(b * 2048 + (chan))) * LX; \
            const float a = (t > 0) ? s[t - 1] : 0.f, m = s[t], n = (t < LX - 1) ? s[t + 1] : 0.f; dst[i] = w0 * a + w1 * m + w2 * n + bb; } } while (0)
    for (int i = tid; i < 2 * LX; i += NT) tp[i] = (i < 2 * LX - 1) ? TP[(size_t)(0 * 512 + c) * (2 * LX) + i] : 0.f;
    SHORTC(vb, c);
    __syncthreads();
    float acc[2][NTT];
#pragma unroll
    for (int e = 0; e < NTT; ++e) { acc[0][e] = 0.f; acc[1][e] = 0.f; }
    for (int s = 0; s < LX; ++s) { const float v0 = vb[s], v1 = vb[LX + s];
#pragma unroll
        for (int e = 0; e < NTT; ++e) { const int t = tid + NT * e; if (t < LX) { const float w = tp[LX - 1 + t - s]; acc[0][e] += w * v0; acc[1][e] += w * v1; } } }
    __syncthreads();
    {
        const int ch = 512 + c; const float w0 = cw[ch], w1 = cw[1536 + ch], w2 = cw[2 * 1536 + ch], bb = cb[ch]; const float d0 = hd[c];
#pragma unroll
        for (int e = 0; e < NTT; ++e) { const int t = tid + NT * e; if (t < LX) {
#pragma unroll
            for (int b = 0; b < 2; ++b) { const float* s = HTb + ((size_t)(b * 2048 + ch)) * LX; const float a = (t > 0) ? s[t - 1] : 0.f, m = s[t], n = (t < LX - 1) ? s[t + 1] : 0.f;
                const float x1 = w0 * a + w1 * m + w2 * n + bb; zb[b * LX + t] = x1 * (acc[b][e] + d0 * vb[b * LX + t]); } } }
    }
    for (int i = tid; i < 2 * LX; i += NT) tp[i] = (i < 2 * LX - 1) ? TP[(size_t)(1 * 512 + c) * (2 * LX) + i] : 0.f;
    __syncthreads();
#pragma unroll
    for (int e = 0; e < NTT; ++e) { acc[0][e] = 0.f; acc[1][e] = 0.f; }
    for (int s = 0; s < LX; ++s) { const float v0 = zb[s], v1 = zb[LX + s];
#pragma unroll
        for (int e = 0; e < NTT; ++e) { const int t = tid + NT * e; if (t < LX) { const float w = tp[LX - 1 + t - s]; acc[0][e] += w * v0; acc[1][e] += w * v1; } } }
    {
        const int ch = 1024 + c; const float w0 = cw[ch], w1 = cw[1536 + ch], w2 = cw[2 * 1536 + ch], bb = cb[ch]; const float d1 = hd[512 + c];
#pragma unroll
        for (int e = 0; e < NTT; ++e) { const int t = tid + NT * e; if (t < LX) {
#pragma unroll
            for (int b = 0; b < 2; ++b) { const float* s = HTb + ((size_t)(b * 2048 + ch)) * LX; const float a = (t > 0) ? s[t - 1] : 0.f, m = s[t], n = (t < LX - 1) ? s[t + 1] : 0.f;
                const float x2 = w0 * a + w1 * m + w2 * n + bb; const float gt = HTb[((size_t)(b * 2048 + 1536 + c)) * LX + t];
                HTb[((size_t)(b * 2048 + c)) * LX + t] = x2 * (acc[b][e] + d1 * zb[b * LX + t]) * silu_f(gt); } } }
    }
    __syncthreads();
#undef SHORTC
}
__device__ __forceinline__ void phase_hy_naive(const Params& p, int l, int bid, int nb, float* smem) {
    float* HT = (float*)(p.ws + WS_HT); float* HTC = HT + (size_t)NB * 2048 * SEQ;
    const float* TPL = (const float*)(p.ws + WS_TP); const float* TPC = TPL + (size_t)2 * 512 * 2 * SEQ;
    for (int it = bid; it < 1024; it += nb) {
        if (it < 512) hy_naive_item<SEQ, 8>(p, l, TPL, HT, it, smem);
        else hy_naive_item<LCX, 1>(p, l, TPC, HTC, it - 512, smem);
    }
}

constexpr int N_POSTT = NB * 8 * (SEQ / 64) + NB * 8 * (LCX / 64);
__device__ __forceinline__ void phase_post(const Params& p, int l, int bid, int nb, float* tile) {
    const int tid = otid(), lane = tid & 63, wave = tid >> 6;
    const float* P = (const float*)(p.ws + WS_P); const float* OG = (const float*)(p.ws + WS_OG); const float* YS = (const float*)(p.ws + WS_YS5);
    bf16_t* YC = (bf16_t*)(p.ws + WS_YCAT); bf16_t* YG = (bf16_t*)(p.ws + WS_YG);
    const float* gn = p.in[I_GNORM] + l * 256;
    for (int r = bid * 8 + wave; r < MROWS; r += nb * 8) {
        const float* pr = P + (size_t)r * NINP;
#pragma unroll
        for (int hh = 0; hh < 4; ++hh) { const int col = hh * 256 + 4 * lane;
            const f32x4 o = *(const f32x4*)(OG + (size_t)r * 1024 + col) + *(const f32x4*)(OG + ((size_t)MROWS + r) * 1024 + col);
            const float rs = rsqrtf(wave_sum(o[0] * o[0] + o[1] * o[1] + o[2] * o[2] + o[3] * o[3]) * (1.f / 256.f) + EPS);
            const f32x4 w = *(const f32x4*)(gn + 4 * lane), g = *(const f32x4*)(pr + PGG + col);
            uint2 q; q.x = pk2(o[0] * rs * w[0] * silu_f(g[0]), o[1] * rs * w[1] * silu_f(g[1])); q.y = pk2(o[2] * rs * w[2] * silu_f(g[2]), o[3] * rs * w[3] * silu_f(g[3]));
            *(uint2*)(YC + (size_t)r * DM + col) = q; }
#pragma unroll
        for (int e = 0; e < 2; ++e) { const int col = 4 * lane + 256 * e;
            const f32x4 y = *(const f32x4*)(YS + (size_t)r * 512 + col);
            uint2 q; q.x = pk2(gelu_tanh(y[0]), gelu_tanh(y[1])); q.y = pk2(gelu_tanh(y[2]), gelu_tanh(y[3]));
            *(uint2*)(YG + (size_t)r * 512 + col) = q; }
    }
    const float* HT = (const float*)(p.ws + WS_HT); const float* HTC = HT + (size_t)NB * 2048 * SEQ;
    for (int it = bid; it < N_POSTT; it += nb) {
        const float* src; int LX, b, cb, tb, rbase;
        if (it < NB * 8 * (SEQ / 64)) { LX = SEQ; b = it / (8 * 64); const int q = it % (8 * 64); cb = q >> 6; tb = q & 63; src = HT; rbase = b * SEQ; }
        else { const int i2 = it - NB * 8 * (SEQ / 64); LX = LCX; b = i2 / (8 * 4); const int q = i2 % (8 * 4); cb = q >> 2; tb = q & 3; src = HTC; rbase = NLAT + b * LCX; }
#pragma unroll
        for (int j = 0; j < 8; ++j) { const int i = tid + NT * j, cc = i >> 6, tt = i & 63; tile[tt * 65 + cc] = src[((size_t)(b * 2048 + cb * 64 + cc)) * LX + tb * 64 + tt]; }
        __syncthreads();
        { const int tt = tid >> 3, cq = tid & 7; const float* s = tile + tt * 65 + cq * 8;
          uint4 o; o.x = pk2(s[0], s[1]); o.y = pk2(s[2], s[3]); o.z = pk2(s[4], s[5]); o.w = pk2(s[6], s[7]);
          *(uint4*)(YC + (size_t)(rbase + tb * 64 + tt) * DM + 1536 + cb * 64 + cq * 8) = o; }
        __syncthreads();
    }
}

typedef short bf16x8_t __attribute__((ext_vector_type(8)));
constexpr int NCH = 68;
constexpr size_t GLA_QT = 0;
constexpr size_t GLA_KT = GLA_QT + (size_t)2 * MROWS * 512 * 2;
constexpr size_t GLA_KDT = GLA_KT + (size_t)2 * MROWS * 512 * 2;
constexpr size_t GLA_VT = GLA_KDT + (size_t)2 * NB * 4 * NCH * 8192 * 2;
constexpr size_t GLA_AG = GLA_VT + (size_t)NB * 4 * NCH * 16384 * 2;
constexpr size_t GLA_BYTES = GLA_AG + (size_t)2 * NB * 4 * NCH * 128 * 4;
__device__ __forceinline__ int chunk_row0(int b, int ch) { return ch < 4 ? (NLAT + b * LCX + 64 * ch) : (b * SEQ + 64 * (ch - 4)); }

constexpr int N_GLAPREP = NB * 4 * NCH;
__device__ __forceinline__ void gla_prep_item(const Params& p, int l, int it, float* smem) {
    const int tid = otid(); const int b = it / (4 * NCH), h = (it / NCH) & 3, ch = it % NCH; const int row0 = chunk_row0(b, ch);
    const float* P = (const float*)(p.ws + WS_P); unsigned char* GB = p.ws + WS_GLA;
    float* lrs = smem;
    float* tot = lrs + 64 * 32;
    float* vtile = tot + 2 * 4 * 128;
    for (int i = tid; i < 64 * 32; i += NT) lrs[i] = P[(size_t)(row0 + (i >> 5)) * NINP + PLR + (i & 31)];
#pragma unroll 1
    for (int j = 0; j < 32; ++j) { const int i = tid + NT * j, r = i >> 8, v = i & 255; vtile[r * 257 + v] = P[(size_t)(row0 + r) * NINP + PV + h * 256 + v]; }
    __syncthreads();
    const int k = tid & 127, seg = tid >> 7;
    float G[2][16];
#pragma unroll
    for (int dir = 0; dir < 2; ++dir) {
        float wg[16];
#pragma unroll
        for (int r = 0; r < 16; ++r) wg[r] = p.in[I_GWG][((size_t)(l * 2 + dir) * 16 + r) * 512 + h * 128 + k];
        const float bias = p.in[I_GBG][(l * 2 + dir) * 512 + h * 128 + k];
#pragma unroll
        for (int e = 0; e < 16; ++e) { const float* lr = lrs + (16 * seg + e) * 32 + dir * 16; float z = bias;
#pragma unroll
            for (int r = 0; r < 16; ++r) z += lr[r] * wg[r];
            G[dir][e] = (fminf(z, 0.f) - log1pf(expf(-fabsf(z)))) * (1.f / 16.f); }
        if (dir == 0) {
#pragma unroll
            for (int e = 1; e < 16; ++e) G[0][e] += G[0][e - 1];
            tot[(0 * 4 + seg) * 128 + k] = G[0][15];
        } else {
#pragma unroll
            for (int e = 14; e >= 0; --e) G[1][e] += G[1][e + 1];
            tot[(1 * 4 + seg) * 128 + k] = G[1][0];
        }
    }
    __syncthreads();
#pragma unroll
    for (int dir = 0; dir < 2; ++dir) {
        float off = 0.f, glast = 0.f;
#pragma unroll
        for (int s = 0; s < 4; ++s) { const float t = tot[(dir * 4 + s) * 128 + k]; glast += t; if (dir == 0 ? (s < seg) : (s > seg)) off += t; }
        bf16_t* QT = (bf16_t*)(GB + GLA_QT) + ((size_t)dir * MROWS + row0) * 512 + h * 128 + k;
        bf16_t* KT = (bf16_t*)(GB + GLA_KT) + ((size_t)dir * MROWS + row0) * 512 + h * 128 + k;
        unsigned kd[8];
#pragma unroll
        for (int e = 0; e < 16; e += 2) { float kdv[2];
#pragma unroll
            for (int u = 0; u < 2; ++u) { const int i = 16 * seg + e + u; const float g = G[dir][e + u] + off;
                const float q = P[(size_t)(row0 + i) * NINP + PQ + h * 128 + k] * 0.08838834764831845f, kk = P[(size_t)(row0 + i) * NINP + PK + h * 128 + k];
                QT[(size_t)i * 512] = (bf16_t)(pk2(q * expf(g), 0.f) & 0xffff); KT[(size_t)i * 512] = (bf16_t)(pk2(kk * expf(-g), 0.f) & 0xffff);
                kdv[u] = kk * expf(glast - g); }
            kd[e >> 1] = pk2(kdv[0], kdv[1]); }
        bf16_t* KD = (bf16_t*)(GB + GLA_KDT) + ((((size_t)dir * NB + b) * 4 + h) * NCH + ch) * 8192 + k * 64 + 16 * seg;
        *(uint4*)KD = make_uint4(kd[0], kd[1], kd[2], kd[3]); *(uint4*)(KD + 8) = make_uint4(kd[4], kd[5], kd[6], kd[7]);
        if (seg == 0) ((float*)(GB + GLA_AG))[((((size_t)dir * NB + b) * 4 + h) * NCH + ch) * 128 + k] = expf(glast);
    }
    {
        const int v = tid >> 1, hf = tid & 1; bf16_t* VT = (bf16_t*)(GB + GLA_VT) + (((size_t)b * 4 + h) * NCH + ch) * 16384 + v * 64 + 32 * hf;
#pragma unroll
        for (int c = 0; c < 4; ++c) { const float* s = vtile + (32 * hf + 8 * c) * 257 + v;
            *(uint4*)(VT + 8 * c) = make_uint4(pk2(s[0], s[257]), pk2(s[2 * 257], s[3 * 257]), pk2(s[4 * 257], s[5 * 257]), pk2(s[6 * 257], s[7 * 257])); }
    }
    __syncthreads();
}

constexpr int GQP = 136, GVP = 72;
__device__ __forceinline__ bf16x8_t ldfrag(const bf16_t* base, int pitch, int row0, int k0, int lane) {
    return *(const bf16x8_t*)(base + (row0 + (lane & 15)) * pitch + k0 + (lane >> 4) * 8);
}
__device__ __forceinline__ void gla_seq_item(const Params& p, int it, bf16_t* lds) {
    const int tid = otid(), lane = tid & 63, w = tid >> 6;
    const int b = it >> 5, dir = (it >> 4) & 1, h = (it >> 2) & 3, vs = it & 3;
    unsigned char* GB = p.ws + WS_GLA; float* OG = (float*)(p.ws + WS_OG);
    bf16_t* Qs = lds; bf16_t* Ks = Qs + 64 * GQP; bf16_t* STs = Ks + 64 * GQP; bf16_t* KdTs = STs + 64 * GQP; bf16_t* VTs = KdTs + 128 * GVP; bf16_t* Ps = VTs + 64 * GVP;
    const bf16_t* QTg = (const bf16_t*)(GB + GLA_QT) + (size_t)dir * MROWS * 512 + h * 128;
    const bf16_t* KTg = (const bf16_t*)(GB + GLA_KT) + (size_t)dir * MROWS * 512 + h * 128;
    const bf16_t* KDg = (const bf16_t*)(GB + GLA_KDT) + (((size_t)dir * NB + b) * 4 + h) * NCH * 8192;
    const bf16_t* VTg = (const bf16_t*)(GB + GLA_VT) + ((size_t)b * 4 + h) * NCH * 16384 + vs * 64 * 64;
    const float* AGg = (const float*)(GB + GLA_AG) + (((size_t)dir * NB + b) * 4 + h) * NCH * 128;
    f32x4 S[4];
#pragma unroll
    for (int i = 0; i < 4; ++i) S[i] = (f32x4){0.f, 0.f, 0.f, 0.f};
    uint4 rq0, rq1, rk0, rk1, rd0, rd1, rv; f32x4 an;
#define GLA_LOAD(cs_) do { const int ch_ = dir ? ((cs_) < 4 ? 3 - (cs_) : 71 - (cs_)) : (cs_); const int r0_ = chunk_row0(b, ch_); const int e0_ = tid, e1_ = tid + NT; \
        rq0 = *(const uint4*)(QTg + (size_t)(r0_ + (e0_ >> 4)) * 512 + (e0_ & 15) * 8); rq1 = *(const uint4*)(QTg + (size_t)(r0_ + (e1_ >> 4)) * 512 + (e1_ & 15) * 8); \
        rk0 = *(const uint4*)(KTg + (size_t)(r0_ + (e0_ >> 4)) * 512 + (e0_ & 15) * 8); rk1 = *(const uint4*)(KTg + (size_t)(r0_ + (e1_ >> 4)) * 512 + (e1_ & 15) * 8); \
        rd0 = *(const uint4*)(KDg + (size_t)ch_ * 8192 + e0_ * 8); rd1 = *(const uint4*)(KDg + (size_t)ch_ * 8192 + e1_ * 8); \
        rv = *(const uint4*)(VTg + (size_t)ch_ * 16384 + tid * 8); an = *(const f32x4*)(AGg + ch_ * 128 + 16 * w + (lane >> 4) * 4); } while (0)
    GLA_LOAD(0);
#pragma unroll 1
    for (int cs = 0; cs < NCH; ++cs) {
        const int ch = dir ? (cs < 4 ? 3 - cs : 71 - cs) : cs; const int r0 = chunk_row0(b, ch);
        { const int e0 = tid, e1 = tid + NT;
            *(uint4*)(Qs + (e0 >> 4) * GQP + (e0 & 15) * 8) = rq0; *(uint4*)(Qs + (e1 >> 4) * GQP + (e1 & 15) * 8) = rq1;
            *(uint4*)(Ks + (e0 >> 4) * GQP + (e0 & 15) * 8) = rk0; *(uint4*)(Ks + (e1 >> 4) * GQP + (e1 & 15) * 8) = rk1;
            *(uint4*)(KdTs + (e0 >> 3) * GVP + (e0 & 7) * 8) = rd0; *(uint4*)(KdTs + (e1 >> 3) * GVP + (e1 & 7) * 8) = rd1; }
        *(uint4*)(VTs + (tid >> 3) * GVP + (tid & 7) * 8) = rv;
        const f32x4 ac = an;
#pragma unroll
        for (int vt = 0; vt < 4; ++vt) *(uint2*)(STs + (16 * vt + (lane & 15)) * GQP + 16 * w + (lane >> 4) * 4) = make_uint2(pk2(S[vt][0], S[vt][1]), pk2(S[vt][2], S[vt][3]));
        __syncthreads();
        if (cs + 1 < NCH) GLA_LOAD(cs + 1);
        const int st = w & 3, tt0 = 2 * (w >> 2);
        {
            f32x4 c0 = {0.f, 0.f, 0.f, 0.f}, c1 = c0;
#pragma unroll
            for (int ks = 0; ks < 4; ++ks) { const bf16x8_t a = ldfrag(Ks, GQP, 16 * st, 32 * ks, lane);
                c0 = __builtin_amdgcn_mfma_f32_16x16x32_bf16(a, ldfrag(Qs, GQP, 16 * tt0, 32 * ks, lane), c0, 0, 0, 0);
                c1 = __builtin_amdgcn_mfma_f32_16x16x32_bf16(a, ldfrag(Qs, GQP, 16 * tt0 + 16, 32 * ks, lane), c1, 0, 0, 0); }
            const int s0 = 16 * st + (lane >> 4) * 4;
#pragma unroll
            for (int u = 0; u < 2; ++u) { const f32x4 c = u ? c1 : c0; const int t = 16 * (tt0 + u) + (lane & 15); float m[4];
#pragma unroll
                for (int r = 0; r < 4; ++r) { const bool keep = dir ? (s0 + r > t) : (s0 + r <= t); m[r] = keep ? c[r] : 0.f; }
                *(uint2*)(Ps + t * GVP + s0) = make_uint2(pk2(m[0], m[1]), pk2(m[2], m[3])); }
        }
        f32x4 o0 = {0.f, 0.f, 0.f, 0.f}, o1 = o0;
#pragma unroll
        for (int ks = 0; ks < 4; ++ks) { const bf16x8_t a = ldfrag(STs, GQP, 16 * st, 32 * ks, lane);
            o0 = __builtin_amdgcn_mfma_f32_16x16x32_bf16(a, ldfrag(Qs, GQP, 16 * tt0, 32 * ks, lane), o0, 0, 0, 0);
            o1 = __builtin_amdgcn_mfma_f32_16x16x32_bf16(a, ldfrag(Qs, GQP, 16 * tt0 + 16, 32 * ks, lane), o1, 0, 0, 0); }
#pragma unroll
        for (int vt = 0; vt < 4; ++vt) { S[vt][0] *= ac[0]; S[vt][1] *= ac[1]; S[vt][2] *= ac[2]; S[vt][3] *= ac[3]; }
#pragma unroll
        for (int ks = 0; ks < 2; ++ks) { const bf16x8_t a = ldfrag(KdTs, GVP, 16 * w, 32 * ks, lane);
#pragma unroll
            for (int vt = 0; vt < 4; ++vt) S[vt] = __builtin_amdgcn_mfma_f32_16x16x32_bf16(a, ldfrag(VTs, GVP, 16 * vt, 32 * ks, lane), S[vt], 0, 0, 0); }
        __syncthreads();
#pragma unroll
        for (int ks = 0; ks < 2; ++ks) { const bf16x8_t a = ldfrag(VTs, GVP, 16 * st, 32 * ks, lane);
            o0 = __builtin_amdgcn_mfma_f32_16x16x32_bf16(a, ldfrag(Ps, GVP, 16 * tt0, 32 * ks, lane), o0, 0, 0, 0);
            o1 = __builtin_amdgcn_mfma_f32_16x16x32_bf16(a, ldfrag(Ps, GVP, 16 * tt0 + 16, 32 * ks, lane), o1, 0, 0, 0); }
        { float* og = OG + ((size_t)dir * MROWS + r0 + 16 * tt0 + (lane & 15)) * 1024 + h * 256 + vs * 64 + 16 * st + (lane >> 4) * 4;
          *(f32x4*)og = o0; *(f32x4*)(og + 16 * 1024) = o1; }
        __syncthreads();
    }
#undef GLA_LOAD
}
#ifndef FFT_HD
#define FFT_HD __device__ __forceinline__
#endif
#define PADI(i) ((i) + ((i) >> 5))
constexpr int FFT_N = 8192, FFT_BUF = FFT_N + FFT_N / 32, FFT_TW = 2048 + 512 + 128 + 32 + 8;
struct __attribute__((aligned(8))) cf { float x, y; };
FFT_HD cf cmul(cf a, cf b) { return cf{a.x * b.x - a.y * b.y, a.x * b.y + a.y * b.x}; }
FFT_HD cf cmulc(cf a, cf b) { return cf{a.x * b.x + a.y * b.y, a.y * b.x - a.x * b.y}; }
FFT_HD cf cadd(cf a, cf b) { return cf{a.x + b.x, a.y + b.y}; }
FFT_HD cf csub(cf a, cf b) { return cf{a.x - b.x, a.y - b.y}; }
FFT_HD int fft_twoff(int s) { return s == 0 ? 0 : s == 1 ? 2048 : s == 2 ? 2560 : s == 3 ? 2688 : 2720; }
template <bool INV> FFT_HD void fft_stage4(cf* buf, const cf* tw, int s, int tid) {
    const int lq = 11 - 2 * s, q4 = 1 << lq; const cf* t = tw + fft_twoff(s);
#pragma unroll
    for (int e = 0; e < 4; ++e) {
        const int bf = tid + 512 * e, blk = bf >> lq, j = bf & (q4 - 1), base = (blk << (lq + 2)) + j;
        const int i0 = PADI(base), i1 = PADI(base + q4), i2 = PADI(base + 2 * q4), i3 = PADI(base + 3 * q4);
        const cf w1 = t[j], w2 = cmul(w1, w1), w3 = cmul(w2, w1);
        cf x0 = buf[i0], x1 = buf[i1], x2 = buf[i2], x3 = buf[i3];
        if (INV) { x1 = cmulc(x1, w1); x2 = cmulc(x2, w2); x3 = cmulc(x3, w3); }
        const cf a = cadd(x0, x2), b = csub(x0, x2), c = cadd(x1, x3), d = csub(x1, x3);
        cf y0 = cadd(a, c), y2 = csub(a, c), y1, y3;
        if (!INV) { y1 = cf{b.x + d.y, b.y - d.x}; y3 = cf{b.x - d.y, b.y + d.x}; y1 = cmul(y1, w1); y2 = cmul(y2, w2); y3 = cmul(y3, w3); }
        else      { y1 = cf{b.x - d.y, b.y + d.x}; y3 = cf{b.x + d.y, b.y - d.x}; }
        buf[i0] = y0; buf[i1] = y1; buf[i2] = y2; buf[i3] = y3;
    }
}
template <bool INV> FFT_HD void fft_last8(cf* buf, int tid) {
    const float h = 0.70710678118654752f;
    const cf w[2][4] = {{{1.f, 0.f}, {1.f, 0.f}, {1.f, 0.f}, {1.f, 0.f}}, {{1.f, 0.f}, {h, -h}, {0.f, -1.f}, {-h, -h}}};
#pragma unroll
    for (int e = 0; e < 2; ++e) {
        const int base = PADI((tid + 512 * e) * 8); cf x[8];
#pragma unroll
        for (int i = 0; i < 8; ++i) x[i] = buf[base + i];
        if (!INV) {
#pragma unroll
            for (int j = 0; j < 2; ++j) { const cf a = cadd(x[j], x[j + 4]), b = csub(x[j], x[j + 4]), c = cadd(x[j + 2], x[j + 6]), d = csub(x[j + 2], x[j + 6]);
                x[j] = cadd(a, c); x[j + 2] = cmul(cf{b.x + d.y, b.y - d.x}, w[j][1]); x[j + 4] = cmul(csub(a, c), w[j][2]); x[j + 6] = cmul(cf{b.x - d.y, b.y + d.x}, w[j][3]); }
#pragma unroll
            for (int m = 0; m < 4; ++m) { const cf a = x[2 * m], b = x[2 * m + 1]; x[2 * m] = cadd(a, b); x[2 * m + 1] = csub(a, b); }
        } else {
#pragma unroll
            for (int m = 0; m < 4; ++m) { const cf a = x[2 * m], b = x[2 * m + 1]; x[2 * m] = cadd(a, b); x[2 * m + 1] = csub(a, b); }
#pragma unroll
            for (int j = 0; j < 2; ++j) { const cf u0 = x[j], u1 = cmulc(x[j + 2], w[j][1]), u2 = cmulc(x[j + 4], w[j][2]), u3 = cmulc(x[j + 6], w[j][3]);
                const cf a = cadd(u0, u2), b = csub(u0, u2), c = cadd(u1, u3), d = csub(u1, u3);
                x[j] = cadd(a, c); x[j + 4] = csub(a, c); x[j + 2] = cf{b.x - d.y, b.y + d.x}; x[j + 6] = cf{b.x + d.y, b.y - d.x}; }
        }
#pragma unroll
        for (int i = 0; i < 8; ++i) buf[base + i] = x[i];
    }
}

constexpr int HY_TW_OFF = 24576;
__device__ __forceinline__ void hy_twiddles(float* smem) {
    cf* tw = (cf*)(smem + HY_TW_OFF); const int tid = otid();
    for (int i = tid; i < FFT_TW; i += NT) { int s = 0, j = i; if (i >= 2720) { s = 4; j = i - 2720; } else if (i >= 2688) { s = 3; j = i - 2688; } else if (i >= 2560) { s = 2; j = i - 2560; } else if (i >= 2048) { s = 1; j = i - 2048; }
        const int Ls = 8192 >> (2 * s); float sn, cs; sincospif(-2.0f * (float)j / (float)Ls, &sn, &cs); tw[i] = cf{cs, sn}; }
    __syncthreads();
}
template <bool INV> __device__ __forceinline__ void hy_fft(cf* buf, const cf* tw, int tid) {
    if (!INV) {
#pragma unroll 1
        for (int s = 0; s < 5; ++s) { fft_stage4<false>(buf, tw, s, tid); __syncthreads(); }
        fft_last8<false>(buf, tid); __syncthreads();
    } else {
        fft_last8<true>(buf, tid); __syncthreads();
#pragma unroll 1
        for (int s = 4; s >= 0; --s) { fft_stage4<true>(buf, tw, s, tid); __syncthreads(); }
    }
}
__device__ __forceinline__ void hy_spec_item(const Params& p, int it, float* smem) {
    const int tid = otid(); cf* buf = (cf*)smem; const cf* tw = (const cf*)(smem + HY_TW_OFF);
    const float* src = (const float*)(p.ws + WS_TP) + (size_t)it * 8192; cf* HS = (cf*)(p.ws + WS_HS) + (size_t)it * 8192;
#pragma unroll 4
    for (int e = 0; e < 16; ++e) { const int j = tid + NT * e, idx = (j + 4095) & 8191; buf[PADI(j)] = cf{idx == 8191 ? 0.f : src[idx], 0.f}; }
    __syncthreads();
    hy_fft<false>(buf, tw, tid);
#pragma unroll 4
    for (int e = 0; e < 16; ++e) { const int i = tid + NT * e; const cf v = buf[PADI(i)]; HS[i] = cf{v.x * (1.f / 8192.f), v.y * (1.f / 8192.f)}; }
    __syncthreads();
}
__device__ __forceinline__ float hy_short(const float* s, int t, float w0, float w1, float w2, float bb) {
    const float a = (t > 0) ? s[t - 1] : 0.f, m = s[t], n = (t < SEQ - 1) ? s[t + 1] : 0.f; return w0 * a + w1 * m + w2 * n + bb;
}
__device__ __forceinline__ void hy_fft_item(const Params& p, int l, int c, float* smem) {
    const int tid = otid(); cf* buf = (cf*)smem; const cf* tw = (const cf*)(smem + HY_TW_OFF);
    float* HT = (float*)(p.ws + WS_HT); const cf* HS = (const cf*)(p.ws + WS_HS);
    const float* cw = p.in[I_HCW] + (size_t)l * 3 * 1536; const float* cb = p.in[I_HCB] + (size_t)l * 1536; const float* hd = p.in[I_HD] + (size_t)l * 2 * 512;
    float v0[8], v1[8];
    { const float w0 = cw[c], w1 = cw[1536 + c], w2 = cw[2 * 1536 + c], bb = cb[c]; const float* s0 = HT + (size_t)c * SEQ; const float* s1 = HT + (size_t)(2048 + c) * SEQ;
#pragma unroll
      for (int e = 0; e < 8; ++e) { const int t = tid + NT * e; v0[e] = hy_short(s0, t, w0, w1, w2, bb); v1[e] = hy_short(s1, t, w0, w1, w2, bb);
          buf[PADI(t)] = cf{v0[e], v1[e]}; buf[PADI(4096 + t)] = cf{0.f, 0.f}; } }
    __syncthreads();
    hy_fft<false>(buf, tw, tid);
    { const cf* H = HS + (size_t)c * 8192;
#pragma unroll 4
      for (int e = 0; e < 16; ++e) { const int i = tid + NT * e; buf[PADI(i)] = cmul(buf[PADI(i)], H[i]); } }
    __syncthreads();
    hy_fft<true>(buf, tw, tid);
    float z0[8], z1[8];
    { const int ch = 512 + c; const float w0 = cw[ch], w1 = cw[1536 + ch], w2 = cw[2 * 1536 + ch], bb = cb[ch]; const float d0 = hd[c];
      const float* s0 = HT + (size_t)ch * SEQ; const float* s1 = HT + (size_t)(2048 + ch) * SEQ;
#pragma unroll
      for (int e = 0; e < 8; ++e) { const int t = tid + NT * e; const cf y = buf[PADI(t)];
          z0[e] = hy_short(s0, t, w0, w1, w2, bb) * (y.x + d0 * v0[e]); z1[e] = hy_short(s1, t, w0, w1, w2, bb) * (y.y + d0 * v1[e]); } }
    __syncthreads();
#pragma unroll
    for (int e = 0; e < 8; ++e) { const int t = tid + NT * e; buf[PADI(t)] = cf{z0[e], z1[e]}; buf[PADI(4096 + t)] = cf{0.f, 0.f}; }
    __syncthreads();
    hy_fft<false>(buf, tw, tid);
    { const cf* H = HS + (size_t)(512 + c) * 8192;
#pragma unroll 4
      for (int e = 0; e < 16; ++e) { const int i = tid + NT * e; buf[PADI(i)] = cmul(buf[PADI(i)], H[i]); } }
    __syncthreads();
    hy_fft<true>(buf, tw, tid);
    { const int ch = 1024 + c; const float w0 = cw[ch], w1 = cw[1536 + ch], w2 = cw[2 * 1536 + ch], bb = cb[ch]; const float d1 = hd[512 + c];
      const float* s0 = HT + (size_t)ch * SEQ; const float* s1 = HT + (size_t)(2048 + ch) * SEQ;
      const float* g0 = HT + (size_t)(1536 + c) * SEQ; const float* g1 = HT + (size_t)(2048 + 1536 + c) * SEQ;
#pragma unroll
      for (int e = 0; e < 8; ++e) { const int t = tid + NT * e; const cf y = buf[PADI(t)];
          HT[(size_t)c * SEQ + t] = hy_short(s0, t, w0, w1, w2, bb) * (y.x + d1 * z0[e]) * silu_f(g0[t]);
          HT[(size_t)(2048 + c) * SEQ + t] = hy_short(s1, t, w0, w1, w2, bb) * (y.y + d1 * z1[e]) * silu_f(g1[t]); } }
    __syncthreads();
}

constexpr size_t S5W_WA = 0;
constexpr size_t S5W_KW = S5W_WA + (size_t)32 * 2 * 128 * 256 * 2;
constexpr size_t S5W_L16 = S5W_KW + (size_t)32 * 256 * 512 * 2;
constexpr size_t S5W_XI = S5W_L16 + (size_t)32 * 2 * 64 * 2 * 4;
constexpr size_t S5W_BYTES = S5W_XI + (size_t)32 * NB * 272 * 256 * 2;
__device__ __forceinline__ int s5_row(int b, int n, int s) { return n < 16 ? (NLAT + b * LCX + 16 * n + s) : (b * SEQ + 16 * (n - 16) + s); }

__device__ __forceinline__ void s5_weights_item(const Params& p, int l, int g, float* smem) {
    const int tid = otid();
    cf* pw = (cf*)smem;
    cf* Bb = pw + 2 * 17 * 64;
    cf* Cc = Bb + 2 * 64 * 16;
    float* KT = (float*)(Cc + 2 * 16 * 64);
    unsigned char* WB = p.ws + WS_S5W;
    for (int i = tid; i < 2 * 17 * 64; i += NT) { const int d = i / (17 * 64), e = (i / 64) % 17, q = i & 63; const size_t pg = ((size_t)(l * 2 + d) * 32 + g);
        const float lr = p.in[I_LRE][pg * 64 + q], li = p.in[I_LIM][pg * 64 + q], step = expf(p.in[I_LSTEP][pg]);
        const float em = expf((float)e * lr * step); float sn, cs; sincosf((float)e * li * step, &sn, &cs); pw[i] = cf{em * cs, em * sn}; }
    for (int i = tid; i < 2 * 64 * 16; i += NT) { const int d = i >> 10, q = (i >> 4) & 63, hh = i & 15; const size_t pg = ((size_t)(l * 2 + d) * 32 + g);
        const float lr = p.in[I_LRE][pg * 64 + q], li = p.in[I_LIM][pg * 64 + q], step = expf(p.in[I_LSTEP][pg]);
        const float em1 = expm1f(lr * step); float sn, cs; sincosf(li * step, &sn, &cs); const float shf = sinf(0.5f * li * step);
        const float nr = em1 * cs - 2.f * shf * shf, ni = (em1 + 1.f) * sn, den = lr * lr + li * li;
        const float cr = (nr * lr + ni * li) / den, ci = (ni * lr - nr * li) / den;
        const float br = p.in[I_BRE][(pg * 64 + q) * 16 + hh], bi = p.in[I_BIM][(pg * 64 + q) * 16 + hh];
        Bb[i] = cf{cr * br - ci * bi, cr * bi + ci * br}; }
    for (int i = tid; i < 2 * 16 * 64; i += NT) { const int d = i >> 10; const size_t pg = ((size_t)(l * 2 + d) * 32 + g); Cc[i] = cf{p.in[I_CRE][pg * 1024 + (i & 1023)], p.in[I_CIM][pg * 1024 + (i & 1023)]}; }
    __syncthreads();
    if (tid < 128) { const int d = tid >> 6, q = tid & 63; const cf v = pw[(d * 17 + 16) * 64 + q]; float* L16 = (float*)(WB + S5W_L16) + ((size_t)g * 2 + d) * 128 + 2 * q; L16[0] = v.x; L16[1] = v.y; }
#pragma unroll 1
    for (int i = tid; i < 2 * 16 * 256; i += NT) { const int d = i >> 12, tau = (i >> 8) & 15, hp = (i >> 4) & 15, hh = i & 15; float s = 0.f;
#pragma unroll 4
        for (int q = 0; q < 64; ++q) { const cf m = cmul(cmul(Cc[(d * 16 + hp) * 64 + q], pw[(d * 17 + tau) * 64 + q]), Bb[(d * 64 + q) * 16 + hh]); s += m.x; }
        KT[i] = s; }
    __syncthreads();
    bf16_t* WA = (bf16_t*)(WB + S5W_WA) + (size_t)g * 2 * 128 * 256; bf16_t* KW = (bf16_t*)(WB + S5W_KW) + (size_t)g * 256 * 512;
#pragma unroll 1
    for (int i = tid; i < 2 * 128 * 256 / 2; i += NT) { const int i2 = 2 * i; const int d = i2 >> 15, rq = (i2 >> 8) & 127, col = i2 & 255; const int ri = rq >> 6, q = rq & 63, s = col >> 4, hh = col & 15;
        const int e = d ? s : 15 - s; const cf w = pw[(d * 17 + e) * 64 + q]; const cf m0 = cmul(w, Bb[(d * 64 + q) * 16 + hh]), m1 = cmul(w, Bb[(d * 64 + q) * 16 + hh + 1]);
        *(unsigned*)(WA + i2) = pk2(ri ? m0.y : m0.x, ri ? m1.y : m1.x); }
#pragma unroll 1
    for (int i = tid; i < 256 * 512 / 2; i += NT) { const int i2 = 2 * i; const int row = i2 >> 9, col = i2 & 511; const int t = row >> 4, hp = row & 15; float v[2];
#pragma unroll
        for (int u = 0; u < 2; ++u) { const int c = col + u;
            if (c < 256) { const int s = c >> 4, hh = c & 15; float a = 0.f; if (s <= t) a += KT[(0 * 16 + (t - s)) * 256 + hp * 16 + hh]; if (s >= t) a += KT[(1 * 16 + (s - t)) * 256 + hp * 16 + hh];
                if (s == t && hh == hp) a += p.in[I_S5D][l * 512 + g * 16 + hp]; v[u] = a; }
            else { const int c2 = c - 256, d = c2 >> 7, ri = (c2 >> 6) & 1, q = c2 & 63; const int e = d ? 16 - t : t + 1; const cf m = cmul(Cc[(d * 16 + hp) * 64 + q], pw[(d * 17 + e) * 64 + q]); v[u] = ri ? -m.y : m.x; } }
        *(unsigned*)(KW + i2) = pk2(v[0], v[1]); }
    __syncthreads();
}

constexpr int S5P = 520;
__device__ __forceinline__ void s5_load_u(const float* P, int b, int g, int mt, bf16_t* At, int tid) {
    const int row = tid >> 5, part = tid & 31, s = part >> 1, h8 = (part & 1) * 8; const float* src = P + (size_t)s5_row(b, 16 * mt + row, s) * NINP + PU + 16 * g + h8;
    const f32x4 a = *(const f32x4*)src, c = *(const f32x4*)(src + 4);
    *(uint4*)(At + row * S5P + 16 * s + h8) = make_uint4(pk2(a[0], a[1]), pk2(a[2], a[3]), pk2(c[0], c[1]), pk2(c[2], c[3]));
}
__device__ __forceinline__ void s5_item(const Params& p, int it, float* smem) {
    const int tid = otid(), lane = tid & 63, w = tid >> 6; const int g = it >> 1, b = it & 1;
    const float* P = (const float*)(p.ws + WS_P); unsigned char* WB = p.ws + WS_S5W; float* YS = (float*)(p.ws + WS_YS5);
    bf16_t* At = (bf16_t*)smem;
    float* Et = smem + (16 * S5P) / 2;
    bf16_t* XI = (bf16_t*)(WB + S5W_XI) + ((size_t)g * NB + b) * 272 * 256;
#pragma unroll 1
    for (int d = 0; d < 2; ++d) {
        const bf16_t* WA = (const bf16_t*)(WB + S5W_WA) + ((size_t)g * 2 + d) * 128 * 256;
        bf16x8_t bfr[8];
#pragma unroll
        for (int ks = 0; ks < 8; ++ks) bfr[ks] = *(const bf16x8_t*)(WA + (size_t)(16 * w + (lane & 15)) * 256 + 32 * ks + (lane >> 4) * 8);
        float xr = 0.f, xi = 0.f, l16r = 0.f, l16i = 0.f;
        if (tid < 64) { const float* L16 = (const float*)(WB + S5W_L16) + ((size_t)g * 2 + d) * 128 + 2 * tid; l16r = L16[0]; l16i = L16[1]; }
#pragma unroll 1
        for (int k = 0; k < 17; ++k) {
            const int mt = d ? (k == 0 ? 0 : 17 - k) : k;
            s5_load_u(P, b, g, mt, At, tid);
            __syncthreads();
            f32x4 acc = {0.f, 0.f, 0.f, 0.f};
#pragma unroll
            for (int ks = 0; ks < 8; ++ks) acc = __builtin_amdgcn_mfma_f32_16x16x32_bf16(ldfrag(At, S5P, 0, 32 * ks, lane), bfr[ks], acc, 0, 0, 0);
#pragma unroll
            for (int r = 0; r < 4; ++r) Et[((lane >> 4) * 4 + r) * 132 + 16 * w + (lane & 15)] = acc[r];
            __syncthreads();
            if (tid < 64) {
#pragma unroll 1
                for (int i = 0; i < 16; ++i) { const int m = d ? 15 - i : i; bf16_t* xo = XI + (size_t)(16 * mt + m) * 256 + d * 128 + tid;
                    xo[0] = (bf16_t)(pk2(xr, 0.f) & 0xffff); xo[64] = (bf16_t)(pk2(xi, 0.f) & 0xffff);
                    const float er = Et[m * 132 + tid], ei = Et[m * 132 + 64 + tid]; const float nr = l16r * xr - l16i * xi + er, ni = l16r * xi + l16i * xr + ei; xr = nr; xi = ni; }
            }
            __syncthreads();
        }
    }
    {
        const bf16_t* KW = (const bf16_t*)(WB + S5W_KW) + (size_t)g * 256 * 512;
        bf16x8_t bw[2][16];
#pragma unroll
        for (int u = 0; u < 2; ++u)
#pragma unroll
            for (int ks = 0; ks < 16; ++ks) bw[u][ks] = *(const bf16x8_t*)(KW + (size_t)(32 * w + 16 * u + (lane & 15)) * 512 + 32 * ks + (lane >> 4) * 8);
#pragma unroll 1
        for (int mt = 0; mt < 17; ++mt) {
            s5_load_u(P, b, g, mt, At, tid);
            { const int row = tid >> 5, c16 = tid & 31; *(uint4*)(At + row * S5P + 256 + c16 * 8) = *(const uint4*)(XI + (size_t)(16 * mt + row) * 256 + c16 * 8); }
            __syncthreads();
            f32x4 a0 = {0.f, 0.f, 0.f, 0.f}, a1 = a0;
#pragma unroll
            for (int ks = 0; ks < 16; ++ks) { const bf16x8_t af = ldfrag(At, S5P, 0, 32 * ks, lane);
                a0 = __builtin_amdgcn_mfma_f32_16x16x32_bf16(af, bw[0][ks], a0, 0, 0, 0); a1 = __builtin_amdgcn_mfma_f32_16x16x32_bf16(af, bw[1][ks], a1, 0, 0, 0); }
#pragma unroll
            for (int r = 0; r < 4; ++r) { const int n = 16 * mt + (lane >> 4) * 4 + r;
                YS[(size_t)s5_row(b, n, 2 * w) * 512 + 16 * g + (lane & 15)] = a0[r]; YS[(size_t)s5_row(b, n, 2 * w + 1) * 512 + 16 * g + (lane & 15)] = a1[r]; }
            __syncthreads();
        }
    }
}

__device__ __forceinline__ void phase_inproj(const Params& p, int l, int bid, int nb, LAS unsigned char* lds) {
    pg8::Gemm g{(const bf16_t*)(p.ws + WS_H), (const bf16_t*)(p.ws + WS_WIN) + (size_t)l * NINP * DM, MROWS, NINP, DM};
    pg8::StaticOrder S; S.init(MROWS, NINP, nb, bid);
    pg8::EpiF32 E{(float*)(p.ws + WS_P), NINP};
    pg8::gemm_phase<pg8::EpiF32, pg8::StaticOrder, true, true>(lds, g, S, E);
}
__device__ __forceinline__ void phase_glu(const Params& p, int l, int bid, int nb, LAS unsigned char* lds) {
    pg8::Gemm g{(const bf16_t*)(p.ws + WS_YG), (const bf16_t*)(p.ws + WS_WGLU) + (size_t)l * 512 * 512, MROWS, 512, 512};
    pg8::StaticOrder S; S.init(MROWS, 512, nb, bid);
    pg8::EpiGlu E{(const bf16_t*)(p.ws + WS_YG), (const float*)(p.ws + WS_P) + PSG, NINP, p.in[I_BGLU] + l * 512, (bf16_t*)(p.ws + WS_YCAT) + 1024, DM};
    pg8::gemm_phase<pg8::EpiGlu, pg8::StaticOrder, true, true>(lds, g, S, E);
}
__device__ __forceinline__ void phase_outproj(const Params& p, int l, int bid, int nb, LAS unsigned char* lds) {
    pg8::Gemm g{(const bf16_t*)(p.ws + WS_YCAT), (const bf16_t*)(p.ws + WS_WOUT) + (size_t)l * DM * DM, MROWS, DM, DM};
    pg8::StaticOrder S; S.init(MROWS, DM, nb, bid);
    pg8::EpiF32 E{(float*)(p.ws + WS_P), DM};
    pg8::gemm_phase<pg8::EpiF32, pg8::StaticOrder, true, true>(lds, g, S, E);
}

static_assert(GLA_BYTES <= (size_t)80 * 1024 * 1024 && S5W_BYTES <= (size_t)24 * 1024 * 1024, "GLA / S5 workspace");
constexpr int LDS_BYTES = 147456;
enum { PH_PRO = 0, PH_TAPS, PH_ROW, PH_INPROJ, PH_HYT, PH_MIX, PH_POST, PH_GLU, PH_OUTPROJ };

template <int PH>
__global__ void __launch_bounds__(NT, 2) k_phase(Params p, int l) {
    extern __shared__ __attribute__((aligned(16))) unsigned char lds[];
    float* smem = (float*)lds; const int bid = blockIdx.x, nb = gridDim.x;
    if (PH == PH_PRO) { phase_weights(p, bid, nb, smem); phase_mod(p, bid, nb, smem); }
    if (PH == PH_TAPS) phase_taps(p, l, bid, nb, smem);
    if (PH == PH_ROW) phase_row(p, l, bid, nb);
    if (PH == PH_INPROJ) phase_inproj(p, l, bid, nb, (LAS unsigned char*)lds);
    if (PH == PH_HYT) phase_hyT(p, bid, nb, smem);
    if (PH == PH_MIX) {
        if (bid < 16) phase_gla_naive(p, l, bid, 16, smem);
        else if (bid < 32) phase_s5_naive(p, l, bid - 16, 16, smem);
        else phase_hy_naive(p, l, bid - 32, nb - 32, smem);
    }
    if (PH == PH_POST) phase_post(p, l, bid, nb, smem);
    if (PH == PH_GLU) phase_glu(p, l, bid, nb, (LAS unsigned char*)lds);
    if (PH == PH_OUTPROJ) phase_outproj(p, l, bid, nb, (LAS unsigned char*)lds);
}


namespace cg = cooperative_groups;
__global__ void __launch_bounds__(NT, 2) k_mega(Params p) {
    extern __shared__ __attribute__((aligned(16))) unsigned char lds[];
    cg::grid_group grid = cg::this_grid();
    float* smem = (float*)lds; const int bid = blockIdx.x, nb = gridDim.x;
    phase_weights(p, bid, nb, smem); phase_mod(p, bid, nb, smem); phase_taps(p, 0, bid, nb, smem);
    grid.sync();
#pragma unroll 1
    for (int l0 = 0; l0 < DEPTH; ++l0) {
        int l = l0; asm volatile("" : "+s"(l));
        phase_row(p, l, bid, nb);
        if (l > 0) phase_taps(p, l, bid, nb, smem);
        for (int g = nb - 1 - bid; g < 32; g += nb) s5_weights_item(p, l, g, smem);
        grid.sync();
        phase_inproj(p, l, bid, nb, (LAS unsigned char*)lds);
        grid.sync();
        phase_hyT(p, bid, nb, smem);
        for (int it = bid; it < N_GLAPREP; it += nb) gla_prep_item(p, l, it, smem);
        hy_twiddles(smem);
        for (int it = bid; it < 1024; it += nb) hy_spec_item(p, it, smem);
        grid.sync();
        if (bid < 64) gla_seq_item(p, bid, (bf16_t*)lds);
        else if (bid < 128) s5_item(p, bid - 64, smem);
        else { hy_twiddles(smem);
            for (int c = bid - 128; c < 512; c += nb - 128) hy_fft_item(p, l, c, smem);
            float* HTC = (float*)(p.ws + WS_HT) + (size_t)NB * 2048 * SEQ; const float* TPC = (const float*)(p.ws + WS_TP) + (size_t)2 * 512 * 2 * SEQ;
            for (int c = bid - 128; c < 512; c += nb - 128) hy_naive_item<LCX, 1>(p, l, TPC, HTC, c, smem); }
        grid.sync();
        phase_post(p, l, bid, nb, smem);
        grid.sync();
        phase_glu(p, l, bid, nb, (LAS unsigned char*)lds);
        grid.sync();
        phase_outproj(p, l, bid, nb, (LAS unsigned char*)lds);
        grid.sync();
    }
    phase_row(p, DEPTH, bid, nb);
}

#ifndef MULTI_LAUNCH
#define MULTI_LAUNCH 0
#endif
template <int PH> static void launch_phase(const Params& p, int l, int grid, hipStream_t stream) {
    static bool attr = false;
    if (!attr) { (void)hipFuncSetAttribute((const void*)k_phase<PH>, hipFuncAttributeMaxDynamicSharedMemorySize, LDS_BYTES); attr = true; }
    hipLaunchKernelGGL(k_phase<PH>, dim3(grid), dim3(NT), LDS_BYTES, stream, p, l);
}

extern "C" void kernel_launch(void* const* d_in, const int* in_sizes, int n_in, void* d_out, int out_size, void* d_ws, size_t ws_size, hipStream_t stream) {
    if (n_in != 33 || out_size != NLAT * DM || ws_size < WS_END) { fprintf(stderr, "kernel_launch: unexpected problem (n_in %d out %d ws %zu need %zu)\n", n_in, out_size, ws_size, (size_t)WS_END); return; }
    Params p{};
    for (int i = 0; i < 33; ++i) p.in[i] = (const float*)d_in[i];
    p.out = (float*)d_out; p.ws = (unsigned char*)d_ws;
#if MULTI_LAUNCH
    const int G = 256;
    launch_phase<PH_PRO>(p, 0, G, stream);
    for (int l = 0; l < DEPTH; ++l) {
        launch_phase<PH_TAPS>(p, l, G, stream);
        launch_phase<PH_ROW>(p, l, G, stream);
        launch_phase<PH_INPROJ>(p, l, G, stream);
        launch_phase<PH_HYT>(p, l, G, stream);
        launch_phase<PH_MIX>(p, l, G, stream);
        launch_phase<PH_POST>(p, l, G, stream);
        launch_phase<PH_GLU>(p, l, G, stream);
        launch_phase<PH_OUTPROJ>(p, l, G, stream);
    }
    launch_phase<PH_ROW>(p, DEPTH, G, stream);
#else
    static int grid_blocks = 0;
    if (!grid_blocks) {
        int dev = 0, cus = 0, per_cu = 0;
        (void)hipGetDevice(&dev);
        (void)hipDeviceGetAttribute(&cus, hipDeviceAttributeMultiprocessorCount, dev);
        (void)hipFuncSetAttribute((const void*)k_mega, hipFuncAttributeMaxDynamicSharedMemorySize, LDS_BYTES);
        (void)hipOccupancyMaxActiveBlocksPerMultiprocessor(&per_cu, (const void*)k_mega, NT, LDS_BYTES);
        if (per_cu < 1) { fprintf(stderr, "kernel_launch: occupancy query says %d blocks per CU\n", per_cu); per_cu = 1; }
        grid_blocks = cus;
        fprintf(stderr, "kernel_launch: cus %d per_cu %d grid %d\n", cus, per_cu, grid_blocks);
    }
    void* args[] = {&p};
    hipError_t e = hipLaunchCooperativeKernel((const void*)k_mega, dim3(grid_blocks), dim3(NT), args, LDS_BYTES, stream);
    if (e != hipSuccess) fprintf(stderr, "cooperative launch failed: %s (grid %d)\n", hipGetErrorString(e), grid_blocks);
#endif
}
```

```cpp
#include <hip/hip_runtime.h>
#include <hip/hip_cooperative_groups.h>
#include <cstdio>
#include <cstdint>
#include <cmath>
namespace pg8 {
#define PG8_LAS __attribute__((address_space(3)))
typedef unsigned short bf16_t;
typedef short bf16x8 __attribute__((ext_vector_type(8)));
typedef float f32x4 __attribute__((ext_vector_type(4)));
typedef unsigned u32x4 __attribute__((ext_vector_type(4)));
constexpr int BM = 256, BK = 64, HALF = 128, HTB = HALF * BK * 2  , STAGE_BYTES = 8 * HTB, NXCD = 8, WGM = 8;

__host__ __device__ __forceinline__ int lds_byte(int r, int c) { const int st = (r >> 4) * 2 + (c >> 5), rr = r & 15, cc = c & 31, ob = rr * 64 + cc * 2; return st * 1024 + (ob ^ (((ob >> 9) & 1) << 5)); }
__host__ __device__ __forceinline__ void stage_rc(int b, int& R, int& C) { const int st = b / 1024, sb = b % 1024, swz = sb ^ (((sb >> 9) & 1) << 5); R = (st >> 1) * 16 + swz / 64; C = (st & 1) * 32 + (swz % 64) / 2; }
__host__ __device__ __forceinline__ int perm32(int rho) { const int n = rho >> 4, i = rho & 15; return 8 * (i >> 2) + 4 * n + (i & 3); }

struct Unit { int pm, pn; };
struct Gemm { const bf16_t* A; const bf16_t* Bt; int M, N, K; };

struct StaticOrder {
    int nM, nN, nwg, G, c;
    __host__ __device__ void init(int M, int N, int G_, int c_) { nM = M / BM; nN = N / BM; nwg = nM * nN; G = G_; c = c_; }
    __host__ __device__ bool next(int i, Unit& u) const {
        const long L = (long)i * G + c; if (L >= nwg) return false;
        int wgid = (int)L; { const int q = nwg / NXCD, r = nwg % NXCD, xcd = wgid % NXCD, off = wgid / NXCD; wgid = (xcd < r ? xcd * (q + 1) : r * (q + 1) + (xcd - r) * q) + off; }
        const int nig = WGM * nN, gid = wgid / nig, fm = gid * WGM, gsz = (nM - fm) < WGM ? (nM - fm) : WGM;
        u.pm = fm + ((wgid % nig) % gsz); u.pn = (wgid % nig) / gsz; return true;
    }
    __device__ __forceinline__ void a_ready(const Unit&) const {}
    __device__ __forceinline__ void done(const Unit&) const {}
};


__device__ __forceinline__ unsigned cvt_pk_bf16(float lo, float hi) { unsigned r; asm volatile("v_cvt_pk_bf16_f32 %0, %1, %2" : "=v"(r) : "v"(lo), "v"(hi)); return r; }
__device__ __forceinline__ float bf2f(unsigned short h) { return __builtin_bit_cast(float, (unsigned)h << 16); }

struct EpiF32 {
    static constexpr bool PERM = false, AFTER_DRAIN = false;
    float* O; int ldc;
    __device__ __forceinline__ void operator()(const f32x4 (&acc)[2][2][4][2], const Unit& u, int wr, int wc, int fr, int fq) const {
        const int row0 = u.pm * BM + wr * 64 + fr, col0 = u.pn * BM + wc * 32 + 4 * fq;
#pragma unroll
        for (int ai = 0; ai < 2; ++ai)
#pragma unroll
            for (int m = 0; m < 4; ++m) { float* rowp = O + (size_t)(row0 + ai * HALF + m * 16) * ldc + col0;
#pragma unroll
                for (int bj = 0; bj < 2; ++bj)
#pragma unroll
                    for (int n = 0; n < 2; ++n) *(f32x4*)(rowp + bj * HALF + n * 16) = acc[ai][bj][m][n]; }
    }
};
struct EpiGlu {
    static constexpr bool PERM = false, AFTER_DRAIN = false;
    const bf16_t* YG; const float* Psg; int ldp; const float* bg; bf16_t* Y; int ldy;
    __device__ __forceinline__ void operator()(const f32x4 (&acc)[2][2][4][2], const Unit& u, int wr, int wc, int fr, int fq) const {
        const int row0 = u.pm * BM + wr * 64 + fr, col0 = u.pn * BM + wc * 32 + 4 * fq;
#pragma unroll
        for (int ai = 0; ai < 2; ++ai)
#pragma unroll
            for (int m = 0; m < 4; ++m) { const size_t row = (size_t)(row0 + ai * HALF + m * 16);
#pragma unroll
                for (int bj = 0; bj < 2; ++bj)
#pragma unroll
                    for (int n = 0; n < 2; ++n) { const int col = col0 + bj * HALF + n * 16;
                        const f32x4 a = acc[ai][bj][m][n]; const f32x4 b = *(const f32x4*)(bg + col); const f32x4 sg = *(const f32x4*)(Psg + row * ldp + col);
                        const uint2 y2 = *(const uint2*)(YG + row * 512 + col);
                        float yv[4] = {bf2f((unsigned short)(y2.x & 0xffff)), bf2f((unsigned short)(y2.x >> 16)), bf2f((unsigned short)(y2.y & 0xffff)), bf2f((unsigned short)(y2.y >> 16))};
                        float o[4];
#pragma unroll
                        for (int e = 0; e < 4; ++e) { const float z = a[e] + b[e]; const float s = 1.f / (1.f + __expf(-z)); const float g = sg[e]; const float sl = g / (1.f + __expf(-g)); o[e] = yv[e] * s * sl; }
                        uint2 w; w.x = cvt_pk_bf16(o[0], o[1]); w.y = cvt_pk_bf16(o[2], o[3]);
                        *(uint2*)(Y + row * ldy + col) = w; } }
    }
};
template <class Epi, class Sched, bool ALIGN_EPI = false, bool SP2 = false>
__device__ __forceinline__ void gemm_phase(PG8_LAS unsigned char* lds, const Gemm g, const Sched& S, const Epi& E) {
    int tid_o = threadIdx.x; asm volatile("" : "+v"(tid_o)); const int tid = tid_o, wid = __builtin_amdgcn_readfirstlane(tid >> 6), lane = tid & 63, wr = wid >> 2, wc = wid & 3, fr = lane & 15, fq = lane >> 4;
    const int K = g.K, nt = K / BK;
    unsigned voffA[2], voffB[2];
#pragma unroll
    for (int i = 0; i < 2; ++i) { int R, C; stage_rc(tid * 16 + i * 8192, R, C); const int Rb = Epi::PERM ? ((R & ~31) + perm32(R & 31)) : R;
        voffA[i] = (unsigned)(R * K + C) * 2u; voffB[i] = (unsigned)(Rb * K + C) * 2u; }
    const size_t kstep = (size_t)(BK * 2);
    const size_t hstep = (size_t)HALF * K * 2;
    const size_t tstep = 2 * hstep;
    const unsigned ldsw = (unsigned)wid * 1024u;
    const int aoff = lds_byte(wr * 64 + fr, fq * 8), boff = lds_byte(wc * 32 + fr, fq * 8);
#define PG8_SA(b, h) (((b) * 2 + (h)) * HTB)
#define PG8_SB(b, h) ((4 + (b) * 2 + (h)) * HTB)
#define PG8_STAGE(bufoff, gbase, voff) do { _Pragma("unroll") for (int _i = 0; _i < 2; ++_i) \
        __builtin_amdgcn_global_load_lds((const unsigned*)((const char*)(gbase) + (voff)[_i]), (PG8_LAS unsigned*)(lds + (bufoff) + ldsw + _i * 8192), 16, 0, 0); } while (0)
#define PG8_LDA(dst, b, h) do { _Pragma("unroll") for (int m = 0; m < 4; ++m) _Pragma("unroll") for (int k = 0; k < 2; ++k) dst[m][k] = *(const PG8_LAS bf16x8*)(lds + PG8_SA(b, h) + aoff + m * 2048 + k * 1024); } while (0)
#define PG8_LDB(dst, b, h) do { _Pragma("unroll") for (int n = 0; n < 2; ++n) _Pragma("unroll") for (int k = 0; k < 2; ++k) dst[n][k] = *(const PG8_LAS bf16x8*)(lds + PG8_SB(b, h) + boff + n * 2048 + k * 1024); } while (0)
#define PG8_MMA(ai, bj, At, Bt) do { __builtin_amdgcn_s_setprio(1); _Pragma("unroll") for (int m = 0; m < 4; ++m) _Pragma("unroll") for (int n = 0; n < 2; ++n) _Pragma("unroll") for (int k = 0; k < 2; ++k) \
        acc[ai][bj][m][n] = __builtin_amdgcn_mfma_f32_16x16x32_bf16(Bt[n][k], At[m][k], acc[ai][bj][m][n], 0, 0, 0); __builtin_amdgcn_s_setprio(0); } while (0)
#define PG8_WAIT_V(n) asm volatile("s_waitcnt vmcnt(" #n ")" ::: "memory")
#define PG8_WAIT_L(n) asm volatile("s_waitcnt lgkmcnt(" #n ")" ::: "memory")
#define PG8_BAR __builtin_amdgcn_s_barrier()
#define PG8_SCHED __builtin_amdgcn_sched_barrier(0)
    Unit cur, nxt; int ui = 0;
    if (!S.next(0, cur)) return;
    f32x4 acc[2][2][4][2];
#pragma unroll
    for (int a = 0; a < 2; ++a)
#pragma unroll
        for (int b = 0; b < 2; ++b)
#pragma unroll
            for (int m = 0; m < 4; ++m)
#pragma unroll
                for (int n = 0; n < 2; ++n) acc[a][b][m][n] = (f32x4){0.f, 0.f, 0.f, 0.f};
    bf16x8 At[4][2], B0[2][2], B1[2][2];
    const char* cA = (const char*)g.A + (size_t)cur.pm * tstep; const char* cB = (const char*)g.Bt + (size_t)cur.pn * tstep;
    S.a_ready(cur);
    if constexpr (SP2) {
        PG8_STAGE(PG8_SB(0, 0), cB, voffB); PG8_STAGE(PG8_SB(0, 1), cB + hstep, voffB); PG8_STAGE(PG8_SA(0, 0), cA, voffA); PG8_STAGE(PG8_SA(0, 1), cA + hstep, voffA);
        if (wr == 1) PG8_BAR;
        PG8_WAIT_V(2); PG8_BAR;
        PG8_STAGE(PG8_SB(1, 0), cB + kstep, voffB); PG8_STAGE(PG8_SA(1, 0), cA + kstep, voffA); PG8_STAGE(PG8_SB(1, 1), cB + hstep + kstep, voffB);
        PG8_WAIT_V(6); PG8_BAR;
    } else {
        PG8_STAGE(PG8_SB(0, 0), cB, voffB); PG8_STAGE(PG8_SA(0, 0), cA, voffA); PG8_STAGE(PG8_SB(0, 1), cB + hstep, voffB); PG8_STAGE(PG8_SA(0, 1), cA + hstep, voffA);
        if (wr == 1) PG8_BAR;
        PG8_WAIT_V(4); PG8_BAR;
        PG8_STAGE(PG8_SB(1, 0), cB + kstep, voffB); PG8_STAGE(PG8_SA(1, 0), cA + kstep, voffA); PG8_STAGE(PG8_SB(1, 1), cB + hstep + kstep, voffB);
        PG8_WAIT_V(6); PG8_BAR;
    }
    for (;;) {
        const bool has_next = S.next(ui + 1, nxt);
        const char* nA = has_next ? (const char*)g.A + (size_t)nxt.pm * tstep : cA; const char* nB = has_next ? (const char*)g.Bt + (size_t)nxt.pn * tstep : cB;
        for (int t = 0; t < nt; t += 2) {
            const bool last = (t == nt - 2);
            const char* a1 = cA + (size_t)(t + 1) * kstep;
            const char* a2 = last ? nA : cA + (size_t)(t + 2) * kstep; const char* b2 = last ? nB : cB + (size_t)(t + 2) * kstep;
            const char* a3 = a2 + kstep; const char* b3 = b2 + kstep;
            if (last && has_next) S.a_ready(nxt);
            if constexpr (SP2) {
            PG8_LDB(B0, 0, 0); PG8_LDB(B1, 0, 1); PG8_SCHED; PG8_LDA(At, 0, 0); PG8_STAGE(PG8_SA(1, 1), a1 + hstep, voffA);
            PG8_WAIT_V(8); PG8_WAIT_L(0); PG8_BAR; PG8_MMA(0, 0, At, B0); PG8_MMA(0, 1, At, B1); PG8_BAR; PG8_SCHED;
            PG8_LDA(At, 0, 1); PG8_STAGE(PG8_SB(0, 0), b2, voffB); PG8_STAGE(PG8_SB(0, 1), b2 + hstep, voffB); PG8_STAGE(PG8_SA(0, 0), a2, voffA);
            PG8_WAIT_V(8); PG8_WAIT_L(0); PG8_BAR; PG8_MMA(1, 0, At, B0); PG8_MMA(1, 1, At, B1); PG8_BAR; PG8_SCHED;
            PG8_LDB(B0, 1, 0); PG8_LDB(B1, 1, 1); PG8_SCHED; PG8_LDA(At, 1, 0); PG8_STAGE(PG8_SA(0, 1), a2 + hstep, voffA);
            PG8_WAIT_V(8); PG8_WAIT_L(0); PG8_BAR; PG8_MMA(0, 0, At, B0); PG8_MMA(0, 1, At, B1); PG8_BAR; PG8_SCHED;
            PG8_LDA(At, 1, 1); PG8_STAGE(PG8_SB(1, 0), b3, voffB); PG8_STAGE(PG8_SB(1, 1), b3 + hstep, voffB); PG8_STAGE(PG8_SA(1, 0), a3, voffA);
            PG8_WAIT_V(8); PG8_WAIT_L(0); PG8_BAR; PG8_MMA(1, 0, At, B0); PG8_MMA(1, 1, At, B1); PG8_BAR; PG8_SCHED;
            } else {
            PG8_LDB(B0, 0, 0); PG8_SCHED; PG8_LDA(At, 0, 0); PG8_STAGE(PG8_SA(1, 1), a1 + hstep, voffA);
            PG8_WAIT_L(8); PG8_BAR; PG8_WAIT_L(0); PG8_MMA(0, 0, At, B0); PG8_BAR; PG8_SCHED;
            PG8_LDB(B1, 0, 1); PG8_STAGE(PG8_SB(0, 0), b2, voffB);
            PG8_BAR; PG8_WAIT_L(0); PG8_MMA(0, 1, At, B1); PG8_BAR;
            PG8_LDA(At, 0, 1); PG8_STAGE(PG8_SA(0, 0), a2, voffA);
            PG8_BAR; PG8_WAIT_L(0); PG8_MMA(1, 0, At, B0); PG8_BAR; PG8_SCHED;
            PG8_STAGE(PG8_SB(0, 1), b2 + hstep, voffB);
            PG8_WAIT_V(6); PG8_BAR; PG8_MMA(1, 1, At, B1); PG8_BAR;
            PG8_LDB(B0, 1, 0); PG8_SCHED; PG8_LDA(At, 1, 0); PG8_STAGE(PG8_SA(0, 1), a2 + hstep, voffA);
            PG8_WAIT_L(8); PG8_BAR; PG8_WAIT_L(0); PG8_MMA(0, 0, At, B0); PG8_BAR; PG8_SCHED;
            PG8_LDB(B1, 1, 1); PG8_STAGE(PG8_SB(1, 0), b3, voffB);
            PG8_BAR; PG8_WAIT_L(0); PG8_MMA(0, 1, At, B1); PG8_BAR;
            PG8_LDA(At, 1, 1); PG8_STAGE(PG8_SA(1, 0), a3, voffA);
            PG8_BAR; PG8_WAIT_L(0); PG8_MMA(1, 0, At, B0); PG8_BAR; PG8_SCHED;
            PG8_STAGE(PG8_SB(1, 1), b3 + hstep, voffB);
            PG8_WAIT_V(6); PG8_BAR; PG8_MMA(1, 1, At, B1); PG8_BAR;
            }
        }
        if constexpr (ALIGN_EPI) { if (wr == 0) PG8_BAR; }
        if constexpr (!Epi::AFTER_DRAIN) { E(acc, cur, wr, wc, fr, fq); S.done(cur); }
        if (!has_next) break;
#pragma unroll
        for (int a = 0; a < 2; ++a)
#pragma unroll
            for (int b = 0; b < 2; ++b)
#pragma unroll
                for (int m = 0; m < 4; ++m)
#pragma unroll
                    for (int n = 0; n < 2; ++n) acc[a][b][m][n] = (f32x4){0.f, 0.f, 0.f, 0.f};
        cur = nxt; cA = nA; cB = nB; ++ui;
        if constexpr (ALIGN_EPI) { if (wr == 1) PG8_BAR; }
    }
    PG8_WAIT_V(0);
    if constexpr (!ALIGN_EPI) { if (wr == 0) PG8_BAR; }
    PG8_BAR;
    if constexpr (Epi::AFTER_DRAIN) { E.fused(acc, cur, wr, wc, fr, fq, lds, wid, lane); S.done(cur); }
#undef PG8_SA
#undef PG8_SB
#undef PG8_STAGE
#undef PG8_LDA
#undef PG8_LDB
#undef PG8_MMA
#undef PG8_WAIT_V
#undef PG8_WAIT_L
#undef PG8_BAR
#undef PG8_SCHED
}
}

using pg8::bf16_t; using pg8::f32x4;
#define LAS __attribute__((address_space(3)))
constexpr int DM = 2048, NB = 2, SEQ = 4096, LCX = 256, DEPTH = 4;
constexpr int NLAT = NB * SEQ;
constexpr int MROWS = NLAT + NB * LCX;
constexpr int NIN = 6176, NINP = 6400;
constexpr int PQ = 0, PK = 512, PV = 1024, PU = 2048, PGG = 2560, PSG = 3584, PHV = 4096, PHG = 5632, PLR = 6144;
constexpr float EPS = 1e-6f;
constexpr int NT = 512;

__host__ __device__ __forceinline__ int in_col_map(int n) {
    if (n < 2048) return n;
    if (n < 6144) return n + 32;
    if (n < 6176) return n - 4096;
    return -1;
}

constexpr size_t al256(size_t x) { return (x + 255) & ~(size_t)255; }
constexpr size_t WS_WIN  = 0;
constexpr size_t WS_WOUT = WS_WIN  + al256((size_t)DEPTH * NINP * DM * 2);
constexpr size_t WS_WGLU = WS_WOUT + al256((size_t)DEPTH * DM * DM * 2);
constexpr size_t WS_MOD  = WS_WGLU + al256((size_t)DEPTH * 512 * 512 * 2);
constexpr size_t WS_H    = WS_MOD  + al256((size_t)DEPTH * 3 * 6144 * 4);
constexpr size_t WS_YCAT = WS_H    + al256((size_t)MROWS * DM * 2);
constexpr size_t WS_P    = WS_YCAT + al256((size_t)MROWS * DM * 2);
constexpr size_t WS_HS   = WS_H;
static_assert((size_t)2 * 512 * 8192 * 8 <= 2 * al256((size_t)MROWS * DM * 2), "spectra alias");
constexpr size_t WS_XC   = WS_P    + al256((size_t)MROWS * NINP * 4);
constexpr size_t WS_OG   = WS_XC   + al256((size_t)NB * LCX * DM * 4);
constexpr size_t WS_YS5  = WS_OG   + al256((size_t)2 * MROWS * 1024 * 4);
constexpr size_t WS_YG   = WS_YS5  + al256((size_t)2 * MROWS * 512 * 4);
constexpr size_t WS_HT   = WS_YG   + al256((size_t)MROWS * 512 * 2);
constexpr size_t WS_TP   = WS_HT   + al256((size_t)MROWS * 2048 * 4);
constexpr size_t WS_GLA  = WS_TP   + al256((size_t)2 * 512 * 2 * SEQ * 4) + al256((size_t)2 * 512 * 2 * LCX * 4);
constexpr size_t WS_S5W  = WS_GLA  + al256((size_t)80 * 1024 * 1024);
constexpr size_t WS_CTL  = WS_S5W  + al256((size_t)24 * 1024 * 1024);
constexpr size_t CTL_BYTES = 16384;
constexpr size_t WS_END  = WS_CTL  + CTL_BYTES;

struct Params {
    const float* in[33];
    float* out;
    unsigned char* ws;
};

#define KARG_AS __attribute__((address_space(4)))
__device__ __forceinline__ const void* karg_ptr(int byte_off) {
    asm volatile("" : "+s"(byte_off));
    const KARG_AS char* ka = (const KARG_AS char*)__builtin_amdgcn_kernarg_segment_ptr();
    return *(void* const KARG_AS*)(ka + byte_off);
}
#define INP(p, i) ((const float*)karg_ptr(8 * (i)))
#define OUTP(p) ((float*)karg_ptr(8 * 33))
#define WSP(p) ((unsigned char*)karg_ptr(8 * 34))
static_assert(sizeof(Params) == 35 * 8, "Params layout: in[33], out, ws");
enum { I_X = 0, I_C, I_CTX, I_CCTX, I_WMOD, I_BMOD, I_GPRE, I_GPOST, I_WIN, I_WOUT, I_GWG, I_GBG, I_GNORM,
       I_LRE, I_LIM, I_LSTEP, I_BRE, I_BIM, I_CRE, I_CIM, I_S5D, I_WGLU, I_BGLU, I_HCW, I_HCB, I_HW1, I_HB1, I_HF1, I_HW2, I_HB2, I_HF2, I_HW3, I_HD };

__device__ __forceinline__ float wave_sum(float v) {
#pragma unroll
    for (int o = 1; o < 64; o <<= 1) v += __shfl_xor(v, o);
    return v;
}
__device__ __forceinline__ float silu_f(float x) { return x / (1.f + expf(-x)); }
__device__ __forceinline__ float gelu_tanh(float x) { const float u = 0.7978845608028654f * (x + 0.044715f * x * x * x); return 0.5f * x * (1.f + tanhf(u)); }
__device__ __forceinline__ unsigned pk2(float lo, float hi) { return pg8::cvt_pk_bf16(lo, hi); }
__device__ __forceinline__ int otid() { int t = threadIdx.x; asm volatile("" : "+v"(t)); return t; }
__device__ __forceinline__ int permtok(int t) { return ((t & 63) << 6) | (t >> 6); }

template <bool MAPIN>
__device__ __forceinline__ void transpose_item(const float* __restrict__ W, int ldw, int K, bf16_t* __restrict__ WT, int k0, int n0, float* tile) {
    const int tid = otid();
#pragma unroll
    for (int j = 0; j < 32; ++j) { const int i = tid + NT * j, kk = i >> 8, nn = i & 255; int oc = n0 + nn; if (MAPIN) oc = in_col_map(oc);
        tile[kk * 257 + nn] = (oc >= 0) ? W[(size_t)(k0 + kk) * ldw + oc] : 0.f; }
    __syncthreads();
    { const int n = tid >> 1, kh = tid & 1; bf16_t* dst = WT + (size_t)(n0 + n) * K + k0 + 32 * kh;
#pragma unroll
      for (int c = 0; c < 4; ++c) { const float* s = tile + (32 * kh + 8 * c) * 257 + n;
          *(uint4*)(dst + 8 * c) = make_uint4(pk2(s[0], s[257]), pk2(s[2 * 257], s[3 * 257]), pk2(s[4 * 257], s[5 * 257]), pk2(s[6 * 257], s[7 * 257])); } }
    __syncthreads();
}
constexpr int TI_IN = (DM / 64) * (NINP / 256), TI_OUT = (DM / 64) * (DM / 256), TI_GLU = 8 * 2;
constexpr int N_TITEMS = DEPTH * (TI_IN + TI_OUT + TI_GLU);
__device__ __forceinline__ void phase_weights(const Params& p, int bid, int nb, float* smem) {
    for (int it = bid; it < N_TITEMS; it += nb) {
        int r = it;
        if (r < DEPTH * TI_IN) { const int l = r / TI_IN, q = r % TI_IN, kb = q / (NINP / 256), nbk = q % (NINP / 256);
            transpose_item<true>(INP(p, I_WIN) + (size_t)l * DM * NIN, NIN, DM, (bf16_t*)(WSP(p) + WS_WIN) + (size_t)l * NINP * DM, kb * 64, nbk * 256, smem); continue; }
        r -= DEPTH * TI_IN;
        if (r < DEPTH * TI_OUT) { const int l = r / TI_OUT, q = r % TI_OUT, kb = q / 8, nbk = q % 8;
            transpose_item<false>(INP(p, I_WOUT) + (size_t)l * DM * DM, DM, DM, (bf16_t*)(WSP(p) + WS_WOUT) + (size_t)l * DM * DM, kb * 64, nbk * 256, smem); continue; }
        r -= DEPTH * TI_OUT;
        { const int l = r / TI_GLU, q = r % TI_GLU, kb = q / 2, nbk = q % 2;
            transpose_item<false>(INP(p, I_WGLU) + (size_t)l * 512 * 512, 512, 512, (bf16_t*)(WSP(p) + WS_WGLU) + (size_t)l * 512 * 512, kb * 64, nbk * 256, smem); }
    }
}
constexpr int N_MODITEMS = DEPTH * (6144 / 64);
__device__ __forceinline__ void phase_mod(const Params& p, int bid, int nb, float* smem) {
    const int tid = otid(); float* sv = smem;   float* red = smem + 3 * 2048;
    bool loaded = false;
    for (int it = bid; it < N_MODITEMS; it += nb) {
        if (!loaded) { for (int i = tid; i < 3 * 2048; i += NT) { const int r = i >> 11, k = i & 2047; const float c = (r < 2) ? INP(p, I_C)[r * 2048 + k] : INP(p, I_CCTX)[k]; sv[i] = silu_f(c); } loaded = true; }
        __syncthreads();
        const int l = it / 96, jb = it % 96, cl = tid & 15, kg = tid >> 4;
        const float* w = INP(p, I_WMOD) + (size_t)l * DM * 6144 + jb * 64 + cl * 4;
        f32x4 a0 = {0, 0, 0, 0}, a1 = a0, a2 = a0;
#pragma unroll 16
        for (int kk = 0; kk < 64; ++kk) { const int k = kg * 64 + kk; const f32x4 wv = *(const f32x4*)(w + (size_t)k * 6144);
            a0 += wv * sv[k]; a1 += wv * sv[2048 + k]; a2 += wv * sv[4096 + k]; }
        *(f32x4*)(red + (kg * 3 + 0) * 64 + cl * 4) = a0; *(f32x4*)(red + (kg * 3 + 1) * 64 + cl * 4) = a1; *(f32x4*)(red + (kg * 3 + 2) * 64 + cl * 4) = a2;
        __syncthreads();
        if (tid < 192) { const int r = tid >> 6, c = tid & 63; float s = INP(p, I_BMOD)[l * 6144 + jb * 64 + c];
            for (int g = 0; g < 32; ++g) s += red[(g * 3 + r) * 64 + c];
            ((float*)(WSP(p) + WS_MOD))[(size_t)(l * 3 + r) * 6144 + jb * 64 + c] = s; }
        __syncthreads();
    }
}
__device__ __forceinline__ void taps_item(const Params& p, int l, int LX, float* TP, int tb, int cb, float* smem) {
    const int tid = otid();
    float* feats = smem;
    float* h1 = feats + 64 * 33;
    float* h2 = h1 + 64 * 64;
    float* T = h2 + 64 * 64;
    const float* w1 = INP(p, I_HW1) + l * 33 * 64; const float* b1 = INP(p, I_HB1) + l * 64; const float* f1 = INP(p, I_HF1) + l * 64;
    const float* w2 = INP(p, I_HW2) + l * 64 * 64; const float* b2 = INP(p, I_HB2) + l * 64; const float* f2 = INP(p, I_HF2) + l * 64;
    const float* w3 = INP(p, I_HW3) + (size_t)l * 64 * 2048;
#pragma unroll 1
    for (int i = tid; i < 64 * 33; i += NT) { const int tt = i / 33, f = i % 33; const int tau = tb * 64 + tt;
        const float ang = (6.283185307179586f / (float)LX) * (float)tau; float v;
        if (f == 0) v = (float)tau / (float)(LX - 1);
        else { const int bi = (f - 1) & 15; const float band = 1e-4f + (float)bi * ((15.0f - 1e-4f) / 15.0f); const float a = band * ang; v = (f <= 16) ? cosf(a) : -sinf(a); }
        feats[i] = v; }
    __syncthreads();
#pragma unroll 1
    for (int i = tid; i < 64 * 64; i += NT) { const int tt = i >> 6, j = i & 63; float s = b1[j];
#pragma unroll 3
        for (int f = 0; f < 33; ++f) s += feats[tt * 33 + f] * w1[f * 64 + j];
        h1[i] = sinf(f1[j] * s); }
    __syncthreads();
#pragma unroll 1
    for (int i = tid; i < 64 * 64; i += NT) { const int tt = i >> 6, j = i & 63; float s = b2[j];
#pragma unroll 4
        for (int f = 0; f < 64; ++f) s += h1[tt * 64 + f] * w2[f * 64 + j];
        h2[i] = sinf(f2[j] * s); }
    __syncthreads();
    { const int cc = tid & 255, th = tid >> 8, col = cb * 256 + cc; float w3r[64];
#pragma unroll
      for (int i = 0; i < 64; ++i) w3r[i] = w3[(size_t)i * 2048 + col];
      const int c = col & 511; const float delta = fabsf(-15.350567286626973f + (float)c * ((-3.0701134573253945f + 15.350567286626973f) / 511.0f));
#pragma unroll 2
      for (int e = 0; e < 32; ++e) { const float* hrow = h2 + (th * 32 + e) * 64; float a = 0.f;
#pragma unroll
          for (int i4 = 0; i4 < 16; ++i4) { const f32x4 hv = *(const f32x4*)(hrow + 4 * i4);
              a += w3r[4 * i4] * hv[0] + w3r[4 * i4 + 1] * hv[1] + w3r[4 * i4 + 2] * hv[2] + w3r[4 * i4 + 3] * hv[3]; }
          const int tau = tb * 64 + th * 32 + e; const float tl = (float)tau / (float)(LX - 1); T[cc * 65 + th * 32 + e] = a * expf(-tl * delta); } }
    __syncthreads();
    { const int tt = tid & 63, cg = tid >> 6; const int tau = tb * 64 + tt;
#pragma unroll 2
      for (int q = 0; q < 32; ++q) { const int cc = cg * 32 + q, col = cb * 256 + cc; const int o = col >> 10, dir = (col >> 9) & 1, c = col & 511;
          float* dst = TP + (size_t)(o * 512 + c) * (2 * LX);
          if (dir == 0) dst[LX - 1 + tau] = T[cc * 65 + tt];
          else if (tau >= 1) dst[LX - 1 - tau] = T[cc * 65 + tt]; } }
    __syncthreads();
}
constexpr int N_TAPITEMS = (SEQ / 64) * 8 + (LCX / 64) * 8;
__device__ __forceinline__ void phase_taps(const Params& p, int l, int bid, int nb, float* smem) {
    float* TPL = (float*)(WSP(p) + WS_TP); float* TPC = TPL + (size_t)2 * 512 * 2 * SEQ;
    for (int it = bid; it < N_TAPITEMS; it += nb) {
        if (it < (SEQ / 64) * 8) taps_item(p, l, SEQ, TPL, it >> 3, it & 7, smem);
        else { const int q = it - (SEQ / 64) * 8; taps_item(p, l, LCX, TPC, q >> 3, q & 7, smem); }
    }
}

__device__ __forceinline__ void phase_row(const Params& p, int l, int bid, int nb) {
    const int tid_ = otid(); const int lane = tid_ & 63, wave = tid_ >> 6;
    const float* MOD = (const float*)(WSP(p) + WS_MOD); const float* R = (const float*)(WSP(p) + WS_P);
    float* XC = (float*)(WSP(p) + WS_XC); bf16_t* H = (bf16_t*)(WSP(p) + WS_H);
    const int nrows = (l == DEPTH) ? NLAT : MROWS;
    for (int r = bid * 8 + wave; r < nrows; r += nb * 8) {
        const bool lat = r < NLAT; const int b = lat ? (r >> 12) : 0, t = r & 4095, rb = lat ? b : 2;
        const float* xin; float* xout;
        if (lat) { xin = ((l <= 1) ? INP(p, I_X) : OUTP(p)) + (size_t)r * DM; xout = OUTP(p) + (size_t)r * DM; }
        else { xin = ((l <= 1) ? INP(p, I_CTX) : XC) + (size_t)(r - NLAT) * DM; xout = XC + (size_t)(r - NLAT) * DM; }
        f32x4 x[8];
#pragma unroll
        for (int j = 0; j < 8; ++j) x[j] = *(const f32x4*)(xin + 4 * lane + 256 * j);
        if (l > 0) {
            const int lp = l - 1; const int rr = (lat && (lp & 1)) ? (b * SEQ + permtok(t)) : r;
            const float* Rr = R + (size_t)rr * DM; f32x4 v[8]; float ss = 0.f;
#pragma unroll
            for (int j = 0; j < 8; ++j) { v[j] = *(const f32x4*)(Rr + 4 * lane + 256 * j); ss += v[j][0] * v[j][0] + v[j][1] * v[j][1] + v[j][2] * v[j][2] + v[j][3] * v[j][3]; }
            const float rs = rsqrtf(wave_sum(ss) * (1.f / DM) + EPS);
            const float* gate = MOD + (size_t)(lp * 3 + rb) * 6144 + 4096; const float* gp = INP(p, I_GPOST) + lp * DM;
#pragma unroll
            for (int j = 0; j < 8; ++j) { const f32x4 g = *(const f32x4*)(gate + 4 * lane + 256 * j), w = *(const f32x4*)(gp + 4 * lane + 256 * j);
                x[j] = x[j] + g * (v[j] * rs * w); *(f32x4*)(xout + 4 * lane + 256 * j) = x[j]; }
        }
        if (l < DEPTH) {
            float ss = 0.f;
#pragma unroll
            for (int j = 0; j < 8; ++j) ss += x[j][0] * x[j][0] + x[j][1] * x[j][1] + x[j][2] * x[j][2] + x[j][3] * x[j][3];
            const float rs = rsqrtf(wave_sum(ss) * (1.f / DM) + EPS);
            const float* shift = MOD + (size_t)(l * 3 + rb) * 6144; const float* scale = shift + 2048; const float* gp = INP(p, I_GPRE) + l * DM;
            const int hr = (lat && (l & 1)) ? (b * SEQ + permtok(t)) : r;
            bf16_t* hrow = H + (size_t)hr * DM;
#pragma unroll
            for (int j = 0; j < 8; ++j) { const f32x4 sh = *(const f32x4*)(shift + 4 * lane + 256 * j), sc = *(const f32x4*)(scale + 4 * lane + 256 * j), w = *(const f32x4*)(gp + 4 * lane + 256 * j);
                const f32x4 y = (x[j] * rs * w) * (sc + 1.f) + sh; uint2 o; o.x = pk2(y[0], y[1]); o.y = pk2(y[2], y[3]);
                *(uint2*)(hrow + 4 * lane + 256 * j) = o; }
        }
    }
}

constexpr int N_HTITEMS = (MROWS / 64) * 32;
__device__ __forceinline__ void phase_hyT(const Params& p, int bid, int nb, float* tile) {
    const int tid = otid(); const float* P = (const float*)(WSP(p) + WS_P); float* HT = (float*)(WSP(p) + WS_HT); float* HTC = HT + (size_t)NB * 2048 * SEQ;
    for (int it = bid; it < N_HTITEMS; it += nb) {
        const int rb = it >> 5, cb = it & 31, r0 = rb * 64, c0 = cb * 64;
#pragma unroll
        for (int j = 0; j < 8; ++j) { const int i = tid + NT * j, rr = i >> 6, cc = i & 63; tile[cc * 65 + rr] = P[(size_t)(r0 + rr) * NINP + PHV + c0 + cc]; }
        __syncthreads();
        { const int cc = tid >> 3, tq = tid & 7; const float* s = tile + cc * 65 + tq * 8; float* dst;
          if (r0 < NLAT) { const int b = r0 >> 12, t0 = r0 & 4095; dst = HT + ((size_t)(b * 2048 + c0 + cc)) * SEQ + t0 + tq * 8; }
          else { const int q = r0 - NLAT, b = q >> 8, t0 = q & 255; dst = HTC + ((size_t)(b * 2048 + c0 + cc)) * LCX + t0 + tq * 8; }
          f32x4 a = {s[0], s[1], s[2], s[3]}, bq = {s[4], s[5], s[6], s[7]}; *(f32x4*)dst = a; *(f32x4*)(dst + 4) = bq; }
        __syncthreads();
    }
}

__device__ __forceinline__ int seq_row(int b, int dir, int n) {
    if (n < LCX) { const int tc = dir ? (LCX - 1 - n) : n; return NLAT + b * LCX + tc; }
    const int m = n - LCX; const int t = dir ? (SEQ - 1 - m) : m; return b * SEQ + t;
}
__device__ __forceinline__ void phase_gla_naive(const Params& p, int l, int bid, int nb, float* smem) {
    const int tid = otid(); const float* P = (const float*)(WSP(p) + WS_P); float* OG = (float*)(WSP(p) + WS_OG);
    float* sq = smem; float* sk = sq + 8 * 128; float* se = sk + 8 * 128; float* sv = se + 8 * 128; float* so = sv + 8 * 256;
    for (int it = bid; it < 16; it += nb) {
        const int b = it >> 3, dir = (it >> 2) & 1, h = it & 3;
        const int j = tid & 255, half = tid >> 8, kk0 = tid & 127;
        float* swg = so + 16 * 256;
        for (int i = tid; i < 16 * 128; i += NT) swg[i] = INP(p, I_GWG)[((size_t)(l * 2 + dir) * 16 + (i >> 7)) * 512 + h * 128 + (i & 127)];
        __syncthreads();
        const float bgk = INP(p, I_GBG)[(l * 2 + dir) * 512 + h * 128 + kk0];
        float S[64];
#pragma unroll
        for (int k = 0; k < 64; ++k) S[k] = 0.f;
        for (int sb = 0; sb < (SEQ + LCX) / 8; ++sb) {
#pragma unroll
            for (int e = 0; e < 2; ++e) { const int i = (tid >> 7) + 4 * e; const int row = seq_row(b, dir, sb * 8 + i); const float* pr = P + (size_t)row * NINP;
                float z = bgk;
#pragma unroll
                for (int r = 0; r < 16; ++r) z += pr[PLR + dir * 16 + r] * swg[r * 128 + kk0];
                const float ls = fminf(z, 0.f) - log1pf(expf(-fabsf(z)));
                sq[i * 128 + kk0] = pr[PQ + h * 128 + kk0] * 0.08838834764831845f; sk[i * 128 + kk0] = pr[PK + h * 128 + kk0]; se[i * 128 + kk0] = expf(ls * (1.f / 16.f)); }
#pragma unroll
            for (int e = 0; e < 4; ++e) { const int idx = tid + NT * e, i = idx >> 8, jj = idx & 255; const int row = seq_row(b, dir, sb * 8 + i); sv[i * 256 + jj] = P[(size_t)row * NINP + PV + h * 256 + jj]; }
            __syncthreads();
#pragma unroll 1
            for (int i = 0; i < 8; ++i) { const float vj = sv[i * 256 + j]; float o = 0.f;
                const f32x4* q4 = (const f32x4*)(sq + i * 128 + half * 64); const f32x4* k4 = (const f32x4*)(sk + i * 128 + half * 64); const f32x4* e4 = (const f32x4*)(se + i * 128 + half * 64);
#pragma unroll
                for (int k = 0; k < 16; ++k) { const f32x4 qv = q4[k], kv = k4[k], ev = e4[k];
#pragma unroll
                    for (int c = 0; c < 4; ++c) { float s = S[4 * k + c] * ev[c]; if (dir == 0) { s += kv[c] * vj; o += qv[c] * s; } else { o += qv[c] * s; s += kv[c] * vj; } S[4 * k + c] = s; } }
                so[(half * 8 + i) * 256 + j] = o; }
            __syncthreads();
            for (int e = tid; e < 8 * 256; e += NT) { const int i = e >> 8, jj = e & 255; const int row = seq_row(b, dir, sb * 8 + i);
                OG[((size_t)dir * MROWS + row) * 1024 + h * 256 + jj] = so[i * 256 + jj] + so[(8 + i) * 256 + jj]; }
            __syncthreads();
        }
    }
}
__device__ __forceinline__ void phase_s5_naive(const Params& p, int l, int bid, int nb, float* smem) {
    const int tid = otid(), lane = tid & 63, wave = tid >> 6; const float* P = (const float*)(WSP(p) + WS_P); float* YS = (float*)(WSP(p) + WS_YS5);
    float2* sC = (float2*)smem + wave * (16 * 64);
    float2* xs = (float2*)smem + 8 * 16 * 64 + wave * (16 * 65);
    for (int wb = bid; wb < 16; wb += nb) {
        const int gw = wb * 8 + wave, b = gw >> 6, dir = (gw >> 5) & 1, g = gw & 31;
        const size_t pg = ((size_t)(l * 2 + dir) * 32 + g);
        const float lr = INP(p, I_LRE)[pg * 64 + lane], li = INP(p, I_LIM)[pg * 64 + lane], step = expf(INP(p, I_LSTEP)[pg]);
        const float em1 = expm1f(lr * step); float sn, cs; sincosf(li * step, &sn, &cs); const float shf = sinf(0.5f * li * step);
        const float lbr = (em1 + 1.f) * cs, lbi = (em1 + 1.f) * sn;
        const float den = lr * lr + li * li, nr = em1 * cs - 2.f * shf * shf, ni = lbi;
        const float cr = (nr * lr + ni * li) / den, ci = (ni * lr - nr * li) / den;
        float Br[16], Bi[16];
#pragma unroll
        for (int hh = 0; hh < 16; ++hh) { const float br = INP(p, I_BRE)[(pg * 64 + lane) * 16 + hh], bi = INP(p, I_BIM)[(pg * 64 + lane) * 16 + hh]; Br[hh] = cr * br - ci * bi; Bi[hh] = cr * bi + ci * br; }
        for (int i = lane; i < 16 * 64; i += 64) sC[i] = make_float2(INP(p, I_CRE)[pg * 1024 + i], INP(p, I_CIM)[pg * 1024 + i]);
        float xr = 0.f, xi = 0.f;
        for (int blk = 0; blk < (SEQ + LCX) / 16; ++blk) {
            for (int i = 0; i < 16; ++i) { const int row = seq_row(b, dir, blk * 16 + i); const float* u = P + (size_t)row * NINP + PU + g * 16;
                float bur = 0.f, bui = 0.f;
#pragma unroll
                for (int q = 0; q < 4; ++q) { const f32x4 uv = *(const f32x4*)(u + 4 * q);
#pragma unroll
                    for (int c = 0; c < 4; ++c) { bur += Br[4 * q + c] * uv[c]; bui += Bi[4 * q + c] * uv[c]; } }
                const float nxr = lbr * xr - lbi * xi + bur, nxi = lbr * xi + lbi * xr + bui; xr = nxr; xi = nxi;
                xs[i * 65 + lane] = make_float2(xr, xi); }
            __syncthreads();
            { const int tt = lane & 15, hg = lane >> 4; float y[4] = {0.f, 0.f, 0.f, 0.f};
              for (int q = 0; q < 64; ++q) { const float2 xv = xs[tt * 65 + q];
#pragma unroll
                  for (int e = 0; e < 4; ++e) { const float2 c = sC[(hg * 4 + e) * 64 + q]; y[e] += c.x * xv.x - c.y * xv.y; } }
              const int row = seq_row(b, dir, blk * 16 + tt);
              f32x4 o = {y[0], y[1], y[2], y[3]}; *(f32x4*)(YS + ((size_t)dir * MROWS + row) * 512 + g * 16 + hg * 4) = o; }
            __syncthreads();
        }
    }
}
template <int LX, int NTT>
__device__ __forceinline__ void hy_naive_item(const Params& p, int l, const float* TP, const float* HTb, float* HOb, int c, float* smem) {
    const int tid = otid();
    float* tp = smem; float* vb = tp + 2 * LX; float* zb = vb + 2 * LX;
    const float* cw = INP(p, I_HCW) + (size_t)l * 3 * 1536; const float* cb = INP(p, I_HCB) + (size_t)l * 1536; const float* hd = INP(p, I_HD) + (size_t)l * 2 * 512;
#define SHORTC(dst, chan) do { const float w0 = cw[chan], w1 = cw[1536 + (chan)], w2 = cw[2 * 1536 + (chan)], bb = cb[chan]; \
        for (int i = tid; i < 2 * LX; i += NT) { const int b = i / LX, t = i % LX; const float* s = HTb + ((size_t)(b * 2048 + (chan))) * LX; \
            const float a = s[t > 0 ? t - 1 : 0], m = s[t], n = s[t < LX - 1 ? t + 1 : LX - 1]; dst[i] = w0 * (t > 0 ? a : 0.f) + w1 * m + w2 * (t < LX - 1 ? n : 0.f) + bb; } } while (0)
    for (int i = tid; i < 2 * LX; i += NT) tp[i] = (i < 2 * LX - 1) ? TP[(size_t)(0 * 512 + c) * (2 * LX) + i] : 0.f;
    SHORTC(vb, c);
    __syncthreads();
    float acc[2][NTT];
#pragma unroll
    for (int e = 0; e < NTT; ++e) { acc[0][e] = 0.f; acc[1][e] = 0.f; }
    for (int s = 0; s < LX; ++s) { const float v0 = vb[s], v1 = vb[LX + s];
#pragma unroll
        for (int e = 0; e < NTT; ++e) { const int t = tid + NT * e; if (t < LX) { const float w = tp[LX - 1 + t - s]; acc[0][e] += w * v0; acc[1][e] += w * v1; } } }
    __syncthreads();
    {
        const int ch = 512 + c; const float w0 = cw[ch], w1 = cw[1536 + ch], w2 = cw[2 * 1536 + ch], bb = cb[ch]; const float d0 = hd[c];
#pragma unroll
        for (int e = 0; e < NTT; ++e) { const int t = tid + NT * e; if (t < LX) {
#pragma unroll
            for (int b = 0; b < 2; ++b) { const float* s = HTb + ((size_t)(b * 2048 + ch)) * LX; const float a = s[t > 0 ? t - 1 : 0], m = s[t], n = s[t < LX - 1 ? t + 1 : LX - 1];
                const float x1 = w0 * (t > 0 ? a : 0.f) + w1 * m + w2 * (t < LX - 1 ? n : 0.f) + bb; zb[b * LX + t] = x1 * (acc[b][e] + d0 * vb[b * LX + t]); } } }
    }
    for (int i = tid; i < 2 * LX; i += NT) tp[i] = (i < 2 * LX - 1) ? TP[(size_t)(1 * 512 + c) * (2 * LX) + i] : 0.f;
    __syncthreads();
#pragma unroll
    for (int e = 0; e < NTT; ++e) { acc[0][e] = 0.f; acc[1][e] = 0.f; }
    for (int s = 0; s < LX; ++s) { const float v0 = zb[s], v1 = zb[LX + s];
#pragma unroll
        for (int e = 0; e < NTT; ++e) { const int t = tid + NT * e; if (t < LX) { const float w = tp[LX - 1 + t - s]; acc[0][e] += w * v0; acc[1][e] += w * v1; } } }
    {
        const int ch = 1024 + c; const float w0 = cw[ch], w1 = cw[1536 + ch], w2 = cw[2 * 1536 + ch], bb = cb[ch]; const float d1 = hd[512 + c];
#pragma unroll
        for (int e = 0; e < NTT; ++e) { const int t = tid + NT * e; if (t < LX) {
#pragma unroll
            for (int b = 0; b < 2; ++b) { const float* s = HTb + ((size_t)(b * 2048 + ch)) * LX; const float a = s[t > 0 ? t - 1 : 0], m = s[t], n = s[t < LX - 1 ? t + 1 : LX - 1];
                const float x2 = w0 * (t > 0 ? a : 0.f) + w1 * m + w2 * (t < LX - 1 ? n : 0.f) + bb; const float gt = HTb[((size_t)(b * 2048 + 1536 + c)) * LX + t];
                HOb[((size_t)(b * 512 + c)) * LX + t] = x2 * (acc[b][e] + d1 * zb[b * LX + t]) * silu_f(gt); } } }
    }
    __syncthreads();
#undef SHORTC
}
constexpr int N_POSTT = NB * 8 * (SEQ / 64) + NB * 8 * (LCX / 64);
__device__ __forceinline__ void phase_post(const Params& p, int l, int bid, int nb, float* tile) {
    const int tid = otid(), lane = tid & 63, wave = tid >> 6;
    const float* P = (const float*)(WSP(p) + WS_P); const float* OG = (const float*)(WSP(p) + WS_OG); const float* YS = (const float*)(WSP(p) + WS_YS5);
    bf16_t* YC = (bf16_t*)(WSP(p) + WS_YCAT); bf16_t* YG = (bf16_t*)(WSP(p) + WS_YG);
    const float* gn = INP(p, I_GNORM) + l * 256;
    for (int r = bid * 8 + wave; r < MROWS; r += nb * 8) {
        const float* pr = P + (size_t)r * NINP;
#pragma unroll
        for (int hh = 0; hh < 4; ++hh) { const int col = hh * 256 + 4 * lane;
            const f32x4 o = *(const f32x4*)(OG + (size_t)r * 1024 + col) + *(const f32x4*)(OG + ((size_t)MROWS + r) * 1024 + col);
            const float rs = rsqrtf(wave_sum(o[0] * o[0] + o[1] * o[1] + o[2] * o[2] + o[3] * o[3]) * (1.f / 256.f) + EPS);
            const f32x4 w = *(const f32x4*)(gn + 4 * lane), g = *(const f32x4*)(pr + PGG + col);
            uint2 q; q.x = pk2(o[0] * rs * w[0] * silu_f(g[0]), o[1] * rs * w[1] * silu_f(g[1])); q.y = pk2(o[2] * rs * w[2] * silu_f(g[2]), o[3] * rs * w[3] * silu_f(g[3]));
            *(uint2*)(YC + (size_t)r * DM + col) = q; }
#pragma unroll
        for (int e = 0; e < 2; ++e) { const int col = 4 * lane + 256 * e;
            const f32x4 y = *(const f32x4*)(YS + (size_t)r * 512 + col);
            uint2 q; q.x = pk2(gelu_tanh(y[0]), gelu_tanh(y[1])); q.y = pk2(gelu_tanh(y[2]), gelu_tanh(y[3]));
            *(uint2*)(YG + (size_t)r * 512 + col) = q; }
    }
    const float* HT = (const float*)(WSP(p) + WS_TP); const float* HTC = HT + (size_t)2 * 512 * SEQ;
    for (int it = bid; it < N_POSTT; it += nb) {
        const float* src; int LX, b, cb, tb, rbase;
        if (it < NB * 8 * (SEQ / 64)) { LX = SEQ; b = it / (8 * 64); const int q = it % (8 * 64); cb = q >> 6; tb = q & 63; src = HT; rbase = b * SEQ; }
        else { const int i2 = it - NB * 8 * (SEQ / 64); LX = LCX; b = i2 / (8 * 4); const int q = i2 % (8 * 4); cb = q >> 2; tb = q & 3; src = HTC; rbase = NLAT + b * LCX; }
#pragma unroll
        for (int j = 0; j < 8; ++j) { const int i = tid + NT * j, cc = i >> 6, tt = i & 63; tile[tt * 65 + cc] = src[((size_t)(b * 512 + cb * 64 + cc)) * LX + tb * 64 + tt]; }
        __syncthreads();
        { const int tt = tid >> 3, cq = tid & 7; const float* s = tile + tt * 65 + cq * 8;
          uint4 o; o.x = pk2(s[0], s[1]); o.y = pk2(s[2], s[3]); o.z = pk2(s[4], s[5]); o.w = pk2(s[6], s[7]);
          *(uint4*)(YC + (size_t)(rbase + tb * 64 + tt) * DM + 1536 + cb * 64 + cq * 8) = o; }
        __syncthreads();
    }
}
#define XB_TMO      128
#define XB_XCNT(j)  (256  + 64 * (j))
#define XB_XSUB(j)  (1280 + 64 * (j))
#define XB_XGEN(j)  (2304 + 64 * (j))
#define XB_TOP      3328
#define XB_TOPGEN   3392
#define XCD_BAR_WORDS 3456
#define XB_SPIN_CAP (1u << 22)

__device__ __forceinline__ unsigned xb_ld(unsigned* p)              { return __hip_atomic_load(p, __ATOMIC_RELAXED, __HIP_MEMORY_SCOPE_AGENT); }
__device__ __forceinline__ unsigned xb_add(unsigned* p, unsigned v) { return __hip_atomic_fetch_add(p, v, __ATOMIC_RELAXED, __HIP_MEMORY_SCOPE_AGENT); }
__device__ __forceinline__ unsigned xb_xcc_id() { return (unsigned)__builtin_amdgcn_s_getreg((3 << 11) | 20) & 0xFu; }
#define XB_SPIN(cond, bar) do { unsigned _sp = 0; while (cond) { __builtin_amdgcn_s_sleep(1); \
    if ((++_sp & 255u) == 0u) { if (xb_ld(&(bar)[XB_TMO])) break; if (_sp > XB_SPIN_CAP) { atomicAdd(&(bar)[XB_TMO], 1u); break; } } } } while (0)

struct XcdBarrier {
    unsigned* bar; unsigned x;
    volatile LAS unsigned* st;
};

__device__ __forceinline__ XcdBarrier xcd_barrier_post(unsigned* bar, volatile LAS unsigned* st) {
    XcdBarrier b; b.bar = bar; b.x = xb_xcc_id(); b.st = st;
    if (threadIdx.x == 0) (void)xb_add(&bar[XB_XCNT(b.x)], 1u);
    return b;
}
__device__ __forceinline__ void xcd_barrier_complete(unsigned* bar, unsigned x, unsigned& nloc, unsigned& nx) {
    const unsigned G = gridDim.x * gridDim.y * gridDim.z;
    unsigned sum, cnt, mine, sp = 0u;
    for (;;) {
        sum = 0u; cnt = 0u; mine = 0u;
#pragma unroll
        for (unsigned j = 0; j < 16; ++j) { const unsigned c = xb_ld(&bar[XB_XCNT(j)]); sum += c; cnt += (c > 0u) ? 1u : 0u; mine = (j == x) ? c : mine; }
        if (sum == G) break;
        __builtin_amdgcn_s_sleep(1);
        if ((++sp & 255u) == 0u) { if (xb_ld(&bar[XB_TMO])) break; if (sp > XB_SPIN_CAP) { atomicAdd(&bar[XB_TMO], 1u); break; } }
    }
    nloc = mine > 0u ? mine : 1u; nx = cnt > 0u ? cnt : 1u;
}

__device__ __forceinline__ void xcd_barrier(const XcdBarrier& b) {
    asm volatile("s_waitcnt vmcnt(0)" ::: "memory");
    __syncthreads();
    if (threadIdx.x == 0) {
        unsigned* bar = b.bar; asm volatile("" : "+s"(bar));
        __builtin_amdgcn_s_waitcnt(0);
        unsigned nloc = b.st[0], nx = b.st[1];
        if (nloc == 0u) { xcd_barrier_complete(bar, b.x, nloc, nx); b.st[0] = nloc; b.st[1] = nx; }
        const unsigned old = xb_add(&bar[XB_XSUB(b.x)], 1u);
        const unsigned gen = old / nloc;
        if (old + 1u == (gen + 1u) * nloc) {
            __builtin_amdgcn_fence(__ATOMIC_RELEASE, "agent");
            asm volatile("s_waitcnt vmcnt(0)" ::: "memory");
            const unsigned og = xb_add(&bar[XB_TOP], 1u);
            const unsigned tg = og / nx;
            if (og + 1u == (tg + 1u) * nx) xb_add(&bar[XB_TOPGEN], 1u);
            else XB_SPIN(xb_ld(&bar[XB_TOPGEN]) == tg, bar);
            __builtin_amdgcn_fence(__ATOMIC_ACQUIRE, "agent");
            xb_add(&bar[XB_XGEN(b.x)], 1u);
            asm volatile("s_waitcnt vmcnt(0)" ::: "memory");
        } else {
            XB_SPIN(xb_ld(&bar[XB_XGEN(b.x)]) == gen, bar);
            __builtin_amdgcn_fence(__ATOMIC_ACQUIRE, "agent");
            asm volatile("s_waitcnt vmcnt(0)" ::: "memory");
        }
    }
    __syncthreads();
}

typedef short bf16x8_t __attribute__((ext_vector_type(8)));
constexpr int NCH = 68;
constexpr size_t GLA_QT = 0;
constexpr size_t GLA_KT = GLA_QT + (size_t)2 * MROWS * 512 * 2;
constexpr size_t GLA_KDT = GLA_KT + (size_t)2 * MROWS * 512 * 2;
constexpr size_t GLA_VT = GLA_KDT + (size_t)2 * NB * 4 * NCH * 8192 * 2;
constexpr size_t GLA_AG = GLA_VT + (size_t)NB * 4 * NCH * 16384 * 2;
constexpr size_t GLA_BYTES = GLA_AG + (size_t)2 * NB * 4 * NCH * 128 * 4;
__device__ __forceinline__ int chunk_row0(int b, int ch) { return ch < 4 ? (NLAT + b * LCX + 64 * ch) : (b * SEQ + 64 * (ch - 4)); }

constexpr int N_GLAPREP = NB * 4 * NCH;
__device__ __forceinline__ void gla_prep_item(const Params& p, int l, int it, float* smem) {
    const int tid = otid(); const int b = it / (4 * NCH), h = (it / NCH) & 3, ch = it % NCH; const int row0 = chunk_row0(b, ch);
    const float* P = (const float*)(WSP(p) + WS_P); unsigned char* GB = WSP(p) + WS_GLA;
    float* lrs = smem;
    float* tot = lrs + 64 * 32;
    float* vtile = tot + 2 * 4 * 128;
    for (int i = tid; i < 64 * 32; i += NT) lrs[i] = P[(size_t)(row0 + (i >> 5)) * NINP + PLR + (i & 31)];
#pragma unroll 16
    for (int j = 0; j < 32; ++j) { const int i = tid + NT * j, r = i >> 8, v = i & 255; vtile[r * 257 + v] = P[(size_t)(row0 + r) * NINP + PV + h * 256 + v]; }
    __syncthreads();
    const int k = tid & 127, seg = tid >> 7;
    float G[2][16];
#pragma unroll
    for (int dir = 0; dir < 2; ++dir) {
        float wg[16];
#pragma unroll
        for (int r = 0; r < 16; ++r) wg[r] = INP(p, I_GWG)[((size_t)(l * 2 + dir) * 16 + r) * 512 + h * 128 + k];
        const float bias = INP(p, I_GBG)[(l * 2 + dir) * 512 + h * 128 + k];
#pragma unroll
        for (int e = 0; e < 16; ++e) { const float* lr = lrs + (16 * seg + e) * 32 + dir * 16; float z = bias;
#pragma unroll
            for (int r = 0; r < 16; ++r) z += lr[r] * wg[r];
            G[dir][e] = (fminf(z, 0.f) - log1pf(expf(-fabsf(z)))) * (1.f / 16.f); }
        if (dir == 0) {
#pragma unroll
            for (int e = 1; e < 16; ++e) G[0][e] += G[0][e - 1];
            tot[(0 * 4 + seg) * 128 + k] = G[0][15];
        } else {
#pragma unroll
            for (int e = 14; e >= 0; --e) G[1][e] += G[1][e + 1];
            tot[(1 * 4 + seg) * 128 + k] = G[1][0];
        }
    }
    __syncthreads();
#pragma unroll
    for (int dir = 0; dir < 2; ++dir) {
        float off = 0.f, glast = 0.f;
#pragma unroll
        for (int s = 0; s < 4; ++s) { const float t = tot[(dir * 4 + s) * 128 + k]; glast += t; if (dir == 0 ? (s < seg) : (s > seg)) off += t; }
        bf16_t* QT = (bf16_t*)(GB + GLA_QT) + ((size_t)dir * MROWS + row0) * 512 + h * 128 + k;
        bf16_t* KT = (bf16_t*)(GB + GLA_KT) + ((size_t)dir * MROWS + row0) * 512 + h * 128 + k;
        unsigned kd[8];
#pragma unroll
        for (int e = 0; e < 16; e += 2) { float kdv[2];
#pragma unroll
            for (int u = 0; u < 2; ++u) { const int i = 16 * seg + e + u; const float g = G[dir][e + u] + off;
                const float q = P[(size_t)(row0 + i) * NINP + PQ + h * 128 + k] * 0.08838834764831845f, kk = P[(size_t)(row0 + i) * NINP + PK + h * 128 + k];
                QT[(size_t)i * 512] = (bf16_t)(pk2(q * expf(g), 0.f) & 0xffff); KT[(size_t)i * 512] = (bf16_t)(pk2(kk * expf(-g), 0.f) & 0xffff);
                kdv[u] = kk * expf(glast - g); }
            kd[e >> 1] = pk2(kdv[0], kdv[1]); }
        bf16_t* KD = (bf16_t*)(GB + GLA_KDT) + ((((size_t)dir * NB + b) * 4 + h) * NCH + ch) * 8192 + k * 64 + 16 * seg;
        *(uint4*)KD = make_uint4(kd[0], kd[1], kd[2], kd[3]); *(uint4*)(KD + 8) = make_uint4(kd[4], kd[5], kd[6], kd[7]);
        if (seg == 0) ((float*)(GB + GLA_AG))[((((size_t)dir * NB + b) * 4 + h) * NCH + ch) * 128 + k] = expf(glast);
    }
    {
        const int v = tid >> 1, hf = tid & 1; bf16_t* VT = (bf16_t*)(GB + GLA_VT) + (((size_t)b * 4 + h) * NCH + ch) * 16384 + v * 64 + 32 * hf;
#pragma unroll
        for (int c = 0; c < 4; ++c) { const float* s = vtile + (32 * hf + 8 * c) * 257 + v;
            *(uint4*)(VT + 8 * c) = make_uint4(pk2(s[0], s[257]), pk2(s[2 * 257], s[3 * 257]), pk2(s[4 * 257], s[5 * 257]), pk2(s[6 * 257], s[7 * 257])); }
    }
    __syncthreads();
}

constexpr int GQP = 136, GVP = 72;
__device__ __forceinline__ bf16x8_t ldfrag(const bf16_t* base, int pitch, int row0, int k0, int lane) {
    return *(const bf16x8_t*)(base + (row0 + (lane & 15)) * pitch + k0 + (lane >> 4) * 8);
}
__device__ __forceinline__ void gla_seq_item(const Params& p, int it, bf16_t* lds) {
    const int tid = otid(), lane = tid & 63, w = tid >> 6;
    const int b = it >> 5, dir = (it >> 4) & 1, h = (it >> 2) & 3, vs = it & 3;
    unsigned char* GB = WSP(p) + WS_GLA; float* OG = (float*)(WSP(p) + WS_OG);
    bf16_t* Qs = lds; bf16_t* Ks = Qs + 64 * GQP; bf16_t* STs = Ks + 64 * GQP; bf16_t* KdTs = STs + 64 * GQP; bf16_t* VTs = KdTs + 128 * GVP; bf16_t* Ps = VTs + 64 * GVP;
    const bf16_t* QTg = (const bf16_t*)(GB + GLA_QT) + (size_t)dir * MROWS * 512 + h * 128;
    const bf16_t* KTg = (const bf16_t*)(GB + GLA_KT) + (size_t)dir * MROWS * 512 + h * 128;
    const bf16_t* KDg = (const bf16_t*)(GB + GLA_KDT) + (((size_t)dir * NB + b) * 4 + h) * NCH * 8192;
    const bf16_t* VTg = (const bf16_t*)(GB + GLA_VT) + ((size_t)b * 4 + h) * NCH * 16384 + vs * 64 * 64;
    const float* AGg = (const float*)(GB + GLA_AG) + (((size_t)dir * NB + b) * 4 + h) * NCH * 128;
    f32x4 S_[4];
#pragma unroll
    for (int i = 0; i < 4; ++i) S_[i] = (f32x4){0.f, 0.f, 0.f, 0.f};
    uint4 rqA0, rqA1, rkA0, rkA1, rdA0, rdA1, rvA; f32x4 anA;
    uint4 rqB0, rqB1, rkB0, rkB1, rdB0, rdB1, rvB; f32x4 anB;
#define GLA_LOAD(S, cs_) do { const int ch_ = dir ? ((cs_) < 4 ? 3 - (cs_) : 71 - (cs_)) : (cs_); const int r0_ = chunk_row0(b, ch_); const int e0_ = tid, e1_ = tid + NT; \
        rq##S##0 = *(const uint4*)(QTg + (size_t)(r0_ + (e0_ >> 4)) * 512 + (e0_ & 15) * 8); rq##S##1 = *(const uint4*)(QTg + (size_t)(r0_ + (e1_ >> 4)) * 512 + (e1_ & 15) * 8); \
        rk##S##0 = *(const uint4*)(KTg + (size_t)(r0_ + (e0_ >> 4)) * 512 + (e0_ & 15) * 8); rk##S##1 = *(const uint4*)(KTg + (size_t)(r0_ + (e1_ >> 4)) * 512 + (e1_ & 15) * 8); \
        rd##S##0 = *(const uint4*)(KDg + (size_t)ch_ * 8192 + e0_ * 8); rd##S##1 = *(const uint4*)(KDg + (size_t)ch_ * 8192 + e1_ * 8); \
        rv##S = *(const uint4*)(VTg + (size_t)ch_ * 16384 + tid * 8); an##S = *(const f32x4*)(AGg + ch_ * 128 + 16 * w + (lane >> 4) * 4); } while (0)
#define GLA_BODY(S, cs) do { \
        const int ch = dir ? ((cs) < 4 ? 3 - (cs) : 71 - (cs)) : (cs); const int r0 = chunk_row0(b, ch); \
        { const int e0 = tid, e1 = tid + NT; \
            *(uint4*)(Qs + (e0 >> 4) * GQP + (e0 & 15) * 8) = rq##S##0; *(uint4*)(Qs + (e1 >> 4) * GQP + (e1 & 15) * 8) = rq##S##1; \
            *(uint4*)(Ks + (e0 >> 4) * GQP + (e0 & 15) * 8) = rk##S##0; *(uint4*)(Ks + (e1 >> 4) * GQP + (e1 & 15) * 8) = rk##S##1; \
            *(uint4*)(KdTs + (e0 >> 3) * GVP + (e0 & 7) * 8) = rd##S##0; *(uint4*)(KdTs + (e1 >> 3) * GVP + (e1 & 7) * 8) = rd##S##1; } \
        *(uint4*)(VTs + (tid >> 3) * GVP + (tid & 7) * 8) = rv##S; \
        const f32x4 ac = an##S; \
        _Pragma("unroll") for (int vt = 0; vt < 4; ++vt) *(uint2*)(STs + (16 * vt + (lane & 15)) * GQP + 16 * w + (lane >> 4) * 4) = make_uint2(pk2(S_[vt][0], S_[vt][1]), pk2(S_[vt][2], S_[vt][3])); \
        __syncthreads(); \
        if ((cs) + 2 < NCH) GLA_LOAD(S, (cs) + 2); \
        const int st = w & 3, tt0 = 2 * (w >> 2); \
        { f32x4 c0 = {0.f, 0.f, 0.f, 0.f}, c1 = c0; \
          _Pragma("unroll") for (int ks = 0; ks < 4; ++ks) { const bf16x8_t a = ldfrag(Ks, GQP, 16 * st, 32 * ks, lane); \
              c0 = __builtin_amdgcn_mfma_f32_16x16x32_bf16(a, ldfrag(Qs, GQP, 16 * tt0, 32 * ks, lane), c0, 0, 0, 0); \
              c1 = __builtin_amdgcn_mfma_f32_16x16x32_bf16(a, ldfrag(Qs, GQP, 16 * tt0 + 16, 32 * ks, lane), c1, 0, 0, 0); } \
          const int s0 = 16 * st + (lane >> 4) * 4; \
          _Pragma("unroll") for (int u = 0; u < 2; ++u) { const f32x4 c = u ? c1 : c0; const int t = 16 * (tt0 + u) + (lane & 15); float m[4]; \
              _Pragma("unroll") for (int r = 0; r < 4; ++r) { const bool keep = dir ? (s0 + r > t) : (s0 + r <= t); m[r] = keep ? c[r] : 0.f; } \
              *(uint2*)(Ps + t * GVP + s0) = make_uint2(pk2(m[0], m[1]), pk2(m[2], m[3])); } } \
        f32x4 o0 = {0.f, 0.f, 0.f, 0.f}, o1 = o0; \
        _Pragma("unroll") for (int ks = 0; ks < 4; ++ks) { const bf16x8_t a = ldfrag(STs, GQP, 16 * st, 32 * ks, lane); \
            o0 = __builtin_amdgcn_mfma_f32_16x16x32_bf16(a, ldfrag(Qs, GQP, 16 * tt0, 32 * ks, lane), o0, 0, 0, 0); \
            o1 = __builtin_amdgcn_mfma_f32_16x16x32_bf16(a, ldfrag(Qs, GQP, 16 * tt0 + 16, 32 * ks, lane), o1, 0, 0, 0); } \
        _Pragma("unroll") for (int vt = 0; vt < 4; ++vt) { S_[vt][0] *= ac[0]; S_[vt][1] *= ac[1]; S_[vt][2] *= ac[2]; S_[vt][3] *= ac[3]; } \
        _Pragma("unroll") for (int ks = 0; ks < 2; ++ks) { const bf16x8_t a = ldfrag(KdTs, GVP, 16 * w, 32 * ks, lane); \
            _Pragma("unroll") for (int vt = 0; vt < 4; ++vt) S_[vt] = __builtin_amdgcn_mfma_f32_16x16x32_bf16(a, ldfrag(VTs, GVP, 16 * vt, 32 * ks, lane), S_[vt], 0, 0, 0); } \
        __syncthreads(); \
        _Pragma("unroll") for (int ks = 0; ks < 2; ++ks) { const bf16x8_t a = ldfrag(VTs, GVP, 16 * st, 32 * ks, lane); \
            o0 = __builtin_amdgcn_mfma_f32_16x16x32_bf16(a, ldfrag(Ps, GVP, 16 * tt0, 32 * ks, lane), o0, 0, 0, 0); \
            o1 = __builtin_amdgcn_mfma_f32_16x16x32_bf16(a, ldfrag(Ps, GVP, 16 * tt0 + 16, 32 * ks, lane), o1, 0, 0, 0); } \
        { float* og = OG + ((size_t)dir * MROWS + r0 + 16 * tt0 + (lane & 15)) * 1024 + h * 256 + vs * 64 + 16 * st + (lane >> 4) * 4; \
          *(f32x4*)og = o0; *(f32x4*)(og + 16 * 1024) = o1; } \
        __syncthreads(); } while (0)
    GLA_LOAD(A, 0); GLA_LOAD(B, 1);
#pragma unroll 1
    for (int cs = 0; cs < NCH; cs += 2) { GLA_BODY(A, cs); GLA_BODY(B, cs + 1); }
#undef GLA_BODY
#undef GLA_LOAD
}
#ifndef FFT_HD
#define FFT_HD __device__ __forceinline__
#endif
#define PADI(i) ((i) + ((i) >> 5))
constexpr int FFT_N = 8192, FFT_BUF = FFT_N + FFT_N / 32, FFT_TW = 2048 + 512 + 128 + 32 + 8;
struct __attribute__((aligned(8))) cf { float x, y; };
FFT_HD cf cmul(cf a, cf b) { return cf{a.x * b.x - a.y * b.y, a.x * b.y + a.y * b.x}; }
FFT_HD cf cmulc(cf a, cf b) { return cf{a.x * b.x + a.y * b.y, a.y * b.x - a.x * b.y}; }
FFT_HD cf cadd(cf a, cf b) { return cf{a.x + b.x, a.y + b.y}; }
FFT_HD cf csub(cf a, cf b) { return cf{a.x - b.x, a.y - b.y}; }
FFT_HD int fft_twoff(int s) { return s == 0 ? 0 : s == 1 ? 2048 : s == 2 ? 2560 : s == 3 ? 2688 : 2720; }
template <bool INV> FFT_HD void fft_stage4(cf* buf, const cf* tw, int s, int tid) {
    const int lq = 11 - 2 * s, q4 = 1 << lq; const cf* t = tw + fft_twoff(s);
#pragma unroll
    for (int e = 0; e < 4; ++e) {
        const int bf = tid + 512 * e, blk = bf >> lq, j = bf & (q4 - 1), base = (blk << (lq + 2)) + j;
        const int i0 = PADI(base), i1 = PADI(base + q4), i2 = PADI(base + 2 * q4), i3 = PADI(base + 3 * q4);
        const cf w1 = t[j], w2 = cmul(w1, w1), w3 = cmul(w2, w1);
        cf x0 = buf[i0], x1 = buf[i1], x2 = buf[i2], x3 = buf[i3];
        if (INV) { x1 = cmulc(x1, w1); x2 = cmulc(x2, w2); x3 = cmulc(x3, w3); }
        const cf a = cadd(x0, x2), b = csub(x0, x2), c = cadd(x1, x3), d = csub(x1, x3);
        cf y0 = cadd(a, c), y2 = csub(a, c), y1, y3;
        if (!INV) { y1 = cf{b.x + d.y, b.y - d.x}; y3 = cf{b.x - d.y, b.y + d.x}; y1 = cmul(y1, w1); y2 = cmul(y2, w2); y3 = cmul(y3, w3); }
        else      { y1 = cf{b.x - d.y, b.y + d.x}; y3 = cf{b.x + d.y, b.y - d.x}; }
        buf[i0] = y0; buf[i1] = y1; buf[i2] = y2; buf[i3] = y3;
    }
}
template <bool INV> FFT_HD void fft_last8(cf* buf, int tid) {
    const float h = 0.70710678118654752f;
    const cf w[2][4] = {{{1.f, 0.f}, {1.f, 0.f}, {1.f, 0.f}, {1.f, 0.f}}, {{1.f, 0.f}, {h, -h}, {0.f, -1.f}, {-h, -h}}};
#pragma unroll
    for (int e = 0; e < 2; ++e) {
        const int base = PADI((tid + 512 * e) * 8); cf x[8];
#pragma unroll
        for (int i = 0; i < 8; ++i) x[i] = buf[base + i];
        if (!INV) {
#pragma unroll
            for (int j = 0; j < 2; ++j) { const cf a = cadd(x[j], x[j + 4]), b = csub(x[j], x[j + 4]), c = cadd(x[j + 2], x[j + 6]), d = csub(x[j + 2], x[j + 6]);
                x[j] = cadd(a, c); x[j + 2] = cmul(cf{b.x + d.y, b.y - d.x}, w[j][1]); x[j + 4] = cmul(csub(a, c), w[j][2]); x[j + 6] = cmul(cf{b.x - d.y, b.y + d.x}, w[j][3]); }
#pragma unroll
            for (int m = 0; m < 4; ++m) { const cf a = x[2 * m], b = x[2 * m + 1]; x[2 * m] = cadd(a, b); x[2 * m + 1] = csub(a, b); }
        } else {
#pragma unroll
            for (int m = 0; m < 4; ++m) { const cf a = x[2 * m], b = x[2 * m + 1]; x[2 * m] = cadd(a, b); x[2 * m + 1] = csub(a, b); }
#pragma unroll
            for (int j = 0; j < 2; ++j) { const cf u0 = x[j], u1 = cmulc(x[j + 2], w[j][1]), u2 = cmulc(x[j + 4], w[j][2]), u3 = cmulc(x[j + 6], w[j][3]);
                const cf a = cadd(u0, u2), b = csub(u0, u2), c = cadd(u1, u3), d = csub(u1, u3);
                x[j] = cadd(a, c); x[j + 4] = csub(a, c); x[j + 2] = cf{b.x - d.y, b.y + d.x}; x[j + 6] = cf{b.x + d.y, b.y - d.x}; }
        }
#pragma unroll
        for (int i = 0; i < 8; ++i) buf[base + i] = x[i];
    }
}

constexpr int HY_TW_OFF = 24576;
__device__ __forceinline__ void hy_twiddles(float* smem) {
    cf* tw = (cf*)(smem + HY_TW_OFF); const int tid = otid();
    for (int i = tid; i < FFT_TW; i += NT) { int s = 0, j = i; if (i >= 2720) { s = 4; j = i - 2720; } else if (i >= 2688) { s = 3; j = i - 2688; } else if (i >= 2560) { s = 2; j = i - 2560; } else if (i >= 2048) { s = 1; j = i - 2048; }
        const int Ls = 8192 >> (2 * s); float sn, cs; sincospif(-2.0f * (float)j / (float)Ls, &sn, &cs); tw[i] = cf{cs, sn}; }
    __syncthreads();
}
template <bool INV> __device__ __forceinline__ void hy_fft(cf* buf, const cf* tw, int tid) {
    if (!INV) {
#pragma unroll 1
        for (int s = 0; s < 5; ++s) { fft_stage4<false>(buf, tw, s, tid); __syncthreads(); }
        fft_last8<false>(buf, tid); __syncthreads();
    } else {
        fft_last8<true>(buf, tid); __syncthreads();
#pragma unroll 1
        for (int s = 4; s >= 0; --s) { fft_stage4<true>(buf, tw, s, tid); __syncthreads(); }
    }
}
__device__ __forceinline__ void hy_spec_item(const Params& p, int it, float* smem) {
    const int tid = otid(); cf* buf = (cf*)smem; const cf* tw = (const cf*)(smem + HY_TW_OFF);
    const float* src = (const float*)(WSP(p) + WS_TP) + (size_t)it * 8192; cf* HS = (cf*)(WSP(p) + WS_HS) + (size_t)it * 8192;
#pragma unroll
    for (int e = 0; e < 16; ++e) { const int j = tid + NT * e, idx = (j + 4095) & 8191; buf[PADI(j)] = cf{idx == 8191 ? 0.f : src[idx], 0.f}; }
    __syncthreads();
    hy_fft<false>(buf, tw, tid);
#pragma unroll 4
    for (int e = 0; e < 16; ++e) { const int i = tid + NT * e; const cf v = buf[PADI(i)]; HS[i] = cf{v.x * (1.f / 8192.f), v.y * (1.f / 8192.f)}; }
    __syncthreads();
}
__device__ __forceinline__ float hy_short(const float* s, int t, float w0, float w1, float w2, float bb) {
    const float a = s[t > 0 ? t - 1 : 0], m = s[t], n = s[t < SEQ - 1 ? t + 1 : SEQ - 1];
    return w0 * (t > 0 ? a : 0.f) + w1 * m + w2 * (t < SEQ - 1 ? n : 0.f) + bb;
}
__device__ __forceinline__ void hy_fft_item(const Params& p, int l, int c, float* smem) {
    const int tid = otid(); cf* buf = (cf*)smem; const cf* tw = (const cf*)(smem + HY_TW_OFF);
    const float* HT = (const float*)(WSP(p) + WS_HT); float* HO = (float*)(WSP(p) + WS_TP); const cf* HS = (const cf*)(WSP(p) + WS_HS);
    const float* cw = INP(p, I_HCW) + (size_t)l * 3 * 1536; const float* cb = INP(p, I_HCB) + (size_t)l * 1536; const float* hd = INP(p, I_HD) + (size_t)l * 2 * 512;
    float v0[8], v1[8];
    { const float w0 = cw[c], w1 = cw[1536 + c], w2 = cw[2 * 1536 + c], bb = cb[c]; const float* s0 = HT + (size_t)c * SEQ; const float* s1 = HT + (size_t)(2048 + c) * SEQ;
#pragma unroll
      for (int e = 0; e < 8; ++e) { const int t = tid + NT * e; v0[e] = hy_short(s0, t, w0, w1, w2, bb); v1[e] = hy_short(s1, t, w0, w1, w2, bb);
          buf[PADI(t)] = cf{v0[e], v1[e]}; buf[PADI(4096 + t)] = cf{0.f, 0.f}; } }
    cf hreg[16];
    { const cf* H = HS + (size_t)c * 8192;
#pragma unroll
      for (int e = 0; e < 16; ++e) hreg[e] = H[tid + NT * e]; }
    __syncthreads();
    hy_fft<false>(buf, tw, tid);
#pragma unroll
    for (int e = 0; e < 16; ++e) { const int i = tid + NT * e; buf[PADI(i)] = cmul(buf[PADI(i)], hreg[e]); }
    float z0[8], z1[8];
    { const int ch = 512 + c; const float w0 = cw[ch], w1 = cw[1536 + ch], w2 = cw[2 * 1536 + ch], bb = cb[ch];
      const float* s0 = HT + (size_t)ch * SEQ; const float* s1 = HT + (size_t)(2048 + ch) * SEQ;
#pragma unroll
      for (int e = 0; e < 8; ++e) { const int t = tid + NT * e; z0[e] = hy_short(s0, t, w0, w1, w2, bb); z1[e] = hy_short(s1, t, w0, w1, w2, bb); } }
    __syncthreads();
    hy_fft<true>(buf, tw, tid);
    { const float d0 = hd[c];
#pragma unroll
      for (int e = 0; e < 8; ++e) { const int t = tid + NT * e; const cf y = buf[PADI(t)]; z0[e] *= (y.x + d0 * v0[e]); z1[e] *= (y.y + d0 * v1[e]); } }
    __syncthreads();
#pragma unroll
    for (int e = 0; e < 8; ++e) { const int t = tid + NT * e; buf[PADI(t)] = cf{z0[e], z1[e]}; buf[PADI(4096 + t)] = cf{0.f, 0.f}; }
    { const cf* H = HS + (size_t)(512 + c) * 8192;
#pragma unroll
      for (int e = 0; e < 16; ++e) hreg[e] = H[tid + NT * e]; }
    __syncthreads();
    hy_fft<false>(buf, tw, tid);
#pragma unroll
    for (int e = 0; e < 16; ++e) { const int i = tid + NT * e; buf[PADI(i)] = cmul(buf[PADI(i)], hreg[e]); }
    { const int ch = 1024 + c; const float w0 = cw[ch], w1 = cw[1536 + ch], w2 = cw[2 * 1536 + ch], bb = cb[ch];
      const float* s0 = HT + (size_t)ch * SEQ; const float* s1 = HT + (size_t)(2048 + ch) * SEQ;
      const float* g0 = HT + (size_t)(1536 + c) * SEQ; const float* g1 = HT + (size_t)(2048 + 1536 + c) * SEQ;
#pragma unroll
      for (int e = 0; e < 8; ++e) { const int t = tid + NT * e; v0[e] = hy_short(s0, t, w0, w1, w2, bb) * silu_f(g0[t]); v1[e] = hy_short(s1, t, w0, w1, w2, bb) * silu_f(g1[t]); } }
    __syncthreads();
    hy_fft<true>(buf, tw, tid);
    { const float d1 = hd[512 + c];
#pragma unroll
      for (int e = 0; e < 8; ++e) { const int t = tid + NT * e; const cf y = buf[PADI(t)];
          HO[(size_t)c * SEQ + t] = v0[e] * (y.x + d1 * z0[e]); HO[(size_t)(512 + c) * SEQ + t] = v1[e] * (y.y + d1 * z1[e]); } }
    __syncthreads();
}


constexpr size_t S5W_WA = 0;
constexpr size_t S5W_KW = S5W_WA + (size_t)32 * 2 * 128 * 256 * 2;
constexpr size_t S5W_L16 = S5W_KW + (size_t)32 * 256 * 512 * 2;
constexpr size_t S5W_XI = S5W_L16 + (size_t)32 * 2 * 64 * 2 * 4;
constexpr size_t S5W_BYTES = S5W_XI + (size_t)32 * NB * 272 * 256 * 2;
__device__ __forceinline__ int s5_row(int b, int n, int s) { return n < 16 ? (NLAT + b * LCX + 16 * n + s) : (b * SEQ + 16 * (n - 16) + s); }

__device__ __forceinline__ void s5_weights_item(const Params& p, int l, int g, float* smem) {
    const int tid = otid();
    cf* pw = (cf*)smem;
    cf* Bb = pw + 2 * 17 * 64;
    cf* Cc = Bb + 2 * 64 * 16;
    float* KT = (float*)(Cc + 2 * 16 * 64);
    unsigned char* WB = WSP(p) + WS_S5W;
    for (int i = tid; i < 2 * 17 * 64; i += NT) { const int d = i / (17 * 64), e = (i / 64) % 17, q = i & 63; const size_t pg = ((size_t)(l * 2 + d) * 32 + g);
        const float lr = INP(p, I_LRE)[pg * 64 + q], li = INP(p, I_LIM)[pg * 64 + q], step = expf(INP(p, I_LSTEP)[pg]);
        const float em = expf((float)e * lr * step); float sn, cs; sincosf((float)e * li * step, &sn, &cs); pw[i] = cf{em * cs, em * sn}; }
    for (int i = tid; i < 2 * 64 * 16; i += NT) { const int d = i >> 10, q = (i >> 4) & 63, hh = i & 15; const size_t pg = ((size_t)(l * 2 + d) * 32 + g);
        const float lr = INP(p, I_LRE)[pg * 64 + q], li = INP(p, I_LIM)[pg * 64 + q], step = expf(INP(p, I_LSTEP)[pg]);
        const float em1 = expm1f(lr * step); float sn, cs; sincosf(li * step, &sn, &cs); const float shf = sinf(0.5f * li * step);
        const float nr = em1 * cs - 2.f * shf * shf, ni = (em1 + 1.f) * sn, den = lr * lr + li * li;
        const float cr = (nr * lr + ni * li) / den, ci = (ni * lr - nr * li) / den;
        const float br = INP(p, I_BRE)[(pg * 64 + q) * 16 + hh], bi = INP(p, I_BIM)[(pg * 64 + q) * 16 + hh];
        Bb[i] = cf{cr * br - ci * bi, cr * bi + ci * br}; }
    for (int i = tid; i < 2 * 16 * 64; i += NT) { const int d = i >> 10; const size_t pg = ((size_t)(l * 2 + d) * 32 + g); Cc[i] = cf{INP(p, I_CRE)[pg * 1024 + (i & 1023)], INP(p, I_CIM)[pg * 1024 + (i & 1023)]}; }
    __syncthreads();
    if (tid < 128) { const int d = tid >> 6, q = tid & 63; const cf v = pw[(d * 17 + 16) * 64 + q]; float* L16 = (float*)(WB + S5W_L16) + ((size_t)g * 2 + d) * 128 + 2 * q; L16[0] = v.x; L16[1] = v.y; }
#pragma unroll 1
    for (int i = tid; i < 2 * 16 * 256; i += NT) { const int d = i >> 12, tau = (i >> 8) & 15, hp = (i >> 4) & 15, hh = i & 15; float s = 0.f;
#pragma unroll 4
        for (int q = 0; q < 64; ++q) { const cf m = cmul(cmul(Cc[(d * 16 + hp) * 64 + q], pw[(d * 17 + tau) * 64 + q]), Bb[(d * 64 + q) * 16 + hh]); s += m.x; }
        KT[i] = s; }
    __syncthreads();
    bf16_t* WA = (bf16_t*)(WB + S5W_WA) + (size_t)g * 2 * 128 * 256; bf16_t* KW = (bf16_t*)(WB + S5W_KW) + (size_t)g * 256 * 512;
#pragma unroll 1
    for (int i = tid; i < 2 * 128 * 256 / 2; i += NT) { const int i2 = 2 * i; const int d = i2 >> 15, rq = (i2 >> 8) & 127, col = i2 & 255; const int ri = rq >> 6, q = rq & 63, s = col >> 4, hh = col & 15;
        const int e = d ? s : 15 - s; const cf w = pw[(d * 17 + e) * 64 + q]; const cf m0 = cmul(w, Bb[(d * 64 + q) * 16 + hh]), m1 = cmul(w, Bb[(d * 64 + q) * 16 + hh + 1]);
        *(unsigned*)(WA + i2) = pk2(ri ? m0.y : m0.x, ri ? m1.y : m1.x); }
#pragma unroll 1
    for (int i = tid; i < 256 * 512 / 2; i += NT) { const int i2 = 2 * i; const int row = i2 >> 9, col = i2 & 511; const int t = row >> 4, hp = row & 15; float v[2];
#pragma unroll
        for (int u = 0; u < 2; ++u) { const int c = col + u;
            if (c < 256) { const int s = c >> 4, hh = c & 15; float a = 0.f; if (s <= t) a += KT[(0 * 16 + (t - s)) * 256 + hp * 16 + hh]; if (s >= t) a += KT[(1 * 16 + (s - t)) * 256 + hp * 16 + hh];
                if (s == t && hh == hp) a += INP(p, I_S5D)[l * 512 + g * 16 + hp]; v[u] = a; }
            else { const int c2 = c - 256, d = c2 >> 7, ri = (c2 >> 6) & 1, q = c2 & 63; const int e = d ? 16 - t : t + 1; const cf m = cmul(Cc[(d * 16 + hp) * 64 + q], pw[(d * 17 + e) * 64 + q]); v[u] = ri ? -m.y : m.x; } }
        *(unsigned*)(KW + i2) = pk2(v[0], v[1]); }
    __syncthreads();
}

constexpr int S5P = 520;
__device__ __forceinline__ void s5_fetch_u(const float* P, int b, int g, int mt, int tid, f32x4& a, f32x4& c) {
    const int row = tid >> 5, part = tid & 31, s = part >> 1, h8 = (part & 1) * 8; const float* src = P + (size_t)s5_row(b, 16 * mt + row, s) * NINP + PU + 16 * g + h8;
    a = *(const f32x4*)src; c = *(const f32x4*)(src + 4);
}
__device__ __forceinline__ void s5_store_u(bf16_t* At, int tid, const f32x4 a, const f32x4 c) {
    const int row = tid >> 5, part = tid & 31, s = part >> 1, h8 = (part & 1) * 8;
    *(uint4*)(At + row * S5P + 16 * s + h8) = make_uint4(pk2(a[0], a[1]), pk2(a[2], a[3]), pk2(c[0], c[1]), pk2(c[2], c[3]));
}
__device__ __forceinline__ void s5_item(const Params& p, int it, float* smem) {
    const int tid = otid(), lane = tid & 63, w = tid >> 6; const int g = it >> 1, b = it & 1;
    const float* P = (const float*)(WSP(p) + WS_P); unsigned char* WB = WSP(p) + WS_S5W; float* YS = (float*)(WSP(p) + WS_YS5);
    bf16_t* At = (bf16_t*)smem;
    float* Et = smem + (16 * S5P) / 2;
    bf16_t* XI = (bf16_t*)(WB + S5W_XI) + ((size_t)g * NB + b) * 272 * 256;
#pragma unroll 1
    for (int d = 0; d < 2; ++d) {
        const bf16_t* WA = (const bf16_t*)(WB + S5W_WA) + ((size_t)g * 2 + d) * 128 * 256;
        bf16x8_t bfr[8];
#pragma unroll
        for (int ks = 0; ks < 8; ++ks) bfr[ks] = *(const bf16x8_t*)(WA + (size_t)(16 * w + (lane & 15)) * 256 + 32 * ks + (lane >> 4) * 8);
        float xr = 0.f, xi = 0.f, l16r = 0.f, l16i = 0.f;
        if (tid < 64) { const float* L16 = (const float*)(WB + S5W_L16) + ((size_t)g * 2 + d) * 128 + 2 * tid; l16r = L16[0]; l16i = L16[1]; }
        f32x4 ua, uc; s5_fetch_u(P, b, g, 0, tid, ua, uc);
#pragma unroll 1
        for (int k = 0; k < 17; ++k) {
            const int mt = d ? (k == 0 ? 0 : 17 - k) : k;
            s5_store_u(At, tid, ua, uc);
            __syncthreads();
            if (k + 1 < 17) s5_fetch_u(P, b, g, d ? 16 - k : k + 1, tid, ua, uc);
            f32x4 acc = {0.f, 0.f, 0.f, 0.f};
#pragma unroll
            for (int ks = 0; ks < 8; ++ks) acc = __builtin_amdgcn_mfma_f32_16x16x32_bf16(ldfrag(At, S5P, 0, 32 * ks, lane), bfr[ks], acc, 0, 0, 0);
#pragma unroll
            for (int r = 0; r < 4; ++r) Et[((lane >> 4) * 4 + r) * 132 + 16 * w + (lane & 15)] = acc[r];
            __syncthreads();
            if (tid < 64) { float er[16], ei[16];
#pragma unroll
                for (int i = 0; i < 16; ++i) { const int m = d ? 15 - i : i; er[i] = Et[m * 132 + tid]; ei[i] = Et[m * 132 + 64 + tid]; }
#pragma unroll
                for (int i = 0; i < 16; ++i) { const int m = d ? 15 - i : i; bf16_t* xo = XI + (size_t)(16 * mt + m) * 256 + d * 128 + tid;
                    xo[0] = (bf16_t)(pk2(xr, 0.f) & 0xffff); xo[64] = (bf16_t)(pk2(xi, 0.f) & 0xffff);
                    const float nr = l16r * xr - l16i * xi + er[i], ni = l16r * xi + l16i * xr + ei[i]; xr = nr; xi = ni; }
            }
            __syncthreads();
        }
    }
    {
        const bf16_t* KW = (const bf16_t*)(WB + S5W_KW) + (size_t)g * 256 * 512;
        bf16x8_t bw[2][16];
#pragma unroll
        for (int u = 0; u < 2; ++u)
#pragma unroll
            for (int ks = 0; ks < 16; ++ks) bw[u][ks] = *(const bf16x8_t*)(KW + (size_t)(32 * w + 16 * u + (lane & 15)) * 512 + 32 * ks + (lane >> 4) * 8);
        f32x4 ua, uc; uint4 xv; s5_fetch_u(P, b, g, 0, tid, ua, uc); xv = *(const uint4*)(XI + (size_t)(tid >> 5) * 256 + (tid & 31) * 8);
#pragma unroll 1
        for (int mt = 0; mt < 17; ++mt) {
            s5_store_u(At, tid, ua, uc);
            *(uint4*)(At + (tid >> 5) * S5P + 256 + (tid & 31) * 8) = xv;
            __syncthreads();
            if (mt + 1 < 17) { s5_fetch_u(P, b, g, mt + 1, tid, ua, uc); xv = *(const uint4*)(XI + (size_t)(16 * (mt + 1) + (tid >> 5)) * 256 + (tid & 31) * 8); }
            f32x4 a0 = {0.f, 0.f, 0.f, 0.f}, a1 = a0;
#pragma unroll
            for (int ks = 0; ks < 16; ++ks) { const bf16x8_t af = ldfrag(At, S5P, 0, 32 * ks, lane);
                a0 = __builtin_amdgcn_mfma_f32_16x16x32_bf16(af, bw[0][ks], a0, 0, 0, 0); a1 = __builtin_amdgcn_mfma_f32_16x16x32_bf16(af, bw[1][ks], a1, 0, 0, 0); }
#pragma unroll
            for (int r = 0; r < 4; ++r) { const int n = 16 * mt + (lane >> 4) * 4 + r;
                YS[(size_t)s5_row(b, n, 2 * w) * 512 + 16 * g + (lane & 15)] = a0[r]; YS[(size_t)s5_row(b, n, 2 * w + 1) * 512 + 16 * g + (lane & 15)] = a1[r]; }
            __syncthreads();
        }
    }
}


__device__ __forceinline__ void phase_inproj(const Params& p, int l, int bid, int nb, LAS unsigned char* lds) {
    pg8::Gemm g{(const bf16_t*)(WSP(p) + WS_H), (const bf16_t*)(WSP(p) + WS_WIN) + (size_t)l * NINP * DM, MROWS, NINP, DM};
    pg8::StaticOrder S; S.init(MROWS, NINP, nb, bid);
    pg8::EpiF32 E{(float*)(WSP(p) + WS_P), NINP};
    pg8::gemm_phase<pg8::EpiF32, pg8::StaticOrder, true, true>(lds, g, S, E);
}
__device__ __forceinline__ void phase_glu(const Params& p, int l, int bid, int nb, LAS unsigned char* lds) {
    pg8::Gemm g{(const bf16_t*)(WSP(p) + WS_YG), (const bf16_t*)(WSP(p) + WS_WGLU) + (size_t)l * 512 * 512, MROWS, 512, 512};
    pg8::StaticOrder S; S.init(MROWS, 512, nb, bid);
    pg8::EpiGlu E{(const bf16_t*)(WSP(p) + WS_YG), (const float*)(WSP(p) + WS_P) + PSG, NINP, INP(p, I_BGLU) + l * 512, (bf16_t*)(WSP(p) + WS_YCAT) + 1024, DM};
    pg8::gemm_phase<pg8::EpiGlu, pg8::StaticOrder, true, true>(lds, g, S, E);
}
__device__ __forceinline__ void phase_outproj(const Params& p, int l, int bid, int nb, LAS unsigned char* lds) {
    pg8::Gemm g{(const bf16_t*)(WSP(p) + WS_YCAT), (const bf16_t*)(WSP(p) + WS_WOUT) + (size_t)l * DM * DM, MROWS, DM, DM};
    pg8::StaticOrder S; S.init(MROWS, DM, nb, bid);
    pg8::EpiF32 E{(float*)(WSP(p) + WS_P), DM};
    pg8::gemm_phase<pg8::EpiF32, pg8::StaticOrder, true, true>(lds, g, S, E);
}

static_assert(GLA_BYTES <= (size_t)80 * 1024 * 1024 && S5W_BYTES <= (size_t)24 * 1024 * 1024, "GLA / S5 workspace");
constexpr int LDS_BYTES = 147456;
namespace cg = cooperative_groups;
#ifndef REP_PHASE
#define REP_PHASE -1
#endif
#if REP_PHASE < 0
#define REPEAT(k)
#else
#define REPEAT(k) for (int rep_ = 0; rep_ < ((REP_PHASE == (k)) ? 2 : 1); ++rep_)
#endif
__global__ void __launch_bounds__(NT, 2) k_mega(Params p) {
    extern __shared__ __attribute__((aligned(16))) unsigned char lds[];
    cg::grid_group grid = cg::this_grid();
    float* smem = (float*)lds;
    volatile LAS unsigned* bst = (volatile LAS unsigned*)((LAS unsigned char*)lds + 131072 + 64);
    if (threadIdx.x == 0) { bst[0] = 0u; bst[1] = 0u; }
    __syncthreads();
    const XcdBarrier xbar = xcd_barrier_post((unsigned*)(WSP(p) + WS_CTL), bst);
    { const int bid = blockIdx.x, nb = gridDim.x; REPEAT(0) { phase_weights(p, bid, nb, smem); phase_mod(p, bid, nb, smem); phase_taps(p, 0, bid, nb, smem); } }
    grid.sync();
#pragma unroll 1
    for (int l0 = 0; l0 < DEPTH; ++l0) {
        int l = l0; asm volatile("" : "+s"(l));
        int bid = blockIdx.x, nb = gridDim.x; asm volatile("" : "+s"(bid), "+s"(nb));
        phase_row(p, l, bid, nb);
        REPEAT(1) { if (l > 0) phase_taps(p, l, bid, nb, smem);
        for (int g = nb - 1 - bid; g < 32; g += nb) s5_weights_item(p, l, g, smem); }
        xcd_barrier(xbar);
        phase_inproj(p, l, bid, nb, (LAS unsigned char*)lds);
        xcd_barrier(xbar);
        REPEAT(3) phase_hyT(p, bid, nb, smem);
        REPEAT(4) for (int it = bid; it < N_GLAPREP; it += nb) gla_prep_item(p, l, it, smem);
        REPEAT(5) { hy_twiddles(smem);
        for (int it = bid; it < 1024; it += nb) hy_spec_item(p, it, smem); }
        xcd_barrier(xbar);
        if (bid < 64) { REPEAT(60) gla_seq_item(p, bid, (bf16_t*)lds); }
        else if (bid < 128) { REPEAT(61) s5_item(p, bid - 64, smem); }
        {
            unsigned* qctr = (unsigned*)(WSP(p) + WS_CTL + 14336) + 64 * l; volatile LAS unsigned* qs = (volatile LAS unsigned*)((LAS unsigned char*)lds + 131072 + 128);
            hy_twiddles(smem);
            const float* HTC = (const float*)(WSP(p) + WS_HT) + (size_t)NB * 2048 * SEQ; float* TPC = (float*)(WSP(p) + WS_TP) + (size_t)2 * 512 * 2 * SEQ;
            for (;;) {
                __syncthreads();
                if (threadIdx.x == 0) qs[0] = atomicAdd(qctr, 1u);
                __syncthreads();
                const unsigned item = qs[0];
                if (item >= 1024u) break;
                if (item < 512u) hy_fft_item(p, l, (int)item, smem);
                else hy_naive_item<LCX, 1>(p, l, TPC, HTC, (float*)(WSP(p) + WS_TP) + (size_t)2 * 512 * SEQ, (int)item - 512, smem);
            }
        }
        xcd_barrier(xbar);
        REPEAT(7) phase_post(p, l, bid, nb, smem);
        xcd_barrier(xbar);
        phase_glu(p, l, bid, nb, (LAS unsigned char*)lds);
        xcd_barrier(xbar);
        REPEAT(8) phase_outproj(p, l, bid, nb, (LAS unsigned char*)lds);
        xcd_barrier(xbar);
    }
    phase_row(p, DEPTH, blockIdx.x, gridDim.x);
}

extern "C" void kernel_launch(void* const* d_in, const int* in_sizes, int n_in, void* d_out, int out_size, void* d_ws, size_t ws_size, hipStream_t stream) {
    if (n_in != 33 || out_size != NLAT * DM || ws_size < WS_END) { fprintf(stderr, "kernel_launch: unexpected problem (n_in %d out %d ws %zu need %zu)\n", n_in, out_size, ws_size, (size_t)WS_END); return; }
    Params p{};
    for (int i = 0; i < 33; ++i) p.in[i] = (const float*)d_in[i];
    p.out = (float*)d_out; p.ws = (unsigned char*)d_ws;
    static int grid_blocks = 0;
    if (!grid_blocks) {
        int dev = 0, cus = 0, per_cu = 0;
        (void)hipGetDevice(&dev);
        (void)hipDeviceGetAttribute(&cus, hipDeviceAttributeMultiprocessorCount, dev);
        (void)hipFuncSetAttribute((const void*)k_mega, hipFuncAttributeMaxDynamicSharedMemorySize, LDS_BYTES);
        (void)hipOccupancyMaxActiveBlocksPerMultiprocessor(&per_cu, (const void*)k_mega, NT, LDS_BYTES);
        if (per_cu < 1) { fprintf(stderr, "kernel_launch: occupancy query says %d blocks per CU\n", per_cu); per_cu = 1; }
        grid_blocks = cus;
        fprintf(stderr, "kernel_launch: cus %d per_cu %d grid %d\n", cus, per_cu, grid_blocks);
    }
    (void)hipMemsetAsync((unsigned char*)d_ws + WS_CTL, 0, CTL_BYTES, stream);
    void* args[] = {&p};
    hipError_t e = hipLaunchCooperativeKernel((const void*)k_mega, dim3(grid_blocks), dim3(NT), args, LDS_BYTES, stream);
    if (e != hipSuccess) fprintf(stderr, "cooperative launch failed: %s (grid %d)\n", hipGetErrorString(e), grid_blocks);
}
```

```cpp
#include <hip/hip_runtime.h>
#include <hip/hip_cooperative_groups.h>
#include <cstdio>
#include <cstdint>
#include <cmath>
namespace pg8 {
#define PG8_LAS __attribute__((address_space(3)))
typedef unsigned short bf16_t;
typedef short bf16x8 __attribute__((ext_vector_type(8)));
typedef float f32x4 __attribute__((ext_vector_type(4)));
typedef unsigned u32x4 __attribute__((ext_vector_type(4)));
constexpr int BM = 256, BK = 64, HALF = 128, HTB = HALF * BK * 2  , STAGE_BYTES = 8 * HTB, NXCD = 8, WGM = 8;

__host__ __device__ __forceinline__ int lds_byte(int r, int c) { const int st = (r >> 4) * 2 + (c >> 5), rr = r & 15, cc = c & 31, ob = rr * 64 + cc * 2; return st * 1024 + (ob ^ (((ob >> 9) & 1) << 5)); }
__host__ __device__ __forceinline__ void stage_rc(int b, int& R, int& C) { const int st = b / 1024, sb = b % 1024, swz = sb ^ (((sb >> 9) & 1) << 5); R = (st >> 1) * 16 + swz / 64; C = (st & 1) * 32 + (swz % 64) / 2; }
__host__ __device__ __forceinline__ int perm32(int rho) { const int n = rho >> 4, i = rho & 15; return 8 * (i >> 2) + 4 * n + (i & 3); }

struct Unit { int pm, pn; };
struct Gemm { const bf16_t* A; const bf16_t* Bt; int M, N, K; };

struct StaticOrder {
    int nM, nN, nwg, G, c;
    __host__ __device__ void init(int M, int N, int G_, int c_) { nM = M / BM; nN = N / BM; nwg = nM * nN; G = G_; c = c_; }
    __host__ __device__ bool next(int i, Unit& u) const {
        const long L = (long)i * G + c; if (L >= nwg) return false;
        int wgid = (int)L; { const int q = nwg / NXCD, r = nwg % NXCD, xcd = wgid % NXCD, off = wgid / NXCD; wgid = (xcd < r ? xcd * (q + 1) : r * (q + 1) + (xcd - r) * q) + off; }
        const int nig = WGM * nN, gid = wgid / nig, fm = gid * WGM, gsz = (nM - fm) < WGM ? (nM - fm) : WGM;
        u.pm = fm + ((wgid % nig) % gsz); u.pn = (wgid % nig) / gsz; return true;
    }
    __device__ __forceinline__ void a_ready(const Unit&) const {}
    __device__ __forceinline__ void done(const Unit&) const {}
};


__device__ __forceinline__ unsigned cvt_pk_bf16(float lo, float hi) { unsigned r; asm volatile("v_cvt_pk_bf16_f32 %0, %1, %2" : "=v"(r) : "v"(lo), "v"(hi)); return r; }
__device__ __forceinline__ float bf2f(unsigned short h) { return __builtin_bit_cast(float, (unsigned)h << 16); }

struct EpiF32 {
    static constexpr bool PERM = false, AFTER_DRAIN = false;
    float* O; int ldc;
    __device__ __forceinline__ void operator()(const f32x4 (&acc)[2][2][4][2], const Unit& u, int wr, int wc, int fr, int fq) const {
        const int row0 = u.pm * BM + wr * 64 + fr, col0 = u.pn * BM + wc * 32 + 4 * fq;
#pragma unroll
        for (int ai = 0; ai < 2; ++ai)
#pragma unroll
            for (int m = 0; m < 4; ++m) { float* rowp = O + (size_t)(row0 + ai * HALF + m * 16) * ldc + col0;
#pragma unroll
                for (int bj = 0; bj < 2; ++bj)
#pragma unroll
                    for (int n = 0; n < 2; ++n) *(f32x4*)(rowp + bj * HALF + n * 16) = acc[ai][bj][m][n]; }
    }
};
struct EpiGlu {
    static constexpr bool PERM = false, AFTER_DRAIN = false;
    const bf16_t* YG; const float* Psg; int ldp; const float* bg; bf16_t* Y; int ldy;
    __device__ __forceinline__ void operator()(const f32x4 (&acc)[2][2][4][2], const Unit& u, int wr, int wc, int fr, int fq) const {
        const int row0 = u.pm * BM + wr * 64 + fr, col0 = u.pn * BM + wc * 32 + 4 * fq;
#pragma unroll
        for (int ai = 0; ai < 2; ++ai)
#pragma unroll
            for (int m = 0; m < 4; ++m) { const size_t row = (size_t)(row0 + ai * HALF + m * 16);
#pragma unroll
                for (int bj = 0; bj < 2; ++bj)
#pragma unroll
                    for (int n = 0; n < 2; ++n) { const int col = col0 + bj * HALF + n * 16;
                        const f32x4 a = acc[ai][bj][m][n]; const f32x4 b = *(const f32x4*)(bg + col); const f32x4 sg = *(const f32x4*)(Psg + row * ldp + col);
                        const uint2 y2 = *(const uint2*)(YG + row * 512 + col);
                        float yv[4] = {bf2f((unsigned short)(y2.x & 0xffff)), bf2f((unsigned short)(y2.x >> 16)), bf2f((unsigned short)(y2.y & 0xffff)), bf2f((unsigned short)(y2.y >> 16))};
                        float o[4];
#pragma unroll
                        for (int e = 0; e < 4; ++e) { const float z = a[e] + b[e]; const float s = 1.f / (1.f + __expf(-z)); const float g = sg[e]; const float sl = g / (1.f + __expf(-g)); o[e] = yv[e] * s * sl; }
                        uint2 w; w.x = cvt_pk_bf16(o[0], o[1]); w.y = cvt_pk_bf16(o[2], o[3]);
                        *(uint2*)(Y + row * ldy + col) = w; } }
    }
};
template <class Epi, class Sched, bool ALIGN_EPI = false, bool SP2 = false>
__device__ __forceinline__ void gemm_phase(PG8_LAS unsigned char* lds, const Gemm g, const Sched& S, const Epi& E) {
    int tid_o = threadIdx.x; asm volatile("" : "+v"(tid_o)); const int tid = tid_o, wid = __builtin_amdgcn_readfirstlane(tid >> 6), lane = tid & 63, wr = wid >> 2, wc = wid & 3, fr = lane & 15, fq = lane >> 4;
    const int K = g.K, nt = K / BK;
    unsigned voffA[2], voffB[2];
#pragma unroll
    for (int i = 0; i < 2; ++i) { int R, C; stage_rc(tid * 16 + i * 8192, R, C); const int Rb = Epi::PERM ? ((R & ~31) + perm32(R & 31)) : R;
        voffA[i] = (unsigned)(R * K + C) * 2u; voffB[i] = (unsigned)(Rb * K + C) * 2u; }
    const size_t kstep = (size_t)(BK * 2);
    const size_t hstep = (size_t)HALF * K * 2;
    const size_t tstep = 2 * hstep;
    const unsigned ldsw = (unsigned)wid * 1024u;
    const int aoff = lds_byte(wr * 64 + fr, fq * 8), boff = lds_byte(wc * 32 + fr, fq * 8);
#define PG8_SA(b, h) (((b) * 2 + (h)) * HTB)
#define PG8_SB(b, h) ((4 + (b) * 2 + (h)) * HTB)
#define PG8_STAGE(bufoff, gbase, voff) do { _Pragma("unroll") for (int _i = 0; _i < 2; ++_i) \
        __builtin_amdgcn_global_load_lds((const unsigned*)((const char*)(gbase) + (voff)[_i]), (PG8_LAS unsigned*)(lds + (bufoff) + ldsw + _i * 8192), 16, 0, 0); } while (0)
#define PG8_LDA(dst, b, h) do { _Pragma("unroll") for (int m = 0; m < 4; ++m) _Pragma("unroll") for (int k = 0; k < 2; ++k) dst[m][k] = *(const PG8_LAS bf16x8*)(lds + PG8_SA(b, h) + aoff + m * 2048 + k * 1024); } while (0)
#define PG8_LDB(dst, b, h) do { _Pragma("unroll") for (int n = 0; n < 2; ++n) _Pragma("unroll") for (int k = 0; k < 2; ++k) dst[n][k] = *(const PG8_LAS bf16x8*)(lds + PG8_SB(b, h) + boff + n * 2048 + k * 1024); } while (0)
#define PG8_MMA(ai, bj, At, Bt) do { __builtin_amdgcn_s_setprio(1); _Pragma("unroll") for (int m = 0; m < 4; ++m) _Pragma("unroll") for (int n = 0; n < 2; ++n) _Pragma("unroll") for (int k = 0; k < 2; ++k) \
        acc[ai][bj][m][n] = __builtin_amdgcn_mfma_f32_16x16x32_bf16(Bt[n][k], At[m][k], acc[ai][bj][m][n], 0, 0, 0); __builtin_amdgcn_s_setprio(0); } while (0)
#define PG8_WAIT_V(n) asm volatile("s_waitcnt vmcnt(" #n ")" ::: "memory")
#define PG8_WAIT_L(n) asm volatile("s_waitcnt lgkmcnt(" #n ")" ::: "memory")
#define PG8_BAR __builtin_amdgcn_s_barrier()
#define PG8_SCHED __builtin_amdgcn_sched_barrier(0)
    Unit cur, nxt; int ui = 0;
    if (!S.next(0, cur)) return;
    f32x4 acc[2][2][4][2];
#pragma unroll
    for (int a = 0; a < 2; ++a)
#pragma unroll
        for (int b = 0; b < 2; ++b)
#pragma unroll
            for (int m = 0; m < 4; ++m)
#pragma unroll
                for (int n = 0; n < 2; ++n) acc[a][b][m][n] = (f32x4){0.f, 0.f, 0.f, 0.f};
    bf16x8 At[4][2], B0[2][2], B1[2][2];
    const char* cA = (const char*)g.A + (size_t)cur.pm * tstep; const char* cB = (const char*)g.Bt + (size_t)cur.pn * tstep;
    S.a_ready(cur);
    if constexpr (SP2) {
        PG8_STAGE(PG8_SB(0, 0), cB, voffB); PG8_STAGE(PG8_SB(0, 1), cB + hstep, voffB); PG8_STAGE(PG8_SA(0, 0), cA, voffA); PG8_STAGE(PG8_SA(0, 1), cA + hstep, voffA);
        if (wr == 1) PG8_BAR;
        PG8_WAIT_V(2); PG8_BAR;
        PG8_STAGE(PG8_SB(1, 0), cB + kstep, voffB); PG8_STAGE(PG8_SA(1, 0), cA + kstep, voffA); PG8_STAGE(PG8_SB(1, 1), cB + hstep + kstep, voffB);
        PG8_WAIT_V(6); PG8_BAR;
    } else {
        PG8_STAGE(PG8_SB(0, 0), cB, voffB); PG8_STAGE(PG8_SA(0, 0), cA, voffA); PG8_STAGE(PG8_SB(0, 1), cB + hstep, voffB); PG8_STAGE(PG8_SA(0, 1), cA + hstep, voffA);
        if (wr == 1) PG8_BAR;
        PG8_WAIT_V(4); PG8_BAR;
        PG8_STAGE(PG8_SB(1, 0), cB + kstep, voffB); PG8_STAGE(PG8_SA(1, 0), cA + kstep, voffA); PG8_STAGE(PG8_SB(1, 1), cB + hstep + kstep, voffB);
        PG8_WAIT_V(6); PG8_BAR;
    }
    for (;;) {
        const bool has_next = S.next(ui + 1, nxt);
        const char* nA = has_next ? (const char*)g.A + (size_t)nxt.pm * tstep : cA; const char* nB = has_next ? (const char*)g.Bt + (size_t)nxt.pn * tstep : cB;
        for (int t = 0; t < nt; t += 2) {
            const bool last = (t == nt - 2);
            const char* a1 = cA + (size_t)(t + 1) * kstep;
            const char* a2 = last ? nA : cA + (size_t)(t + 2) * kstep; const char* b2 = last ? nB : cB + (size_t)(t + 2) * kstep;
            const char* a3 = a2 + kstep; const char* b3 = b2 + kstep;
            if (last && has_next) S.a_ready(nxt);
            if constexpr (SP2) {
            PG8_LDB(B0, 0, 0); PG8_LDB(B1, 0, 1); PG8_SCHED; PG8_LDA(At, 0, 0); PG8_STAGE(PG8_SA(1, 1), a1 + hstep, voffA);
            PG8_WAIT_V(8); PG8_WAIT_L(0); PG8_BAR; PG8_MMA(0, 0, At, B0); PG8_MMA(0, 1, At, B1); PG8_BAR; PG8_SCHED;
            PG8_LDA(At, 0, 1); PG8_STAGE(PG8_SB(0, 0), b2, voffB); PG8_STAGE(PG8_SB(0, 1), b2 + hstep, voffB); PG8_STAGE(PG8_SA(0, 0), a2, voffA);
            PG8_WAIT_V(8); PG8_WAIT_L(0); PG8_BAR; PG8_MMA(1, 0, At, B0); PG8_MMA(1, 1, At, B1); PG8_BAR; PG8_SCHED;
            PG8_LDB(B0, 1, 0); PG8_LDB(B1, 1, 1); PG8_SCHED; PG8_LDA(At, 1, 0); PG8_STAGE(PG8_SA(0, 1), a2 + hstep, voffA);
            PG8_WAIT_V(8); PG8_WAIT_L(0); PG8_BAR; PG8_MMA(0, 0, At, B0); PG8_MMA(0, 1, At, B1); PG8_BAR; PG8_SCHED;
            PG8_LDA(At, 1, 1); PG8_STAGE(PG8_SB(1, 0), b3, voffB); PG8_STAGE(PG8_SB(1, 1), b3 + hstep, voffB); PG8_STAGE(PG8_SA(1, 0), a3, voffA);
            PG8_WAIT_V(8); PG8_WAIT_L(0); PG8_BAR; PG8_MMA(1, 0, At, B0); PG8_MMA(1, 1, At, B1); PG8_BAR; PG8_SCHED;
            } else {
            PG8_LDB(B0, 0, 0); PG8_SCHED; PG8_LDA(At, 0, 0); PG8_STAGE(PG8_SA(1, 1), a1 + hstep, voffA);
            PG8_WAIT_L(8); PG8_BAR; PG8_WAIT_L(0); PG8_MMA(0, 0, At, B0); PG8_BAR; PG8_SCHED;
            PG8_LDB(B1, 0, 1); PG8_STAGE(PG8_SB(0, 0), b2, voffB);
            PG8_BAR; PG8_WAIT_L(0); PG8_MMA(0, 1, At, B1); PG8_BAR;
            PG8_LDA(At, 0, 1); PG8_STAGE(PG8_SA(0, 0), a2, voffA);
            PG8_BAR; PG8_WAIT_L(0); PG8_MMA(1, 0, At, B0); PG8_BAR; PG8_SCHED;
            PG8_STAGE(PG8_SB(0, 1), b2 + hstep, voffB);
            PG8_WAIT_V(6); PG8_BAR; PG8_MMA(1, 1, At, B1); PG8_BAR;
            PG8_LDB(B0, 1, 0); PG8_SCHED; PG8_LDA(At, 1, 0); PG8_STAGE(PG8_SA(0, 1), a2 + hstep, voffA);
            PG8_WAIT_L(8); PG8_BAR; PG8_WAIT_L(0); PG8_MMA(0, 0, At, B0); PG8_BAR; PG8_SCHED;
            PG8_LDB(B1, 1, 1); PG8_STAGE(PG8_SB(1, 0), b3, voffB);
            PG8_BAR; PG8_WAIT_L(0); PG8_MMA(0, 1, At, B1); PG8_BAR;
            PG8_LDA(At, 1, 1); PG8_STAGE(PG8_SA(1, 0), a3, voffA);
            PG8_BAR; PG8_WAIT_L(0); PG8_MMA(1, 0, At, B0); PG8_BAR; PG8_SCHED;
            PG8_STAGE(PG8_SB(1, 1), b3 + hstep, voffB);
            PG8_WAIT_V(6); PG8_BAR; PG8_MMA(1, 1, At, B1); PG8_BAR;
            }
        }
        if constexpr (ALIGN_EPI) { if (wr == 0) PG8_BAR; }
        if constexpr (!Epi::AFTER_DRAIN) { E(acc, cur, wr, wc, fr, fq); S.done(cur); }
        if (!has_next) break;
#pragma unroll
        for (int a = 0; a < 2; ++a)
#pragma unroll
            for (int b = 0; b < 2; ++b)
#pragma unroll
                for (int m = 0; m < 4; ++m)
#pragma unroll
                    for (int n = 0; n < 2; ++n) acc[a][b][m][n] = (f32x4){0.f, 0.f, 0.f, 0.f};
        cur = nxt; cA = nA; cB = nB; ++ui;
        if constexpr (ALIGN_EPI) { if (wr == 1) PG8_BAR; }
    }
    PG8_WAIT_V(0);
    if constexpr (!ALIGN_EPI) { if (wr == 0) PG8_BAR; }
    PG8_BAR;
    if constexpr (Epi::AFTER_DRAIN) { E.fused(acc, cur, wr, wc, fr, fq, lds, wid, lane); S.done(cur); }
#undef PG8_SA
#undef PG8_SB
#undef PG8_STAGE
#undef PG8_LDA
#undef PG8_LDB
#undef PG8_MMA
#undef PG8_WAIT_V
#undef PG8_WAIT_L
#undef PG8_BAR
#undef PG8_SCHED
}
}

using pg8::bf16_t; using pg8::f32x4;
#define LAS __attribute__((address_space(3)))
constexpr int DM = 2048, NB = 2, SEQ = 4096, LCX = 256, DEPTH = 4;
constexpr int NLAT = NB * SEQ;
constexpr int MROWS = NLAT + NB * LCX;
constexpr int NIN = 6176, NINP = 6400;
constexpr int PQ = 0, PK = 512, PV = 1024, PU = 2048, PGG = 2560, PSG = 3584, PHV = 4096, PHG = 5632, PLR = 6144;
constexpr float EPS = 1e-6f;
constexpr int NT = 512;

__host__ __device__ __forceinline__ int in_col_map(int n) {
    if (n < 2048) return n;
    if (n < 6144) return n + 32;
    if (n < 6176) return n - 4096;
    return -1;
}

constexpr size_t al256(size_t x) { return (x + 255) & ~(size_t)255; }
constexpr size_t WS_WIN  = 0;
constexpr size_t WS_WOUT = WS_WIN  + al256((size_t)DEPTH * NINP * DM * 2);
constexpr size_t WS_WGLU = WS_WOUT + al256((size_t)DEPTH * DM * DM * 2);
constexpr size_t WS_MOD  = WS_WGLU + al256((size_t)DEPTH * 512 * 512 * 2);
constexpr size_t WS_H    = WS_MOD  + al256((size_t)DEPTH * 3 * 6144 * 4);
constexpr size_t WS_YCAT = WS_H    + al256((size_t)MROWS * DM * 2);
constexpr size_t WS_P    = WS_YCAT + al256((size_t)MROWS * DM * 2);
constexpr size_t WS_XC   = WS_P    + al256((size_t)MROWS * NINP * 4);
constexpr size_t WS_OG   = WS_XC   + al256((size_t)NB * LCX * DM * 4);
constexpr size_t WS_YS5  = WS_OG   + al256((size_t)2 * MROWS * 1024 * 4);
constexpr size_t WS_YG   = WS_YS5  + al256((size_t)MROWS * 512 * 4);
constexpr size_t WS_HT   = WS_YG   + al256((size_t)MROWS * 512 * 2);
constexpr size_t WS_TP   = WS_HT   + al256((size_t)MROWS * 2048 * 4);
constexpr size_t HO_C = (size_t)2 * 512 * SEQ, TPC_OFF = HO_C + (size_t)2 * 512 * LCX;
constexpr size_t WS_HS   = WS_TP   + al256((TPC_OFF + (size_t)2 * 512 * 2 * LCX) * 4);
constexpr size_t WS_H2   = WS_HS   + al256((size_t)2 * 512 * 8192 * 8);
constexpr size_t WS_GLA  = WS_H2   + al256((size_t)DEPTH * SEQ * 64 * 4);
constexpr size_t WS_S5W  = WS_GLA  + al256((size_t)72 * 1000 * 1000);
constexpr size_t WS_CTL  = WS_S5W  + al256((size_t)22 * 1000 * 1000);
constexpr size_t CTL_BYTES = 16384;
constexpr size_t WS_END  = WS_CTL  + CTL_BYTES;

struct Params {
    const float* in[33];
    float* out;
    unsigned char* ws;
};

#define KARG_AS __attribute__((address_space(4)))
__device__ __forceinline__ const void* karg_ptr(int byte_off) {
    asm volatile("" : "+s"(byte_off));
    const KARG_AS char* ka = (const KARG_AS char*)__builtin_amdgcn_kernarg_segment_ptr();
    return *(void* const KARG_AS*)(ka + byte_off);
}
#define INP(p, i) ((const float*)karg_ptr(8 * (i)))
#define OUTP(p) ((float*)karg_ptr(8 * 33))
#define WSP(p) ((unsigned char*)karg_ptr(8 * 34))
static_assert(sizeof(Params) == 35 * 8, "Params layout: in[33], out, ws");
enum { I_X = 0, I_C, I_CTX, I_CCTX, I_WMOD, I_BMOD, I_GPRE, I_GPOST, I_WIN, I_WOUT, I_GWG, I_GBG, I_GNORM,
       I_LRE, I_LIM, I_LSTEP, I_BRE, I_BIM, I_CRE, I_CIM, I_S5D, I_WGLU, I_BGLU, I_HCW, I_HCB, I_HW1, I_HB1, I_HF1, I_HW2, I_HB2, I_HF2, I_HW3, I_HD };

__device__ __forceinline__ float wave_sum(float v) {
#pragma unroll
    for (int o = 1; o < 64; o <<= 1) v += __shfl_xor(v, o);
    return v;
}
__device__ __forceinline__ float silu_f(float x) { return x / (1.f + expf(-x)); }
__device__ __forceinline__ float gelu_tanh(float x) { const float u = 0.7978845608028654f * (x + 0.044715f * x * x * x); return 0.5f * x * (1.f + tanhf(u)); }
__device__ __forceinline__ unsigned pk2(float lo, float hi) { return pg8::cvt_pk_bf16(lo, hi); }
__device__ __forceinline__ int otid() { int t = threadIdx.x; asm volatile("" : "+v"(t)); return t; }
__device__ __forceinline__ int permtok(int t) { return ((t & 63) << 6) | (t >> 6); }

template <bool MAPIN>
__device__ __forceinline__ void transpose_item(const float* __restrict__ W, int ldw, int K, bf16_t* __restrict__ WT, int k0, int n0, float* tile) {
    const int tid = otid();
#pragma unroll
    for (int j = 0; j < 32; ++j) { const int i = tid + NT * j, kk = i >> 8, nn = i & 255; int oc = n0 + nn; if (MAPIN) oc = in_col_map(oc);
        tile[kk * 257 + nn] = (oc >= 0) ? W[(size_t)(k0 + kk) * ldw + oc] : 0.f; }
    __syncthreads();
    { const int n = tid >> 1, kh = tid & 1; bf16_t* dst = WT + (size_t)(n0 + n) * K + k0 + 32 * kh;
#pragma unroll
      for (int c = 0; c < 4; ++c) { const float* s = tile + (32 * kh + 8 * c) * 257 + n;
          *(uint4*)(dst + 8 * c) = make_uint4(pk2(s[0], s[257]), pk2(s[2 * 257], s[3 * 257]), pk2(s[4 * 257], s[5 * 257]), pk2(s[6 * 257], s[7 * 257])); } }
    __syncthreads();
}
constexpr int TI_IN = (DM / 64) * (NINP / 256), TI_OUT = (DM / 64) * (DM / 256), TI_GLU = 8 * 2;
constexpr int N_TITEMS = DEPTH * (TI_IN + TI_OUT + TI_GLU);
__device__ __forceinline__ void phase_weights(const Params& p, int bid, int nb, float* smem) {
    for (int it = bid; it < N_TITEMS; it += nb) {
        int r = it;
        if (r < DEPTH * TI_IN) { const int l = r / TI_IN, q = r % TI_IN, kb = q / (NINP / 256), nbk = q % (NINP / 256);
            transpose_item<true>(INP(p, I_WIN) + (size_t)l * DM * NIN, NIN, DM, (bf16_t*)(WSP(p) + WS_WIN) + (size_t)l * NINP * DM, kb * 64, nbk * 256, smem); continue; }
        r -= DEPTH * TI_IN;
        if (r < DEPTH * TI_OUT) { const int l = r / TI_OUT, q = r % TI_OUT, kb = q / 8, nbk = q % 8;
            transpose_item<false>(INP(p, I_WOUT) + (size_t)l * DM * DM, DM, DM, (bf16_t*)(WSP(p) + WS_WOUT) + (size_t)l * DM * DM, kb * 64, nbk * 256, smem); continue; }
        r -= DEPTH * TI_OUT;
        { const int l = r / TI_GLU, q = r % TI_GLU, kb = q / 2, nbk = q % 2;
            transpose_item<false>(INP(p, I_WGLU) + (size_t)l * 512 * 512, 512, 512, (bf16_t*)(WSP(p) + WS_WGLU) + (size_t)l * 512 * 512, kb * 64, nbk * 256, smem); }
    }
}
constexpr int N_MODITEMS = DEPTH * (6144 / 64);
__device__ __forceinline__ void phase_mod(const Params& p, int bid, int nb, float* smem) {
    const int tid = otid(); float* sv = smem;   float* red = smem + 3 * 2048;
    bool loaded = false;
    for (int it = bid; it < N_MODITEMS; it += nb) {
        if (!loaded) { for (int i = tid; i < 3 * 2048; i += NT) { const int r = i >> 11, k = i & 2047; const float c = (r < 2) ? INP(p, I_C)[r * 2048 + k] : INP(p, I_CCTX)[k]; sv[i] = silu_f(c); } loaded = true; }
        __syncthreads();
        const int l = it / 96, jb = it % 96, cl = tid & 15, kg = tid >> 4;
        const float* w = INP(p, I_WMOD) + (size_t)l * DM * 6144 + jb * 64 + cl * 4;
        f32x4 a0 = {0, 0, 0, 0}, a1 = a0, a2 = a0;
#pragma unroll 16
        for (int kk = 0; kk < 64; ++kk) { const int k = kg * 64 + kk; const f32x4 wv = *(const f32x4*)(w + (size_t)k * 6144);
            a0 += wv * sv[k]; a1 += wv * sv[2048 + k]; a2 += wv * sv[4096 + k]; }
        *(f32x4*)(red + (kg * 3 + 0) * 64 + cl * 4) = a0; *(f32x4*)(red + (kg * 3 + 1) * 64 + cl * 4) = a1; *(f32x4*)(red + (kg * 3 + 2) * 64 + cl * 4) = a2;
        __syncthreads();
        if (tid < 192) { const int r = tid >> 6, c = tid & 63; float s = INP(p, I_BMOD)[l * 6144 + jb * 64 + c];
            for (int g = 0; g < 32; ++g) s += red[(g * 3 + r) * 64 + c];
            ((float*)(WSP(p) + WS_MOD))[(size_t)(l * 3 + r) * 6144 + jb * 64 + c] = s; }
        __syncthreads();
    }
}
__device__ __forceinline__ void taps_item(const Params& p, int l, int LX, float* TP, int tb, int cb, float* smem) {
    const int tid = otid();
    float* feats = smem;
    float* h1 = feats + 64 * 33;
    float* h2 = h1 + 64 * 64;
    float* T = h2 + 64 * 64;
    const float* w1 = INP(p, I_HW1) + l * 33 * 64; const float* b1 = INP(p, I_HB1) + l * 64; const float* f1 = INP(p, I_HF1) + l * 64;
    const float* w2 = INP(p, I_HW2) + l * 64 * 64; const float* b2 = INP(p, I_HB2) + l * 64; const float* f2 = INP(p, I_HF2) + l * 64;
    const float* w3 = INP(p, I_HW3) + (size_t)l * 64 * 2048;
#pragma unroll 1
    for (int i = tid; i < 64 * 33; i += NT) { const int tt = i / 33, f = i % 33; const int tau = tb * 64 + tt;
        const float ang = (6.283185307179586f / (float)LX) * (float)tau; float v;
        if (f == 0) v = (float)tau / (float)(LX - 1);
        else { const int bi = (f - 1) & 15; const float band = 1e-4f + (float)bi * ((15.0f - 1e-4f) / 15.0f); const float a = band * ang; v = (f <= 16) ? cosf(a) : -sinf(a); }
        feats[i] = v; }
    __syncthreads();
#pragma unroll 1
    for (int i = tid; i < 64 * 64; i += NT) { const int tt = i >> 6, j = i & 63; float s = b1[j];
#pragma unroll 3
        for (int f = 0; f < 33; ++f) s += feats[tt * 33 + f] * w1[f * 64 + j];
        h1[i] = sinf(f1[j] * s); }
    __syncthreads();
#pragma unroll 1
    for (int i = tid; i < 64 * 64; i += NT) { const int tt = i >> 6, j = i & 63; float s = b2[j];
#pragma unroll 4
        for (int f = 0; f < 64; ++f) s += h1[tt * 64 + f] * w2[f * 64 + j];
        h2[i] = sinf(f2[j] * s); }
    __syncthreads();
    { const int cc = tid & 255, th = tid >> 8, col = cb * 256 + cc; float w3r[64];
#pragma unroll
      for (int i = 0; i < 64; ++i) w3r[i] = w3[(size_t)i * 2048 + col];
      const int c = col & 511; const float delta = fabsf(-15.350567286626973f + (float)c * ((-3.0701134573253945f + 15.350567286626973f) / 511.0f));
#pragma unroll 2
      for (int e = 0; e < 32; ++e) { const float* hrow = h2 + (th * 32 + e) * 64; float a = 0.f;
#pragma unroll
          for (int i4 = 0; i4 < 16; ++i4) { const f32x4 hv = *(const f32x4*)(hrow + 4 * i4);
              a += w3r[4 * i4] * hv[0] + w3r[4 * i4 + 1] * hv[1] + w3r[4 * i4 + 2] * hv[2] + w3r[4 * i4 + 3] * hv[3]; }
          const int tau = tb * 64 + th * 32 + e; const float tl = (float)tau / (float)(LX - 1); T[cc * 65 + th * 32 + e] = a * expf(-tl * delta); } }
    __syncthreads();
    { const int tt = tid & 63, cg = tid >> 6; const int tau = tb * 64 + tt;
#pragma unroll 2
      for (int q = 0; q < 32; ++q) { const int cc = cg * 32 + q, col = cb * 256 + cc; const int o = col >> 10, dir = (col >> 9) & 1, c = col & 511;
          float* dst = TP + (size_t)(o * 512 + c) * (2 * LX);
          if (dir == 0) dst[LX - 1 + tau] = T[cc * 65 + tt];
          else if (tau >= 1) dst[LX - 1 - tau] = T[cc * 65 + tt]; } }
    __syncthreads();
}
constexpr int N_H2ITEMS = DEPTH * (SEQ / 64);
__device__ __forceinline__ void h2_item(const Params& p, int it, float* smem) {
    const int tid = otid(); const int l = it / (SEQ / 64), tb = it % (SEQ / 64); constexpr int LX = SEQ;
    float* dst = (float*)(WSP(p) + WS_H2) + (size_t)l * 64 * SEQ + tb * 64;
    float* feats = smem; float* h1 = feats + 64 * 33;
    const float* w1 = INP(p, I_HW1) + l * 33 * 64; const float* b1 = INP(p, I_HB1) + l * 64; const float* f1 = INP(p, I_HF1) + l * 64;
    const float* w2 = INP(p, I_HW2) + l * 64 * 64; const float* b2 = INP(p, I_HB2) + l * 64; const float* f2 = INP(p, I_HF2) + l * 64;
#pragma unroll 1
    for (int i = tid; i < 64 * 33; i += NT) { const int tt = i / 33, f = i % 33; const int tau = tb * 64 + tt;
        const float ang = (6.283185307179586f / (float)LX) * (float)tau; float v;
        if (f == 0) v = (float)tau / (float)(LX - 1);
        else { const int bi = (f - 1) & 15; const float band = 1e-4f + (float)bi * ((15.0f - 1e-4f) / 15.0f); const float a = band * ang; v = (f <= 16) ? cosf(a) : -sinf(a); }
        feats[i] = v; }
    __syncthreads();
#pragma unroll 1
    for (int i = tid; i < 64 * 64; i += NT) { const int tt = i >> 6, j = i & 63; float s = b1[j];
#pragma unroll 3
        for (int f = 0; f < 33; ++f) s += feats[tt * 33 + f] * w1[f * 64 + j];
        h1[tt * 65 + j] = sinf(f1[j] * s); }
    __syncthreads();
#pragma unroll 1
    for (int i = tid; i < 64 * 64; i += NT) { const int j = i >> 6, tt = i & 63; float s = b2[j];
#pragma unroll 4
        for (int f = 0; f < 64; ++f) s += h1[tt * 65 + f] * w2[f * 64 + j];
        dst[(size_t)j * SEQ + tt] = sinf(f2[j] * s); }
    __syncthreads();
}
constexpr int N_CTAPITEMS = (LCX / 64) * 8;
__device__ __forceinline__ void ctaps_item(const Params& p, int l, int it, float* smem) { taps_item(p, l, LCX, (float*)(WSP(p) + WS_TP) + TPC_OFF, it >> 3, it & 7, smem); }

__device__ __forceinline__ void phase_row(const Params& p, int l, int bid, int nb) {
    const int tid_ = otid(); const int lane = tid_ & 63, wave = tid_ >> 6;
    const float* MOD = (const float*)(WSP(p) + WS_MOD); const float* R = (const float*)(WSP(p) + WS_P);
    float* XC = (float*)(WSP(p) + WS_XC); bf16_t* H = (bf16_t*)(WSP(p) + WS_H);
    const int nrows = (l == DEPTH) ? NLAT : MROWS;
    for (int r = bid * 8 + wave; r < nrows; r += nb * 8) {
        const bool lat = r < NLAT; const int b = lat ? (r >> 12) : 0, t = r & 4095, rb = lat ? b : 2;
        const float* xin; float* xout;
        if (lat) { xin = ((l <= 1) ? INP(p, I_X) : OUTP(p)) + (size_t)r * DM; xout = OUTP(p) + (size_t)r * DM; }
        else { xin = ((l <= 1) ? INP(p, I_CTX) : XC) + (size_t)(r - NLAT) * DM; xout = XC + (size_t)(r - NLAT) * DM; }
        f32x4 x[8];
#pragma unroll
        for (int j = 0; j < 8; ++j) x[j] = *(const f32x4*)(xin + 4 * lane + 256 * j);
        if (l > 0) {
            const int lp = l - 1; const int rr = (lat && (lp & 1)) ? (b * SEQ + permtok(t)) : r;
            const float* Rr = R + (size_t)rr * DM; f32x4 v[8]; float ss = 0.f;
#pragma unroll
            for (int j = 0; j < 8; ++j) { v[j] = *(const f32x4*)(Rr + 4 * lane + 256 * j); ss += v[j][0] * v[j][0] + v[j][1] * v[j][1] + v[j][2] * v[j][2] + v[j][3] * v[j][3]; }
            const float rs = rsqrtf(wave_sum(ss) * (1.f / DM) + EPS);
            const float* gate = MOD + (size_t)(lp * 3 + rb) * 6144 + 4096; const float* gp = INP(p, I_GPOST) + lp * DM;
#pragma unroll
            for (int j = 0; j < 8; ++j) { const f32x4 g = *(const f32x4*)(gate + 4 * lane + 256 * j), w = *(const f32x4*)(gp + 4 * lane + 256 * j);
                x[j] = x[j] + g * (v[j] * rs * w); *(f32x4*)(xout + 4 * lane + 256 * j) = x[j]; }
        }
        if (l < DEPTH) {
            float ss = 0.f;
#pragma unroll
            for (int j = 0; j < 8; ++j) ss += x[j][0] * x[j][0] + x[j][1] * x[j][1] + x[j][2] * x[j][2] + x[j][3] * x[j][3];
            const float rs = rsqrtf(wave_sum(ss) * (1.f / DM) + EPS);
            const float* shift = MOD + (size_t)(l * 3 + rb) * 6144; const float* scale = shift + 2048; const float* gp = INP(p, I_GPRE) + l * DM;
            const int hr = (lat && (l & 1)) ? (b * SEQ + permtok(t)) : r;
            bf16_t* hrow = H + (size_t)hr * DM;
#pragma unroll
            for (int j = 0; j < 8; ++j) { const f32x4 sh = *(const f32x4*)(shift + 4 * lane + 256 * j), sc = *(const f32x4*)(scale + 4 * lane + 256 * j), w = *(const f32x4*)(gp + 4 * lane + 256 * j);
                const f32x4 y = (x[j] * rs * w) * (sc + 1.f) + sh; uint2 o; o.x = pk2(y[0], y[1]); o.y = pk2(y[2], y[3]);
                *(uint2*)(hrow + 4 * lane + 256 * j) = o; }
        }
    }
}

constexpr int N_HTITEMS = (MROWS / 64) * 32;
__device__ __forceinline__ void phase_hyT(const Params& p, int bid, int nb, float* tile) {
    const int tid = otid(); const float* P = (const float*)(WSP(p) + WS_P); float* HT = (float*)(WSP(p) + WS_HT); float* HTC = HT + (size_t)NB * 2048 * SEQ;
    for (int it = bid; it < N_HTITEMS; it += nb) {
        const int rb = it >> 5, cb = it & 31, r0 = rb * 64, c0 = cb * 64;
#pragma unroll
        for (int j = 0; j < 8; ++j) { const int i = tid + NT * j, rr = i >> 6, cc = i & 63; tile[cc * 65 + rr] = P[(size_t)(r0 + rr) * NINP + PHV + c0 + cc]; }
        __syncthreads();
        { const int cc = tid >> 3, tq = tid & 7; const float* s = tile + cc * 65 + tq * 8; float* dst;
          if (r0 < NLAT) { const int b = r0 >> 12, t0 = r0 & 4095; dst = HT + ((size_t)(b * 2048 + c0 + cc)) * SEQ + t0 + tq * 8; }
          else { const int q = r0 - NLAT, b = q >> 8, t0 = q & 255; dst = HTC + ((size_t)(b * 2048 + c0 + cc)) * LCX + t0 + tq * 8; }
          f32x4 a = {s[0], s[1], s[2], s[3]}, bq = {s[4], s[5], s[6], s[7]}; *(f32x4*)dst = a; *(f32x4*)(dst + 4) = bq; }
        __syncthreads();
    }
}

__device__ __forceinline__ int seq_row(int b, int dir, int n) {
    if (n < LCX) { const int tc = dir ? (LCX - 1 - n) : n; return NLAT + b * LCX + tc; }
    const int m = n - LCX; const int t = dir ? (SEQ - 1 - m) : m; return b * SEQ + t;
}
__device__ __forceinline__ void phase_gla_naive(const Params& p, int l, int bid, int nb, float* smem) {
    const int tid = otid(); const float* P = (const float*)(WSP(p) + WS_P); float* OG = (float*)(WSP(p) + WS_OG);
    float* sq = smem; float* sk = sq + 8 * 128; float* se = sk + 8 * 128; float* sv = se + 8 * 128; float* so = sv + 8 * 256;
    for (int it = bid; it < 16; it += nb) {
        const int b = it >> 3, dir = (it >> 2) & 1, h = it & 3;
        const int j = tid & 255, half = tid >> 8, kk0 = tid & 127;
        float* swg = so + 16 * 256;
        for (int i = tid; i < 16 * 128; i += NT) swg[i] = INP(p, I_GWG)[((size_t)(l * 2 + dir) * 16 + (i >> 7)) * 512 + h * 128 + (i & 127)];
        __syncthreads();
        const float bgk = INP(p, I_GBG)[(l * 2 + dir) * 512 + h * 128 + kk0];
        float S[64];
#pragma unroll
        for (int k = 0; k < 64; ++k) S[k] = 0.f;
        for (int sb = 0; sb < (SEQ + LCX) / 8; ++sb) {
#pragma unroll
            for (int e = 0; e < 2; ++e) { const int i = (tid >> 7) + 4 * e; const int row = seq_row(b, dir, sb * 8 + i); const float* pr = P + (size_t)row * NINP;
                float z = bgk;
#pragma unroll
                for (int r = 0; r < 16; ++r) z += pr[PLR + dir * 16 + r] * swg[r * 128 + kk0];
                const float ls = fminf(z, 0.f) - log1pf(expf(-fabsf(z)));
                sq[i * 128 + kk0] = pr[PQ + h * 128 + kk0] * 0.08838834764831845f; sk[i * 128 + kk0] = pr[PK + h * 128 + kk0]; se[i * 128 + kk0] = expf(ls * (1.f / 16.f)); }
#pragma unroll
            for (int e = 0; e < 4; ++e) { const int idx = tid + NT * e, i = idx >> 8, jj = idx & 255; const int row = seq_row(b, dir, sb * 8 + i); sv[i * 256 + jj] = P[(size_t)row * NINP + PV + h * 256 + jj]; }
            __syncthreads();
#pragma unroll 1
            for (int i = 0; i < 8; ++i) { const float vj = sv[i * 256 + j]; float o = 0.f;
                const f32x4* q4 = (const f32x4*)(sq + i * 128 + half * 64); const f32x4* k4 = (const f32x4*)(sk + i * 128 + half * 64); const f32x4* e4 = (const f32x4*)(se + i * 128 + half * 64);
#pragma unroll
                for (int k = 0; k < 16; ++k) { const f32x4 qv = q4[k], kv = k4[k], ev = e4[k];
#pragma unroll
                    for (int c = 0; c < 4; ++c) { float s = S[4 * k + c] * ev[c]; if (dir == 0) { s += kv[c] * vj; o += qv[c] * s; } else { o += qv[c] * s; s += kv[c] * vj; } S[4 * k + c] = s; } }
                so[(half * 8 + i) * 256 + j] = o; }
            __syncthreads();
            for (int e = tid; e < 8 * 256; e += NT) { const int i = e >> 8, jj = e & 255; const int row = seq_row(b, dir, sb * 8 + i);
                OG[((size_t)dir * MROWS + row) * 1024 + h * 256 + jj] = so[i * 256 + jj] + so[(8 + i) * 256 + jj]; }
            __syncthreads();
        }
    }
}
__device__ __forceinline__ void phase_s5_naive(const Params& p, int l, int bid, int nb, float* smem) {
    const int tid = otid(), lane = tid & 63, wave = tid >> 6; const float* P = (const float*)(WSP(p) + WS_P); float* YS = (float*)(WSP(p) + WS_YS5);
    float2* sC = (float2*)smem + wave * (16 * 64);
    float2* xs = (float2*)smem + 8 * 16 * 64 + wave * (16 * 65);
    for (int wb = bid; wb < 16; wb += nb) {
        const int gw = wb * 8 + wave, b = gw >> 6, dir = (gw >> 5) & 1, g = gw & 31;
        const size_t pg = ((size_t)(l * 2 + dir) * 32 + g);
        const float lr = INP(p, I_LRE)[pg * 64 + lane], li = INP(p, I_LIM)[pg * 64 + lane], step = expf(INP(p, I_LSTEP)[pg]);
        const float em1 = expm1f(lr * step); float sn, cs; sincosf(li * step, &sn, &cs); const float shf = sinf(0.5f * li * step);
        const float lbr = (em1 + 1.f) * cs, lbi = (em1 + 1.f) * sn;
        const float den = lr * lr + li * li, nr = em1 * cs - 2.f * shf * shf, ni = lbi;
        const float cr = (nr * lr + ni * li) / den, ci = (ni * lr - nr * li) / den;
        float Br[16], Bi[16];
#pragma unroll
        for (int hh = 0; hh < 16; ++hh) { const float br = INP(p, I_BRE)[(pg * 64 + lane) * 16 + hh], bi = INP(p, I_BIM)[(pg * 64 + lane) * 16 + hh]; Br[hh] = cr * br - ci * bi; Bi[hh] = cr * bi + ci * br; }
        for (int i = lane; i < 16 * 64; i += 64) sC[i] = make_float2(INP(p, I_CRE)[pg * 1024 + i], INP(p, I_CIM)[pg * 1024 + i]);
        float xr = 0.f, xi = 0.f;
        for (int blk = 0; blk < (SEQ + LCX) / 16; ++blk) {
            for (int i = 0; i < 16; ++i) { const int row = seq_row(b, dir, blk * 16 + i); const float* u = P + (size_t)row * NINP + PU + g * 16;
                float bur = 0.f, bui = 0.f;
#pragma unroll
                for (int q = 0; q < 4; ++q) { const f32x4 uv = *(const f32x4*)(u + 4 * q);
#pragma unroll
                    for (int c = 0; c < 4; ++c) { bur += Br[4 * q + c] * uv[c]; bui += Bi[4 * q + c] * uv[c]; } }
                const float nxr = lbr * xr - lbi * xi + bur, nxi = lbr * xi + lbi * xr + bui; xr = nxr; xi = nxi;
                xs[i * 65 + lane] = make_float2(xr, xi); }
            __syncthreads();
            { const int tt = lane & 15, hg = lane >> 4; float y[4] = {0.f, 0.f, 0.f, 0.f};
              for (int q = 0; q < 64; ++q) { const float2 xv = xs[tt * 65 + q];
#pragma unroll
                  for (int e = 0; e < 4; ++e) { const float2 c = sC[(hg * 4 + e) * 64 + q]; y[e] += c.x * xv.x - c.y * xv.y; } }
              const int row = seq_row(b, dir, blk * 16 + tt);
              f32x4 o = {y[0], y[1], y[2], y[3]}; *(f32x4*)(YS + ((size_t)dir * MROWS + row) * 512 + g * 16 + hg * 4) = o; }
            __syncthreads();
        }
    }
}
template <int LX, int NTT>
__device__ __forceinline__ void hy_naive_item(const Params& p, int l, const float* TP, const float* HTb, float* HOb, int c, float* smem) {
    const int tid = otid();
    float* tp = smem; float* vb = tp + 2 * LX; float* zb = vb + 2 * LX;
    const float* cw = INP(p, I_HCW) + (size_t)l * 3 * 1536; const float* cb = INP(p, I_HCB) + (size_t)l * 1536; const float* hd = INP(p, I_HD) + (size_t)l * 2 * 512;
#define SHORTC(dst, chan) do { const float w0 = cw[chan], w1 = cw[1536 + (chan)], w2 = cw[2 * 1536 + (chan)], bb = cb[chan]; \
        for (int i = tid; i < 2 * LX; i += NT) { const int b = i / LX, t = i % LX; const float* s = HTb + ((size_t)(b * 2048 + (chan))) * LX; \
            const float a = s[t > 0 ? t - 1 : 0], m = s[t], n = s[t < LX - 1 ? t + 1 : LX - 1]; dst[i] = w0 * (t > 0 ? a : 0.f) + w1 * m + w2 * (t < LX - 1 ? n : 0.f) + bb; } } while (0)
    for (int i = tid; i < 2 * LX; i += NT) tp[i] = (i < 2 * LX - 1) ? TP[(size_t)(0 * 512 + c) * (2 * LX) + i] : 0.f;
    SHORTC(vb, c);
    __syncthreads();
    float acc[2][NTT];
#pragma unroll
    for (int e = 0; e < NTT; ++e) { acc[0][e] = 0.f; acc[1][e] = 0.f; }
    for (int s = 0; s < LX; ++s) { const float v0 = vb[s], v1 = vb[LX + s];
#pragma unroll
        for (int e = 0; e < NTT; ++e) { const int t = tid + NT * e; if (t < LX) { const float w = tp[LX - 1 + t - s]; acc[0][e] += w * v0; acc[1][e] += w * v1; } } }
    __syncthreads();
    {
        const int ch = 512 + c; const float w0 = cw[ch], w1 = cw[1536 + ch], w2 = cw[2 * 1536 + ch], bb = cb[ch]; const float d0 = hd[c];
#pragma unroll
        for (int e = 0; e < NTT; ++e) { const int t = tid + NT * e; if (t < LX) {
#pragma unroll
            for (int b = 0; b < 2; ++b) { const float* s = HTb + ((size_t)(b * 2048 + ch)) * LX; const float a = s[t > 0 ? t - 1 : 0], m = s[t], n = s[t < LX - 1 ? t + 1 : LX - 1];
                const float x1 = w0 * (t > 0 ? a : 0.f) + w1 * m + w2 * (t < LX - 1 ? n : 0.f) + bb; zb[b * LX + t] = x1 * (acc[b][e] + d0 * vb[b * LX + t]); } } }
    }
    for (int i = tid; i < 2 * LX; i += NT) tp[i] = (i < 2 * LX - 1) ? TP[(size_t)(1 * 512 + c) * (2 * LX) + i] : 0.f;
    __syncthreads();
#pragma unroll
    for (int e = 0; e < NTT; ++e) { acc[0][e] = 0.f; acc[1][e] = 0.f; }
    for (int s = 0; s < LX; ++s) { const float v0 = zb[s], v1 = zb[LX + s];
#pragma unroll
        for (int e = 0; e < NTT; ++e) { const int t = tid + NT * e; if (t < LX) { const float w = tp[LX - 1 + t - s]; acc[0][e] += w * v0; acc[1][e] += w * v1; } } }
    {
        const int ch = 1024 + c; const float w0 = cw[ch], w1 = cw[1536 + ch], w2 = cw[2 * 1536 + ch], bb = cb[ch]; const float d1 = hd[512 + c];
#pragma unroll
        for (int e = 0; e < NTT; ++e) { const int t = tid + NT * e; if (t < LX) {
#pragma unroll
            for (int b = 0; b < 2; ++b) { const float* s = HTb + ((size_t)(b * 2048 + ch)) * LX; const float a = s[t > 0 ? t - 1 : 0], m = s[t], n = s[t < LX - 1 ? t + 1 : LX - 1];
                const float x2 = w0 * (t > 0 ? a : 0.f) + w1 * m + w2 * (t < LX - 1 ? n : 0.f) + bb; const float gt = HTb[((size_t)(b * 2048 + 1536 + c)) * LX + t];
                HOb[((size_t)(b * 512 + c)) * LX + t] = x2 * (acc[b][e] + d1 * zb[b * LX + t]) * silu_f(gt); } } }
    }
    __syncthreads();
#undef SHORTC
}
constexpr int N_POSTT = NB * 8 * (SEQ / 64) + NB * 8 * (LCX / 64);
__device__ __forceinline__ void phase_post(const Params& p, int l, int bid, int nb, float* tile) {
    const int tid = otid(), lane = tid & 63, wave = tid >> 6;
    const float* P = (const float*)(WSP(p) + WS_P); const float* OG = (const float*)(WSP(p) + WS_OG);
    bf16_t* YC = (bf16_t*)(WSP(p) + WS_YCAT);
    const float* gn = INP(p, I_GNORM) + l * 256;
    for (int r = bid * 8 + wave; r < MROWS; r += nb * 8) {
        const float* pr = P + (size_t)r * NINP;
#pragma unroll
        for (int hh = 0; hh < 4; ++hh) { const int col = hh * 256 + 4 * lane;
            const f32x4 o = *(const f32x4*)(OG + (size_t)r * 1024 + col) + *(const f32x4*)(OG + ((size_t)MROWS + r) * 1024 + col);
            const float rs = rsqrtf(wave_sum(o[0] * o[0] + o[1] * o[1] + o[2] * o[2] + o[3] * o[3]) * (1.f / 256.f) + EPS);
            const f32x4 w = *(const f32x4*)(gn + 4 * lane), g = *(const f32x4*)(pr + PGG + col);
            uint2 q; q.x = pk2(o[0] * rs * w[0] * silu_f(g[0]), o[1] * rs * w[1] * silu_f(g[1])); q.y = pk2(o[2] * rs * w[2] * silu_f(g[2]), o[3] * rs * w[3] * silu_f(g[3]));
            *(uint2*)(YC + (size_t)r * DM + col) = q; }
    }
    const float* HT = (const float*)(WSP(p) + WS_TP); const float* HTC = HT + HO_C;
    for (int it = bid; it < N_POSTT; it += nb) {
        const float* src; int LX, b, cb, tb, rbase;
        if (it < NB * 8 * (SEQ / 64)) { LX = SEQ; b = it / (8 * 64); const int q = it % (8 * 64); cb = q >> 6; tb = q & 63; src = HT; rbase = b * SEQ; }
        else { const int i2 = it - NB * 8 * (SEQ / 64); LX = LCX; b = i2 / (8 * 4); const int q = i2 % (8 * 4); cb = q >> 2; tb = q & 3; src = HTC; rbase = NLAT + b * LCX; }
#pragma unroll
        for (int j = 0; j < 8; ++j) { const int i = tid + NT * j, cc = i >> 6, tt = i & 63; tile[tt * 65 + cc] = src[((size_t)(b * 512 + cb * 64 + cc)) * LX + tb * 64 + tt]; }
        __syncthreads();
        { const int tt = tid >> 3, cq = tid & 7; const float* s = tile + tt * 65 + cq * 8;
          uint4 o; o.x = pk2(s[0], s[1]); o.y = pk2(s[2], s[3]); o.z = pk2(s[4], s[5]); o.w = pk2(s[6], s[7]);
          *(uint4*)(YC + (size_t)(rbase + tb * 64 + tt) * DM + 1536 + cb * 64 + cq * 8) = o; }
        __syncthreads();
    }
}
#define XB_TMO      128
#define XB_XCNT(j)  (256  + 64 * (j))
#define XB_XSUB(j)  (1280 + 64 * (j))
#define XB_XGEN(j)  (2304 + 64 * (j))
#define XB_TOP      3328
#define XB_TOPGEN   3392
#define XCD_BAR_WORDS 3456
#define XB_SPIN_CAP (1u << 22)

__device__ __forceinline__ unsigned xb_ld(unsigned* p)              { return __hip_atomic_load(p, __ATOMIC_RELAXED, __HIP_MEMORY_SCOPE_AGENT); }
__device__ __forceinline__ unsigned xb_add(unsigned* p, unsigned v) { return __hip_atomic_fetch_add(p, v, __ATOMIC_RELAXED, __HIP_MEMORY_SCOPE_AGENT); }
__device__ __forceinline__ unsigned xb_xcc_id() { return (unsigned)__builtin_amdgcn_s_getreg((3 << 11) | 20) & 0xFu; }
#define XB_SPIN(cond, bar) do { unsigned _sp = 0; while (cond) { __builtin_amdgcn_s_sleep(1); \
    if ((++_sp & 255u) == 0u) { if (xb_ld(&(bar)[XB_TMO])) break; if (_sp > XB_SPIN_CAP) { atomicAdd(&(bar)[XB_TMO], 1u); break; } } } } while (0)

struct XcdBarrier {
    unsigned* bar; unsigned x;
    volatile LAS unsigned* st;
};

__device__ __forceinline__ XcdBarrier xcd_barrier_post(unsigned* bar, volatile LAS unsigned* st) {
    XcdBarrier b; b.bar = bar; b.x = xb_xcc_id(); b.st = st;
    if (threadIdx.x == 0) (void)xb_add(&bar[XB_XCNT(b.x)], 1u);
    return b;
}
__device__ __forceinline__ void xcd_barrier_complete(unsigned* bar, unsigned x, unsigned& nloc, unsigned& nx) {
    const unsigned G = gridDim.x * gridDim.y * gridDim.z;
    unsigned sum, cnt, mine, sp = 0u;
    for (;;) {
        sum = 0u; cnt = 0u; mine = 0u;
#pragma unroll
        for (unsigned j = 0; j < 16; ++j) { const unsigned c = xb_ld(&bar[XB_XCNT(j)]); sum += c; cnt += (c > 0u) ? 1u : 0u; mine = (j == x) ? c : mine; }
        if (sum == G) break;
        __builtin_amdgcn_s_sleep(1);
        if ((++sp & 255u) == 0u) { if (xb_ld(&bar[XB_TMO])) break; if (sp > XB_SPIN_CAP) { atomicAdd(&bar[XB_TMO], 1u); break; } }
    }
    nloc = mine > 0u ? mine : 1u; nx = cnt > 0u ? cnt : 1u;
}

__device__ __forceinline__ void xcd_barrier(const XcdBarrier& b) {
    asm volatile("s_waitcnt vmcnt(0)" ::: "memory");
    __syncthreads();
    if (threadIdx.x == 0) {
        unsigned* bar = b.bar; asm volatile("" : "+s"(bar));
        __builtin_amdgcn_s_waitcnt(0);
        unsigned nloc = b.st[0], nx = b.st[1];
        if (nloc == 0u) { xcd_barrier_complete(bar, b.x, nloc, nx); b.st[0] = nloc; b.st[1] = nx; }
        const unsigned old = xb_add(&bar[XB_XSUB(b.x)], 1u);
        const unsigned gen = old / nloc;
        if (old + 1u == (gen + 1u) * nloc) {
            __builtin_amdgcn_fence(__ATOMIC_RELEASE, "agent");
            asm volatile("s_waitcnt vmcnt(0)" ::: "memory");
            const unsigned og = xb_add(&bar[XB_TOP], 1u);
            const unsigned tg = og / nx;
            if (og + 1u == (tg + 1u) * nx) xb_add(&bar[XB_TOPGEN], 1u);
            else XB_SPIN(xb_ld(&bar[XB_TOPGEN]) == tg, bar);
            __builtin_amdgcn_fence(__ATOMIC_ACQUIRE, "agent");
            xb_add(&bar[XB_XGEN(b.x)], 1u);
            asm volatile("s_waitcnt vmcnt(0)" ::: "memory");
        } else {
            XB_SPIN(xb_ld(&bar[XB_XGEN(b.x)]) == gen, bar);
            __builtin_amdgcn_fence(__ATOMIC_ACQUIRE, "agent");
            asm volatile("s_waitcnt vmcnt(0)" ::: "memory");
        }
    }
    __syncthreads();
}

typedef short bf16x8_t __attribute__((ext_vector_type(8)));
constexpr int NCH = 68;
constexpr size_t GLA_QT = 0;
constexpr size_t GLA_KT = GLA_QT + (size_t)2 * MROWS * 512 * 2;
constexpr size_t GLA_KDT = GLA_KT + (size_t)2 * MROWS * 512 * 2;
constexpr size_t GLA_VT = GLA_KDT + (size_t)2 * NB * 4 * NCH * 8192 * 2;
constexpr size_t GLA_AG = GLA_VT + (size_t)NB * 4 * NCH * 16384 * 2;
constexpr size_t GLA_BYTES = GLA_AG + (size_t)2 * NB * 4 * NCH * 128 * 4;
__device__ __forceinline__ int chunk_row0(int b, int ch) { return ch < 4 ? (NLAT + b * LCX + 64 * ch) : (b * SEQ + 64 * (ch - 4)); }

constexpr int N_GLAPREP = NB * 4 * NCH;
__device__ __forceinline__ void gla_prep_item(const Params& p, int l, int it, float* smem) {
    const int tid = otid(); const int b = it / (4 * NCH), h = (it / NCH) & 3, ch = it % NCH; const int row0 = chunk_row0(b, ch);
    const float* P = (const float*)(WSP(p) + WS_P); unsigned char* GB = WSP(p) + WS_GLA;
    float* lrs = smem;
    float* tot = lrs + 64 * 32;
    float* vtile = tot + 2 * 4 * 128;
    for (int i = tid; i < 64 * 32; i += NT) lrs[i] = P[(size_t)(row0 + (i >> 5)) * NINP + PLR + (i & 31)];
#pragma unroll 16
    for (int j = 0; j < 32; ++j) { const int i = tid + NT * j, r = i >> 8, v = i & 255; vtile[r * 257 + v] = P[(size_t)(row0 + r) * NINP + PV + h * 256 + v]; }
    __syncthreads();
    const int k = tid & 127, seg = tid >> 7;
    float G[2][16];
#pragma unroll
    for (int dir = 0; dir < 2; ++dir) {
        float wg[16];
#pragma unroll
        for (int r = 0; r < 16; ++r) wg[r] = INP(p, I_GWG)[((size_t)(l * 2 + dir) * 16 + r) * 512 + h * 128 + k];
        const float bias = INP(p, I_GBG)[(l * 2 + dir) * 512 + h * 128 + k];
#pragma unroll
        for (int e = 0; e < 16; ++e) { const float* lr = lrs + (16 * seg + e) * 32 + dir * 16; float z = bias;
#pragma unroll
            for (int r = 0; r < 16; ++r) z += lr[r] * wg[r];
            G[dir][e] = (fminf(z, 0.f) - log1pf(expf(-fabsf(z)))) * (1.f / 16.f); }
        if (dir == 0) {
#pragma unroll
            for (int e = 1; e < 16; ++e) G[0][e] += G[0][e - 1];
            tot[(0 * 4 + seg) * 128 + k] = G[0][15];
        } else {
#pragma unroll
            for (int e = 14; e >= 0; --e) G[1][e] += G[1][e + 1];
            tot[(1 * 4 + seg) * 128 + k] = G[1][0];
        }
    }
    __syncthreads();
#pragma unroll
    for (int dir = 0; dir < 2; ++dir) {
        float off = 0.f, glast = 0.f;
#pragma unroll
        for (int s = 0; s < 4; ++s) { const float t = tot[(dir * 4 + s) * 128 + k]; glast += t; if (dir == 0 ? (s < seg) : (s > seg)) off += t; }
        bf16_t* QT = (bf16_t*)(GB + GLA_QT) + ((size_t)dir * MROWS + row0) * 512 + h * 128 + k;
        bf16_t* KT = (bf16_t*)(GB + GLA_KT) + ((size_t)dir * MROWS + row0) * 512 + h * 128 + k;
        unsigned kd[8];
#pragma unroll
        for (int e = 0; e < 16; e += 2) { float kdv[2];
#pragma unroll
            for (int u = 0; u < 2; ++u) { const int i = 16 * seg + e + u; const float g = G[dir][e + u] + off;
                const float q = P[(size_t)(row0 + i) * NINP + PQ + h * 128 + k] * 0.08838834764831845f, kk = P[(size_t)(row0 + i) * NINP + PK + h * 128 + k];
                QT[(size_t)i * 512] = (bf16_t)(pk2(q * expf(g), 0.f) & 0xffff); KT[(size_t)i * 512] = (bf16_t)(pk2(kk * expf(-g), 0.f) & 0xffff);
                kdv[u] = kk * expf(glast - g); }
            kd[e >> 1] = pk2(kdv[0], kdv[1]); }
        bf16_t* KD = (bf16_t*)(GB + GLA_KDT) + ((((size_t)dir * NB + b) * 4 + h) * NCH + ch) * 8192 + k * 64 + 16 * seg;
        *(uint4*)KD = make_uint4(kd[0], kd[1], kd[2], kd[3]); *(uint4*)(KD + 8) = make_uint4(kd[4], kd[5], kd[6], kd[7]);
        if (seg == 0) ((float*)(GB + GLA_AG))[((((size_t)dir * NB + b) * 4 + h) * NCH + ch) * 128 + k] = expf(glast);
    }
    {
        const int v = tid >> 1, hf = tid & 1; bf16_t* VT = (bf16_t*)(GB + GLA_VT) + (((size_t)b * 4 + h) * NCH + ch) * 16384 + v * 64 + 32 * hf;
#pragma unroll
        for (int c = 0; c < 4; ++c) { const float* s = vtile + (32 * hf + 8 * c) * 257 + v;
            *(uint4*)(VT + 8 * c) = make_uint4(pk2(s[0], s[257]), pk2(s[2 * 257], s[3 * 257]), pk2(s[4 * 257], s[5 * 257]), pk2(s[6 * 257], s[7 * 257])); }
    }
    __syncthreads();
}

constexpr int GQP = 136, GVP = 72;
__device__ __forceinline__ bf16x8_t ldfrag(const bf16_t* base, int pitch, int row0, int k0, int lane) {
    return *(const bf16x8_t*)(base + (row0 + (lane & 15)) * pitch + k0 + (lane >> 4) * 8);
}
__device__ __forceinline__ void gla_seq_item(const Params& p, int it, bf16_t* lds) {
    const int tid = otid(), lane = tid & 63, w = tid >> 6;
    const int b = it >> 5, dir = (it >> 4) & 1, h = (it >> 2) & 3, vs = it & 3;
    unsigned char* GB = WSP(p) + WS_GLA; float* OG = (float*)(WSP(p) + WS_OG);
    bf16_t* Qs = lds; bf16_t* Ks = Qs + 64 * GQP; bf16_t* STs = Ks + 64 * GQP; bf16_t* KdTs = STs + 64 * GQP; bf16_t* VTs = KdTs + 128 * GVP; bf16_t* Ps = VTs + 64 * GVP;
    const bf16_t* QTg = (const bf16_t*)(GB + GLA_QT) + (size_t)dir * MROWS * 512 + h * 128;
    const bf16_t* KTg = (const bf16_t*)(GB + GLA_KT) + (size_t)dir * MROWS * 512 + h * 128;
    const bf16_t* KDg = (const bf16_t*)(GB + GLA_KDT) + (((size_t)dir * NB + b) * 4 + h) * NCH * 8192;
    const bf16_t* VTg = (const bf16_t*)(GB + GLA_VT) + ((size_t)b * 4 + h) * NCH * 16384 + vs * 64 * 64;
    const float* AGg = (const float*)(GB + GLA_AG) + (((size_t)dir * NB + b) * 4 + h) * NCH * 128;
    f32x4 S_[4];
#pragma unroll
    for (int i = 0; i < 4; ++i) S_[i] = (f32x4){0.f, 0.f, 0.f, 0.f};
    uint4 rqA0, rqA1, rkA0, rkA1, rdA0, rdA1, rvA; f32x4 anA;
    uint4 rqB0, rqB1, rkB0, rkB1, rdB0, rdB1, rvB; f32x4 anB;
#define GLA_LOAD(S, cs_) do { const int ch_ = dir ? ((cs_) < 4 ? 3 - (cs_) : 71 - (cs_)) : (cs_); const int r0_ = chunk_row0(b, ch_); const int e0_ = tid, e1_ = tid + NT; \
        rq##S##0 = *(const uint4*)(QTg + (size_t)(r0_ + (e0_ >> 4)) * 512 + (e0_ & 15) * 8); rq##S##1 = *(const uint4*)(QTg + (size_t)(r0_ + (e1_ >> 4)) * 512 + (e1_ & 15) * 8); \
        rk##S##0 = *(const uint4*)(KTg + (size_t)(r0_ + (e0_ >> 4)) * 512 + (e0_ & 15) * 8); rk##S##1 = *(const uint4*)(KTg + (size_t)(r0_ + (e1_ >> 4)) * 512 + (e1_ & 15) * 8); \
        rd##S##0 = *(const uint4*)(KDg + (size_t)ch_ * 8192 + e0_ * 8); rd##S##1 = *(const uint4*)(KDg + (size_t)ch_ * 8192 + e1_ * 8); \
        rv##S = *(const uint4*)(VTg + (size_t)ch_ * 16384 + tid * 8); an##S = *(const f32x4*)(AGg + ch_ * 128 + 16 * w + (lane >> 4) * 4); } while (0)
#define GLA_BODY(S, cs) do { \
        const int ch = dir ? ((cs) < 4 ? 3 - (cs) : 71 - (cs)) : (cs); const int r0 = chunk_row0(b, ch); \
        { const int e0 = tid, e1 = tid + NT; \
            *(uint4*)(Qs + (e0 >> 4) * GQP + (e0 & 15) * 8) = rq##S##0; *(uint4*)(Qs + (e1 >> 4) * GQP + (e1 & 15) * 8) = rq##S##1; \
            *(uint4*)(Ks + (e0 >> 4) * GQP + (e0 & 15) * 8) = rk##S##0; *(uint4*)(Ks + (e1 >> 4) * GQP + (e1 & 15) * 8) = rk##S##1; \
            *(uint4*)(KdTs + (e0 >> 3) * GVP + (e0 & 7) * 8) = rd##S##0; *(uint4*)(KdTs + (e1 >> 3) * GVP + (e1 & 7) * 8) = rd##S##1; } \
        *(uint4*)(VTs + (tid >> 3) * GVP + (tid & 7) * 8) = rv##S; \
        const f32x4 ac = an##S; \
        _Pragma("unroll") for (int vt = 0; vt < 4; ++vt) *(uint2*)(STs + (16 * vt + (lane & 15)) * GQP + 16 * w + (lane >> 4) * 4) = make_uint2(pk2(S_[vt][0], S_[vt][1]), pk2(S_[vt][2], S_[vt][3])); \
        __syncthreads(); \
        if ((cs) + 2 < NCH) GLA_LOAD(S, (cs) + 2); \
        const int st = w & 3, tt0 = 2 * (w >> 2); \
        { f32x4 c0 = {0.f, 0.f, 0.f, 0.f}, c1 = c0; \
          _Pragma("unroll") for (int ks = 0; ks < 4; ++ks) { const bf16x8_t a = ldfrag(Ks, GQP, 16 * st, 32 * ks, lane); \
              c0 = __builtin_amdgcn_mfma_f32_16x16x32_bf16(a, ldfrag(Qs, GQP, 16 * tt0, 32 * ks, lane), c0, 0, 0, 0); \
              c1 = __builtin_amdgcn_mfma_f32_16x16x32_bf16(a, ldfrag(Qs, GQP, 16 * tt0 + 16, 32 * ks, lane), c1, 0, 0, 0); } \
          const int s0 = 16 * st + (lane >> 4) * 4; \
          _Pragma("unroll") for (int u = 0; u < 2; ++u) { const f32x4 c = u ? c1 : c0; const int t = 16 * (tt0 + u) + (lane & 15); float m[4]; \
              _Pragma("unroll") for (int r = 0; r < 4; ++r) { const bool keep = dir ? (s0 + r > t) : (s0 + r <= t); m[r] = keep ? c[r] : 0.f; } \
              *(uint2*)(Ps + t * GVP + s0) = make_uint2(pk2(m[0], m[1]), pk2(m[2], m[3])); } } \
        f32x4 o0 = {0.f, 0.f, 0.f, 0.f}, o1 = o0; \
        _Pragma("unroll") for (int ks = 0; ks < 4; ++ks) { const bf16x8_t a = ldfrag(STs, GQP, 16 * st, 32 * ks, lane); \
            o0 = __builtin_amdgcn_mfma_f32_16x16x32_bf16(a, ldfrag(Qs, GQP, 16 * tt0, 32 * ks, lane), o0, 0, 0, 0); \
            o1 = __builtin_amdgcn_mfma_f32_16x16x32_bf16(a, ldfrag(Qs, GQP, 16 * tt0 + 16, 32 * ks, lane), o1, 0, 0, 0); } \
        _Pragma("unroll") for (int vt = 0; vt < 4; ++vt) { S_[vt][0] *= ac[0]; S_[vt][1] *= ac[1]; S_[vt][2] *= ac[2]; S_[vt][3] *= ac[3]; } \
        _Pragma("unroll") for (int ks = 0; ks < 2; ++ks) { const bf16x8_t a = ldfrag(KdTs, GVP, 16 * w, 32 * ks, lane); \
            _Pragma("unroll") for (int vt = 0; vt < 4; ++vt) S_[vt] = __builtin_amdgcn_mfma_f32_16x16x32_bf16(a, ldfrag(VTs, GVP, 16 * vt, 32 * ks, lane), S_[vt], 0, 0, 0); } \
        __syncthreads(); \
        _Pragma("unroll") for (int ks = 0; ks < 2; ++ks) { const bf16x8_t a = ldfrag(VTs, GVP, 16 * st, 32 * ks, lane); \
            o0 = __builtin_amdgcn_mfma_f32_16x16x32_bf16(a, ldfrag(Ps, GVP, 16 * tt0, 32 * ks, lane), o0, 0, 0, 0); \
            o1 = __builtin_amdgcn_mfma_f32_16x16x32_bf16(a, ldfrag(Ps, GVP, 16 * tt0 + 16, 32 * ks, lane), o1, 0, 0, 0); } \
        { float* og = OG + ((size_t)dir * MROWS + r0 + 16 * tt0 + (lane & 15)) * 1024 + h * 256 + vs * 64 + 16 * st + (lane >> 4) * 4; \
          *(f32x4*)og = o0; *(f32x4*)(og + 16 * 1024) = o1; } \
        __syncthreads(); } while (0)
    GLA_LOAD(A, 0); GLA_LOAD(B, 1);
#pragma unroll 1
    for (int cs = 0; cs < NCH; cs += 2) { GLA_BODY(A, cs); GLA_BODY(B, cs + 1); }
#undef GLA_BODY
#undef GLA_LOAD
}
#ifndef FFT_HD
#define FFT_HD __device__ __forceinline__
#endif
#define PADI(i) ((i) + ((i) >> 5))
constexpr int FFT_N = 8192, FFT_BUF = FFT_N + FFT_N / 32, FFT_TW = 2048 + 512 + 128 + 32 + 8;
struct __attribute__((aligned(8))) cf { float x, y; };
FFT_HD cf cmul(cf a, cf b) { return cf{a.x * b.x - a.y * b.y, a.x * b.y + a.y * b.x}; }
FFT_HD cf cmulc(cf a, cf b) { return cf{a.x * b.x + a.y * b.y, a.y * b.x - a.x * b.y}; }
FFT_HD cf cadd(cf a, cf b) { return cf{a.x + b.x, a.y + b.y}; }
FFT_HD cf csub(cf a, cf b) { return cf{a.x - b.x, a.y - b.y}; }
FFT_HD int fft_twoff(int s) { return s == 0 ? 0 : s == 1 ? 2048 : s == 2 ? 2560 : s == 3 ? 2688 : 2720; }
template <bool INV> FFT_HD void fft_stage4(cf* buf, const cf* tw, int s, int tid) {
    const int lq = 11 - 2 * s, q4 = 1 << lq; const cf* t = tw + fft_twoff(s);
#pragma unroll
    for (int e = 0; e < 4; ++e) {
        const int bf = tid + 512 * e, blk = bf >> lq, j = bf & (q4 - 1), base = (blk << (lq + 2)) + j;
        const int i0 = PADI(base), i1 = PADI(base + q4), i2 = PADI(base + 2 * q4), i3 = PADI(base + 3 * q4);
        const cf w1 = t[j], w2 = cmul(w1, w1), w3 = cmul(w2, w1);
        cf x0 = buf[i0], x1 = buf[i1], x2 = buf[i2], x3 = buf[i3];
        if (INV) { x1 = cmulc(x1, w1); x2 = cmulc(x2, w2); x3 = cmulc(x3, w3); }
        const cf a = cadd(x0, x2), b = csub(x0, x2), c = cadd(x1, x3), d = csub(x1, x3);
        cf y0 = cadd(a, c), y2 = csub(a, c), y1, y3;
        if (!INV) { y1 = cf{b.x + d.y, b.y - d.x}; y3 = cf{b.x - d.y, b.y + d.x}; y1 = cmul(y1, w1); y2 = cmul(y2, w2); y3 = cmul(y3, w3); }
        else      { y1 = cf{b.x - d.y, b.y + d.x}; y3 = cf{b.x + d.y, b.y - d.x}; }
        buf[i0] = y0; buf[i1] = y1; buf[i2] = y2; buf[i3] = y3;
    }
}
template <bool INV> FFT_HD void fft_last8(cf* buf, int tid) {
    const float h = 0.70710678118654752f;
    const cf w[2][4] = {{{1.f, 0.f}, {1.f, 0.f}, {1.f, 0.f}, {1.f, 0.f}}, {{1.f, 0.f}, {h, -h}, {0.f, -1.f}, {-h, -h}}};
#pragma unroll
    for (int e = 0; e < 2; ++e) {
        const int base = PADI((tid + 512 * e) * 8); cf x[8];
#pragma unroll
        for (int i = 0; i < 8; ++i) x[i] = buf[base + i];
        if (!INV) {
#pragma unroll
            for (int j = 0; j < 2; ++j) { const cf a = cadd(x[j], x[j + 4]), b = csub(x[j], x[j + 4]), c = cadd(x[j + 2], x[j + 6]), d = csub(x[j + 2], x[j + 6]);
                x[j] = cadd(a, c); x[j + 2] = cmul(cf{b.x + d.y, b.y - d.x}, w[j][1]); x[j + 4] = cmul(csub(a, c), w[j][2]); x[j + 6] = cmul(cf{b.x - d.y, b.y + d.x}, w[j][3]); }
#pragma unroll
            for (int m = 0; m < 4; ++m) { const cf a = x[2 * m], b = x[2 * m + 1]; x[2 * m] = cadd(a, b); x[2 * m + 1] = csub(a, b); }
        } else {
#pragma unroll
            for (int m = 0; m < 4; ++m) { const cf a = x[2 * m], b = x[2 * m + 1]; x[2 * m] = cadd(a, b); x[2 * m + 1] = csub(a, b); }
#pragma unroll
            for (int j = 0; j < 2; ++j) { const cf u0 = x[j], u1 = cmulc(x[j + 2], w[j][1]), u2 = cmulc(x[j + 4], w[j][2]), u3 = cmulc(x[j + 6], w[j][3]);
                const cf a = cadd(u0, u2), b = csub(u0, u2), c = cadd(u1, u3), d = csub(u1, u3);
                x[j] = cadd(a, c); x[j + 4] = csub(a, c); x[j + 2] = cf{b.x - d.y, b.y + d.x}; x[j + 6] = cf{b.x + d.y, b.y - d.x}; }
        }
#pragma unroll
        for (int i = 0; i < 8; ++i) buf[base + i] = x[i];
    }
}

constexpr int HY_TW_OFF = 27136;
__device__ __forceinline__ void hy_twiddles(float* smem) {
    cf* tw = (cf*)(smem + HY_TW_OFF); const int tid = otid();
    for (int i = tid; i < FFT_TW; i += NT) { int s = 0, j = i; if (i >= 2720) { s = 4; j = i - 2720; } else if (i >= 2688) { s = 3; j = i - 2688; } else if (i >= 2560) { s = 2; j = i - 2560; } else if (i >= 2048) { s = 1; j = i - 2048; }
        const int Ls = 8192 >> (2 * s); float sn, cs; sincospif(-2.0f * (float)j / (float)Ls, &sn, &cs); tw[i] = cf{cs, sn}; }
    __syncthreads();
}
template <bool INV> __device__ __forceinline__ void hy_fft(cf* buf, const cf* tw, int tid) {
    if (!INV) {
#pragma unroll 1
        for (int s = 0; s < 5; ++s) { fft_stage4<false>(buf, tw, s, tid); __syncthreads(); }
        fft_last8<false>(buf, tid); __syncthreads();
    } else {
        fft_last8<true>(buf, tid); __syncthreads();
#pragma unroll 1
        for (int s = 4; s >= 0; --s) { fft_stage4<true>(buf, tw, s, tid); __syncthreads(); }
    }
}
__device__ __forceinline__ int fft_pos2freq(int p) {
    return ((p >> 11) & 3) | (((p >> 9) & 3) << 2) | (((p >> 7) & 3) << 4) | (((p >> 5) & 3) << 6) | (((p >> 3) & 3) << 8) | (((p >> 1) & 3) << 10) | ((p & 1) << 12);
}
__device__ __forceinline__ int fft_freq2pos(int k) {
    return ((k & 3) << 11) | (((k >> 2) & 3) << 9) | (((k >> 4) & 3) << 7) | (((k >> 6) & 3) << 5) | (((k >> 8) & 3) << 3) | (((k >> 10) & 3) << 1) | ((k >> 12) & 1);
}
__device__ __forceinline__ void hy_spec2_item(const Params& p, int l, int c, float* smem) {
    const int tid = otid(); cf* buf = (cf*)smem; float* w3c = smem + 2 * FFT_BUF; const cf* tw = (const cf*)(smem + HY_TW_OFF);
    const float* w3 = INP(p, I_HW3) + (size_t)l * 64 * 2048; const float* H2 = (const float*)(WSP(p) + WS_H2) + (size_t)l * 64 * SEQ; cf* HS = (cf*)(WSP(p) + WS_HS);
    if (tid < 256) { const int q = tid & 3, i = tid >> 2; w3c[i * 4 + q] = w3[(size_t)i * 2048 + (q >> 1) * 1024 + (q & 1) * 512 + c]; }
    const float delta = fabsf(-15.350567286626973f + (float)c * ((-3.0701134573253945f + 15.350567286626973f) / 511.0f));
    __syncthreads();
#pragma unroll 1
    for (int e = 0; e < 2; ++e) { const int tau0 = 4 * tid + 2048 * e; const float* hc = H2 + tau0;
        float t[4][4];
#pragma unroll
        for (int u = 0; u < 4; ++u) { t[u][0] = 0.f; t[u][1] = 0.f; t[u][2] = 0.f; t[u][3] = 0.f; }
#pragma unroll 16
        for (int i = 0; i < 64; ++i) { const f32x4 hv = *(const f32x4*)(hc + (size_t)i * SEQ); const f32x4 wv = *(const f32x4*)(w3c + 4 * i);
#pragma unroll
            for (int u = 0; u < 4; ++u) { t[u][0] += hv[u] * wv[0]; t[u][1] += hv[u] * wv[1]; t[u][2] += hv[u] * wv[2]; t[u][3] += hv[u] * wv[3]; } }
#pragma unroll
        for (int u = 0; u < 4; ++u) { const int tau = tau0 + u; const float dec = expf(-((float)tau / (float)(SEQ - 1)) * delta);
            buf[PADI(tau)] = cf{t[u][0] * dec, t[u][2] * dec};
            buf[PADI((8192 - tau) & 8191 ? 8192 - tau : 4096)] = (tau == 0) ? cf{0.f, 0.f} : cf{t[u][1] * dec, t[u][3] * dec}; } }
    __syncthreads();
    hy_fft<false>(buf, tw, tid);
#pragma unroll 4
    for (int e = 0; e < 16; ++e) { const int pp = tid + NT * e; const int p2 = fft_freq2pos((8192 - fft_pos2freq(pp)) & 8191);
        const cf F = buf[PADI(pp)], G = buf[PADI(p2)]; const float s = 0.5f / 8192.f;
        HS[(size_t)c * 8192 + pp] = cf{(F.x + G.x) * s, (F.y - G.y) * s};
        HS[(size_t)(512 + c) * 8192 + pp] = cf{(F.y + G.y) * s, -(F.x - G.x) * s}; }
    __syncthreads();
}
__device__ __forceinline__ float hy_short(const float* s, int t, float w0, float w1, float w2, float bb) {
    const float a = s[t > 0 ? t - 1 : 0], m = s[t], n = s[t < SEQ - 1 ? t + 1 : SEQ - 1];
    return w0 * (t > 0 ? a : 0.f) + w1 * m + w2 * (t < SEQ - 1 ? n : 0.f) + bb;
}
__device__ __forceinline__ void hy_fft_item(const Params& p, int l, int c, float* smem) {
    const int tid = otid(); cf* buf = (cf*)smem; const cf* tw = (const cf*)(smem + HY_TW_OFF);
    const float* HT = (const float*)(WSP(p) + WS_HT); float* HO = (float*)(WSP(p) + WS_TP); const cf* HS = (const cf*)(WSP(p) + WS_HS);
    const float* cw = INP(p, I_HCW) + (size_t)l * 3 * 1536; const float* cb = INP(p, I_HCB) + (size_t)l * 1536; const float* hd = INP(p, I_HD) + (size_t)l * 2 * 512;
    float v0[8], v1[8];
    { const float w0 = cw[c], w1 = cw[1536 + c], w2 = cw[2 * 1536 + c], bb = cb[c]; const float* s0 = HT + (size_t)c * SEQ; const float* s1 = HT + (size_t)(2048 + c) * SEQ;
#pragma unroll
      for (int e = 0; e < 8; ++e) { const int t = tid + NT * e; v0[e] = hy_short(s0, t, w0, w1, w2, bb); v1[e] = hy_short(s1, t, w0, w1, w2, bb);
          buf[PADI(t)] = cf{v0[e], v1[e]}; buf[PADI(4096 + t)] = cf{0.f, 0.f}; } }
    cf hreg[16];
    { const cf* H = HS + (size_t)c * 8192;
#pragma unroll
      for (int e = 0; e < 16; ++e) hreg[e] = H[tid + NT * e]; }
    __syncthreads();
    hy_fft<false>(buf, tw, tid);
#pragma unroll
    for (int e = 0; e < 16; ++e) { const int i = tid + NT * e; buf[PADI(i)] = cmul(buf[PADI(i)], hreg[e]); }
    float z0[8], z1[8];
    { const int ch = 512 + c; const float w0 = cw[ch], w1 = cw[1536 + ch], w2 = cw[2 * 1536 + ch], bb = cb[ch];
      const float* s0 = HT + (size_t)ch * SEQ; const float* s1 = HT + (size_t)(2048 + ch) * SEQ;
#pragma unroll
      for (int e = 0; e < 8; ++e) { const int t = tid + NT * e; z0[e] = hy_short(s0, t, w0, w1, w2, bb); z1[e] = hy_short(s1, t, w0, w1, w2, bb); } }
    __syncthreads();
    hy_fft<true>(buf, tw, tid);
    { const float d0 = hd[c];
#pragma unroll
      for (int e = 0; e < 8; ++e) { const int t = tid + NT * e; const cf y = buf[PADI(t)]; z0[e] *= (y.x + d0 * v0[e]); z1[e] *= (y.y + d0 * v1[e]); } }
    __syncthreads();
#pragma unroll
    for (int e = 0; e < 8; ++e) { const int t = tid + NT * e; buf[PADI(t)] = cf{z0[e], z1[e]}; buf[PADI(4096 + t)] = cf{0.f, 0.f}; }
    { const cf* H = HS + (size_t)(512 + c) * 8192;
#pragma unroll
      for (int e = 0; e < 16; ++e) hreg[e] = H[tid + NT * e]; }
    __syncthreads();
    hy_fft<false>(buf, tw, tid);
#pragma unroll
    for (int e = 0; e < 16; ++e) { const int i = tid + NT * e; buf[PADI(i)] = cmul(buf[PADI(i)], hreg[e]); }
    { const int ch = 1024 + c; const float w0 = cw[ch], w1 = cw[1536 + ch], w2 = cw[2 * 1536 + ch], bb = cb[ch];
      const float* s0 = HT + (size_t)ch * SEQ; const float* s1 = HT + (size_t)(2048 + ch) * SEQ;
      const float* g0 = HT + (size_t)(1536 + c) * SEQ; const float* g1 = HT + (size_t)(2048 + 1536 + c) * SEQ;
#pragma unroll
      for (int e = 0; e < 8; ++e) { const int t = tid + NT * e; v0[e] = hy_short(s0, t, w0, w1, w2, bb) * silu_f(g0[t]); v1[e] = hy_short(s1, t, w0, w1, w2, bb) * silu_f(g1[t]); } }
    __syncthreads();
    hy_fft<true>(buf, tw, tid);
    { const float d1 = hd[512 + c];
#pragma unroll
      for (int e = 0; e < 8; ++e) { const int t = tid + NT * e; const cf y = buf[PADI(t)];
          HO[(size_t)c * SEQ + t] = v0[e] * (y.x + d1 * z0[e]); HO[(size_t)(512 + c) * SEQ + t] = v1[e] * (y.y + d1 * z1[e]); } }
    __syncthreads();
}


constexpr size_t S5W_WA = 0;
constexpr size_t S5W_KW = S5W_WA + (size_t)32 * 2 * 128 * 256 * 2;
constexpr size_t S5W_L16 = S5W_KW + (size_t)32 * 256 * 512 * 2;
constexpr size_t S5W_XI = S5W_L16 + (size_t)32 * 2 * 64 * 2 * 4;
constexpr size_t S5W_BYTES = S5W_XI + (size_t)32 * NB * 272 * 256 * 2;
__device__ __forceinline__ int s5_row(int b, int n, int s) { return n < 16 ? (NLAT + b * LCX + 16 * n + s) : (b * SEQ + 16 * (n - 16) + s); }

__device__ __forceinline__ void s5_weights_item(const Params& p, int l, int g, float* smem) {
    const int tid = otid();
    cf* pw = (cf*)smem;
    cf* Bb = pw + 2 * 17 * 64;
    cf* Cc = Bb + 2 * 64 * 16;
    float* KT = (float*)(Cc + 2 * 16 * 64);
    float* dsk = KT + 2 * 16 * 256;
    if (tid < 16) dsk[tid] = INP(p, I_S5D)[l * 512 + g * 16 + tid];
    unsigned char* WB = WSP(p) + WS_S5W;
    for (int i = tid; i < 2 * 17 * 64; i += NT) { const int d = i / (17 * 64), e = (i / 64) % 17, q = i & 63; const size_t pg = ((size_t)(l * 2 + d) * 32 + g);
        const float lr = INP(p, I_LRE)[pg * 64 + q], li = INP(p, I_LIM)[pg * 64 + q], step = expf(INP(p, I_LSTEP)[pg]);
        const float em = expf((float)e * lr * step); float sn, cs; sincosf((float)e * li * step, &sn, &cs); pw[i] = cf{em * cs, em * sn}; }
    for (int i = tid; i < 2 * 64 * 16; i += NT) { const int d = i >> 10, q = (i >> 4) & 63, hh = i & 15; const size_t pg = ((size_t)(l * 2 + d) * 32 + g);
        const float lr = INP(p, I_LRE)[pg * 64 + q], li = INP(p, I_LIM)[pg * 64 + q], step = expf(INP(p, I_LSTEP)[pg]);
        const float em1 = expm1f(lr * step); float sn, cs; sincosf(li * step, &sn, &cs); const float shf = sinf(0.5f * li * step);
        const float nr = em1 * cs - 2.f * shf * shf, ni = (em1 + 1.f) * sn, den = lr * lr + li * li;
        const float cr = (nr * lr + ni * li) / den, ci = (ni * lr - nr * li) / den;
        const float br = INP(p, I_BRE)[(pg * 64 + q) * 16 + hh], bi = INP(p, I_BIM)[(pg * 64 + q) * 16 + hh];
        Bb[i] = cf{cr * br - ci * bi, cr * bi + ci * br}; }
    for (int i = tid; i < 2 * 16 * 64; i += NT) { const int d = i >> 10; const size_t pg = ((size_t)(l * 2 + d) * 32 + g); Cc[i] = cf{INP(p, I_CRE)[pg * 1024 + (i & 1023)], INP(p, I_CIM)[pg * 1024 + (i & 1023)]}; }
    __syncthreads();
    if (tid < 128) { const int d = tid >> 6, q = tid & 63; const cf v = pw[(d * 17 + 16) * 64 + q]; float* L16 = (float*)(WB + S5W_L16) + ((size_t)g * 2 + d) * 128 + 2 * q; L16[0] = v.x; L16[1] = v.y; }
#pragma unroll 1
    for (int i = tid; i < 2 * 16 * 256; i += NT) { const int d = i >> 12, tau = (i >> 8) & 15, hp = (i >> 4) & 15, hh = i & 15; float s = 0.f;
#pragma unroll 4
        for (int q = 0; q < 64; ++q) { const cf m = cmul(cmul(Cc[(d * 16 + hp) * 64 + q], pw[(d * 17 + tau) * 64 + q]), Bb[(d * 64 + q) * 16 + hh]); s += m.x; }
        KT[i] = s; }
    __syncthreads();
    bf16_t* WA = (bf16_t*)(WB + S5W_WA) + (size_t)g * 2 * 128 * 256; bf16_t* KW = (bf16_t*)(WB + S5W_KW) + (size_t)g * 256 * 512;
#pragma unroll 1
    for (int i = tid; i < 2 * 128 * 256 / 2; i += NT) { const int i2 = 2 * i; const int d = i2 >> 15, rq = (i2 >> 8) & 127, col = i2 & 255; const int ri = rq >> 6, q = rq & 63, s = col >> 4, hh = col & 15;
        const int e = d ? s : 15 - s; const cf w = pw[(d * 17 + e) * 64 + q]; const cf m0 = cmul(w, Bb[(d * 64 + q) * 16 + hh]), m1 = cmul(w, Bb[(d * 64 + q) * 16 + hh + 1]);
        *(unsigned*)(WA + i2) = pk2(ri ? m0.y : m0.x, ri ? m1.y : m1.x); }
#pragma unroll 1
    for (int i = tid; i < 256 * 512 / 2; i += NT) { const int i2 = 2 * i; const int row = i2 >> 9, col = i2 & 511; const int t = row >> 4, hp = row & 15; float v[2];
#pragma unroll
        for (int u = 0; u < 2; ++u) { const int c = col + u;
            if (c < 256) { const int s = c >> 4, hh = c & 15; float a = 0.f; if (s <= t) a += KT[(0 * 16 + (t - s)) * 256 + hp * 16 + hh]; if (s >= t) a += KT[(1 * 16 + (s - t)) * 256 + hp * 16 + hh];
                if (s == t && hh == hp) a += dsk[hp]; v[u] = a; }
            else { const int c2 = c - 256, d = c2 >> 7, ri = (c2 >> 6) & 1, q = c2 & 63; const int e = d ? 16 - t : t + 1; const cf m = cmul(Cc[(d * 16 + hp) * 64 + q], pw[(d * 17 + e) * 64 + q]); v[u] = ri ? -m.y : m.x; } }
        *(unsigned*)(KW + i2) = pk2(v[0], v[1]); }
    __syncthreads();
}

constexpr int S5P = 520;
__device__ __forceinline__ void s5_fetch_u(const float* P, int b, int g, int mt, int tid, f32x4& a, f32x4& c) {
    const int row = tid >> 5, part = tid & 31, s = part >> 1, h8 = (part & 1) * 8; const float* src = P + (size_t)s5_row(b, 16 * mt + row, s) * NINP + PU + 16 * g + h8;
    a = *(const f32x4*)src; c = *(const f32x4*)(src + 4);
}
__device__ __forceinline__ void s5_store_u(bf16_t* At, int tid, const f32x4 a, const f32x4 c) {
    const int row = tid >> 5, part = tid & 31, s = part >> 1, h8 = (part & 1) * 8;
    *(uint4*)(At + row * S5P + 16 * s + h8) = make_uint4(pk2(a[0], a[1]), pk2(a[2], a[3]), pk2(c[0], c[1]), pk2(c[2], c[3]));
}
__device__ __forceinline__ void s5_item(const Params& p, int it, float* smem) {
    const int tid = otid(), lane = tid & 63, w = tid >> 6; const int g = it >> 1, b = it & 1;
    const float* P = (const float*)(WSP(p) + WS_P); unsigned char* WB = WSP(p) + WS_S5W; bf16_t* YG = (bf16_t*)(WSP(p) + WS_YG);
    bf16_t* At = (bf16_t*)smem;
    float* Et = smem + (16 * S5P) / 2;
    bf16_t* XI = (bf16_t*)(WB + S5W_XI) + ((size_t)g * NB + b) * 272 * 256;
#pragma unroll 1
    for (int d = 0; d < 2; ++d) {
        const bf16_t* WA = (const bf16_t*)(WB + S5W_WA) + ((size_t)g * 2 + d) * 128 * 256;
        bf16x8_t bfr[8];
#pragma unroll
        for (int ks = 0; ks < 8; ++ks) bfr[ks] = *(const bf16x8_t*)(WA + (size_t)(16 * w + (lane & 15)) * 256 + 32 * ks + (lane >> 4) * 8);
        float xr = 0.f, xi = 0.f, l16r = 0.f, l16i = 0.f;
        if (tid < 64) { const float* L16 = (const float*)(WB + S5W_L16) + ((size_t)g * 2 + d) * 128 + 2 * tid; l16r = L16[0]; l16i = L16[1]; }
        f32x4 ua, uc; s5_fetch_u(P, b, g, 0, tid, ua, uc);
#pragma unroll 1
        for (int k = 0; k < 17; ++k) {
            const int mt = d ? (k == 0 ? 0 : 17 - k) : k;
            s5_store_u(At, tid, ua, uc);
            __syncthreads();
            if (k + 1 < 17) s5_fetch_u(P, b, g, d ? 16 - k : k + 1, tid, ua, uc);
            f32x4 acc = {0.f, 0.f, 0.f, 0.f};
#pragma unroll
            for (int ks = 0; ks < 8; ++ks) acc = __builtin_amdgcn_mfma_f32_16x16x32_bf16(ldfrag(At, S5P, 0, 32 * ks, lane), bfr[ks], acc, 0, 0, 0);
#pragma unroll
            for (int r = 0; r < 4; ++r) Et[((lane >> 4) * 4 + r) * 132 + 16 * w + (lane & 15)] = acc[r];
            __syncthreads();
            if (tid < 64) { float er[16], ei[16];
#pragma unroll
                for (int i = 0; i < 16; ++i) { const int m = d ? 15 - i : i; er[i] = Et[m * 132 + tid]; ei[i] = Et[m * 132 + 64 + tid]; }
#pragma unroll
                for (int i = 0; i < 16; ++i) { const int m = d ? 15 - i : i; bf16_t* xo = XI + (size_t)(16 * mt + m) * 256 + d * 128 + tid;
                    xo[0] = (bf16_t)(pk2(xr, 0.f) & 0xffff); xo[64] = (bf16_t)(pk2(xi, 0.f) & 0xffff);
                    const float nr = l16r * xr - l16i * xi + er[i], ni = l16r * xi + l16i * xr + ei[i]; xr = nr; xi = ni; }
            }
            __syncthreads();
        }
    }
    {
        const bf16_t* KW = (const bf16_t*)(WB + S5W_KW) + (size_t)g * 256 * 512;
        bf16x8_t bw[2][16];
#pragma unroll
        for (int u = 0; u < 2; ++u)
#pragma unroll
            for (int ks = 0; ks < 16; ++ks) bw[u][ks] = *(const bf16x8_t*)(KW + (size_t)(32 * w + 16 * u + (lane & 15)) * 512 + 32 * ks + (lane >> 4) * 8);
        f32x4 ua, uc; uint4 xv; s5_fetch_u(P, b, g, 0, tid, ua, uc); xv = *(const uint4*)(XI + (size_t)(tid >> 5) * 256 + (tid & 31) * 8);
#pragma unroll 1
        for (int mt = 0; mt < 17; ++mt) {
            s5_store_u(At, tid, ua, uc);
            *(uint4*)(At + (tid >> 5) * S5P + 256 + (tid & 31) * 8) = xv;
            __syncthreads();
            if (mt + 1 < 17) { s5_fetch_u(P, b, g, mt + 1, tid, ua, uc); xv = *(const uint4*)(XI + (size_t)(16 * (mt + 1) + (tid >> 5)) * 256 + (tid & 31) * 8); }
            f32x4 a0 = {0.f, 0.f, 0.f, 0.f}, a1 = a0;
#pragma unroll
            for (int ks = 0; ks < 16; ++ks) { const bf16x8_t af = ldfrag(At, S5P, 0, 32 * ks, lane);
                a0 = __builtin_amdgcn_mfma_f32_16x16x32_bf16(af, bw[0][ks], a0, 0, 0, 0); a1 = __builtin_amdgcn_mfma_f32_16x16x32_bf16(af, bw[1][ks], a1, 0, 0, 0); }
#pragma unroll
            for (int r = 0; r < 4; ++r) { const int n = 16 * mt + (lane >> 4) * 4 + r;
                YG[(size_t)s5_row(b, n, 2 * w) * 512 + 16 * g + (lane & 15)] = (bf16_t)(pk2(gelu_tanh(a0[r]), 0.f) & 0xffff);
                YG[(size_t)s5_row(b, n, 2 * w + 1) * 512 + 16 * g + (lane & 15)] = (bf16_t)(pk2(gelu_tanh(a1[r]), 0.f) & 0xffff); }
            __syncthreads();
        }
    }
}


__device__ __forceinline__ void phase_inproj(const Params& p, int l, int bid, int nb, LAS unsigned char* lds) {
    pg8::Gemm g{(const bf16_t*)(WSP(p) + WS_H), (const bf16_t*)(WSP(p) + WS_WIN) + (size_t)l * NINP * DM, MROWS, NINP, DM};
    pg8::StaticOrder S; S.init(MROWS, NINP, nb, bid);
    pg8::EpiF32 E{(float*)(WSP(p) + WS_P), NINP};
    pg8::gemm_phase<pg8::EpiF32, pg8::StaticOrder, true, true>(lds, g, S, E);
}
__device__ __forceinline__ void phase_glu(const Params& p, int l, int bid, int nb, LAS unsigned char* lds) {
    pg8::Gemm g{(const bf16_t*)(WSP(p) + WS_YG), (const bf16_t*)(WSP(p) + WS_WGLU) + (size_t)l * 512 * 512, MROWS, 512, 512};
    pg8::StaticOrder S; S.init(MROWS, 512, nb, bid);
    pg8::EpiGlu E{(const bf16_t*)(WSP(p) + WS_YG), (const float*)(WSP(p) + WS_P) + PSG, NINP, INP(p, I_BGLU) + l * 512, (bf16_t*)(WSP(p) + WS_YCAT) + 1024, DM};
    pg8::gemm_phase<pg8::EpiGlu, pg8::StaticOrder, true, true>(lds, g, S, E);
}
__device__ __forceinline__ void phase_outproj(const Params& p, int l, int bid, int nb, LAS unsigned char* lds) {
    pg8::Gemm g{(const bf16_t*)(WSP(p) + WS_YCAT), (const bf16_t*)(WSP(p) + WS_WOUT) + (size_t)l * DM * DM, MROWS, DM, DM};
    pg8::StaticOrder S; S.init(MROWS, DM, nb, bid);
    pg8::EpiF32 E{(float*)(WSP(p) + WS_P), DM};
    pg8::gemm_phase<pg8::EpiF32, pg8::StaticOrder, true, true>(lds, g, S, E);
}

static_assert(GLA_BYTES <= (size_t)72 * 1000 * 1000 && S5W_BYTES <= (size_t)22 * 1000 * 1000 && WS_END <= (size_t)800 * 1000 * 1000, "workspace map");
constexpr int LDS_BYTES = 147456;
namespace cg = cooperative_groups;
#ifndef REP_PHASE
#define REP_PHASE -1
#endif
#if REP_PHASE < 0
#define REPEAT(k)
#else
#define REPEAT(k) for (int rep_ = 0; rep_ < ((REP_PHASE == (k)) ? 2 : 1); ++rep_)
#endif

#define WQUEUE(ln) do { unsigned* qctr_ = (unsigned*)(WSP(p) + WS_CTL + 15360) + 64 * (ln); volatile LAS unsigned* qs_ = (volatile LAS unsigned*)((LAS unsigned char*)lds + 131072 + 128); \
        hy_twiddles(smem); \
        for (;;) { __syncthreads(); if (threadIdx.x == 0) qs_[0] = atomicAdd(qctr_, 1u); __syncthreads(); const unsigned item_ = qs_[0]; if (item_ >= 576u) break; \
            REPEAT(90) { if (item_ < 32u) s5_weights_item(p, (ln), (int)item_, smem); else if (item_ < 64u) ctaps_item(p, (ln), (int)item_ - 32, smem); else hy_spec2_item(p, (ln), (int)item_ - 64, smem); } } } while (0)
__global__ void __launch_bounds__(NT, 2) k_mega(Params p) {
    extern __shared__ __attribute__((aligned(16))) unsigned char lds[];
    cg::grid_group grid = cg::this_grid();
    float* smem = (float*)lds;
    volatile LAS unsigned* bst = (volatile LAS unsigned*)((LAS unsigned char*)lds + 131072 + 64);
    if (threadIdx.x == 0) { bst[0] = 0u; bst[1] = 0u; }
    __syncthreads();
    const XcdBarrier xbar = xcd_barrier_post((unsigned*)(WSP(p) + WS_CTL), bst);
    { const int bid = blockIdx.x, nb = gridDim.x;
      REPEAT(0) { phase_weights(p, bid, nb, smem); phase_mod(p, bid, nb, smem);
        for (int it = bid; it < N_H2ITEMS; it += nb) h2_item(p, it, smem);
} }
    grid.sync();
#pragma unroll 1
    for (int l0 = 0; l0 < DEPTH; ++l0) {
        int l = l0; asm volatile("" : "+s"(l));
        int bid = blockIdx.x, nb = gridDim.x; asm volatile("" : "+s"(bid), "+s"(nb));
        phase_row(p, l, bid, nb);
        if (l == 0) WQUEUE(0);
        xcd_barrier(xbar);
        REPEAT(2) phase_inproj(p, l, bid, nb, (LAS unsigned char*)lds);
        xcd_barrier(xbar);
        REPEAT(3) phase_hyT(p, bid, nb, smem);
        REPEAT(4) for (int it = bid; it < N_GLAPREP; it += nb) gla_prep_item(p, l, it, smem);
        xcd_barrier(xbar);
        if (bid < 64) { REPEAT(60) gla_seq_item(p, bid, (bf16_t*)lds); }
        else if (bid < 128) { REPEAT(61) s5_item(p, bid - 64, smem); }
        {
            unsigned* qctr = (unsigned*)(WSP(p) + WS_CTL + 14336) + 64 * l; volatile LAS unsigned* qs = (volatile LAS unsigned*)((LAS unsigned char*)lds + 131072 + 128);
            hy_twiddles(smem);
            const float* HTC = (const float*)(WSP(p) + WS_HT) + (size_t)NB * 2048 * SEQ; float* HOb = (float*)(WSP(p) + WS_TP);
            for (;;) {
                __syncthreads();
                if (threadIdx.x == 0) qs[0] = atomicAdd(qctr, 1u);
                __syncthreads();
                const unsigned item = qs[0];
                if (item >= 1024u) break;
                REPEAT(62) { if (item < 512u) hy_fft_item(p, l, (int)item, smem);
                else hy_naive_item<LCX, 1>(p, l, HOb + TPC_OFF, HTC, HOb + HO_C, (int)item - 512, smem); }
            }
        }
        xcd_barrier(xbar);
        REPEAT(6) phase_glu(p, l, bid, nb, (LAS unsigned char*)lds);
        REPEAT(7) phase_post(p, l, bid, nb, smem);
        xcd_barrier(xbar);
        REPEAT(8) phase_outproj(p, l, bid, nb, (LAS unsigned char*)lds);
        if (l + 1 < DEPTH) WQUEUE(l + 1);
        xcd_barrier(xbar);
    }
    phase_row(p, DEPTH, blockIdx.x, gridDim.x);
}

extern "C" void kernel_launch(void* const* d_in, const int* in_sizes, int n_in, void* d_out, int out_size, void* d_ws, size_t ws_size, hipStream_t stream) {
    if (n_in != 33 || out_size != NLAT * DM || ws_size < WS_END) { fprintf(stderr, "kernel_launch: unexpected problem (n_in %d out %d ws %zu need %zu)\n", n_in, out_size, ws_size, (size_t)WS_END); return; }
    Params p{};
    for (int i = 0; i < 33; ++i) p.in[i] = (const float*)d_in[i];
    p.out = (float*)d_out; p.ws = (unsigned char*)d_ws;
    static int grid_blocks = 0;
    if (!grid_blocks) {
        int dev = 0, cus = 0, per_cu = 0;
        (void)hipGetDevice(&dev);
        (void)hipDeviceGetAttribute(&cus, hipDeviceAttributeMultiprocessorCount, dev);
        (void)hipFuncSetAttribute((const void*)k_mega, hipFuncAttributeMaxDynamicSharedMemorySize, LDS_BYTES);
        (void)hipOccupancyMaxActiveBlocksPerMultiprocessor(&per_cu, (const void*)k_mega, NT, LDS_BYTES);
        if (per_cu < 1) { fprintf(stderr, "kernel_launch: occupancy query says %d blocks per CU\n", per_cu); per_cu = 1; }
        grid_blocks = cus;
        fprintf(stderr, "kernel_launch: cus %d per_cu %d grid %d\n", cus, per_cu, grid_blocks);
    }
    (void)hipMemsetAsync((unsigned char*)d_ws + WS_CTL, 0, CTL_BYTES, stream);
    void* args[] = {&p};
    hipError_t e = hipLaunchCooperativeKernel((const void*)k_mega, dim3(grid_blocks), dim3(NT), args, LDS_BYTES, stream);
    if (e != hipSuccess) fprintf(stderr, "cooperative launch failed: %s (grid %d)\n", hipGetErrorString(e), grid_blocks);
}
```

```cpp
#include <hip/hip_runtime.h>
#include <hip/hip_cooperative_groups.h>
#include <cstdio>
#include <cstdint>
#include <cmath>
namespace pg8 {
#define PG8_LAS __attribute__((address_space(3)))
typedef unsigned short bf16_t;
typedef short bf16x8 __attribute__((ext_vector_type(8)));
typedef float f32x4 __attribute__((ext_vector_type(4)));
typedef unsigned u32x4 __attribute__((ext_vector_type(4)));
constexpr int BM = 256, BK = 64, HALF = 128, HTB = HALF * BK * 2  , STAGE_BYTES = 8 * HTB, NXCD = 8, WGM = 8;

__host__ __device__ __forceinline__ int lds_byte(int r, int c) { const int st = (r >> 4) * 2 + (c >> 5), rr = r & 15, cc = c & 31, ob = rr * 64 + cc * 2; return st * 1024 + (ob ^ (((ob >> 9) & 1) << 5)); }
__host__ __device__ __forceinline__ void stage_rc(int b, int& R, int& C) { const int st = b / 1024, sb = b % 1024, swz = sb ^ (((sb >> 9) & 1) << 5); R = (st >> 1) * 16 + swz / 64; C = (st & 1) * 32 + (swz % 64) / 2; }
__host__ __device__ __forceinline__ int perm32(int rho) { const int n = rho >> 4, i = rho & 15; return 8 * (i >> 2) + 4 * n + (i & 3); }

struct Unit { int pm, pn; };
struct Gemm { const bf16_t* A; const bf16_t* Bt; int M, N, K; };

struct StaticOrder {
    int nM, nN, nwg, G, c;
    __host__ __device__ void init(int M, int N, int G_, int c_) { nM = M / BM; nN = N / BM; nwg = nM * nN; G = G_; c = c_; }
    __host__ __device__ bool next(int i, Unit& u) const {
        const long L = (long)i * G + c; if (L >= nwg) return false;
        int wgid = (int)L; { const int q = nwg / NXCD, r = nwg % NXCD, xcd = wgid % NXCD, off = wgid / NXCD; wgid = (xcd < r ? xcd * (q + 1) : r * (q + 1) + (xcd - r) * q) + off; }
        const int nig = WGM * nN, gid = wgid / nig, fm = gid * WGM, gsz = (nM - fm) < WGM ? (nM - fm) : WGM;
        u.pm = fm + ((wgid % nig) % gsz); u.pn = (wgid % nig) / gsz; return true;
    }
    __device__ __forceinline__ void a_ready(const Unit&) const {}
    __device__ __forceinline__ void done(const Unit&) const {}
};


__device__ __forceinline__ unsigned cvt_pk_bf16(float lo, float hi) { unsigned r; asm volatile("v_cvt_pk_bf16_f32 %0, %1, %2" : "=v"(r) : "v"(lo), "v"(hi)); return r; }
__device__ __forceinline__ float bf2f(unsigned short h) { return __builtin_bit_cast(float, (unsigned)h << 16); }

struct EpiF32 {
    static constexpr bool PERM = false, AFTER_DRAIN = false;
    float* O; int ldc;
    __device__ __forceinline__ void operator()(const f32x4 (&acc)[2][2][4][2], const Unit& u, int wr, int wc, int fr, int fq) const {
        const int row0 = u.pm * BM + wr * 64 + fr, col0 = u.pn * BM + wc * 32 + 4 * fq;
#pragma unroll
        for (int ai = 0; ai < 2; ++ai)
#pragma unroll
            for (int m = 0; m < 4; ++m) { float* rowp = O + (size_t)(row0 + ai * HALF + m * 16) * ldc + col0;
#pragma unroll
                for (int bj = 0; bj < 2; ++bj)
#pragma unroll
                    for (int n = 0; n < 2; ++n) *(f32x4*)(rowp + bj * HALF + n * 16) = acc[ai][bj][m][n]; }
    }
};
struct EpiIn {
    static constexpr bool PERM = false, AFTER_DRAIN = false;
    bf16_t* P16; int pp; float* HT; float* HTC;
    __device__ __forceinline__ void operator()(const f32x4 (&acc)[2][2][4][2], const Unit& u, int wr, int wc, int fr, int fq) const {
        const int row0 = u.pm * BM + wr * 64 + fr;
        if (u.pn < 16 || u.pn == 24) {
            const int col0 = (u.pn < 16 ? u.pn : 16) * BM + wc * 32 + 4 * fq;
#pragma unroll
            for (int ai = 0; ai < 2; ++ai)
#pragma unroll
                for (int m = 0; m < 4; ++m) { bf16_t* rowp = P16 + (size_t)(row0 + ai * HALF + m * 16) * pp + col0;
#pragma unroll
                    for (int bj = 0; bj < 2; ++bj)
#pragma unroll
                        for (int n = 0; n < 2; ++n) { const f32x4 a = acc[ai][bj][m][n]; uint2 w; w.x = cvt_pk_bf16(a[0], a[1]); w.y = cvt_pk_bf16(a[2], a[3]); *(uint2*)(rowp + bj * HALF + n * 16) = w; } }
        } else {
            const int ch0 = (u.pn - 16) * BM + wc * 32 + 4 * fq; float* base; int lx, t0;
            if (u.pm < 32) { const int b = u.pm >> 4; lx = 4096; t0 = (u.pm & 15) * BM + wr * 64 + fr; base = HT + (size_t)b * 2048 * 4096; }
            else { const int b = u.pm - 32; lx = 256; t0 = wr * 64 + fr; base = HTC + (size_t)b * 2048 * 256; }
#pragma unroll
            for (int ai = 0; ai < 2; ++ai)
#pragma unroll
                for (int m = 0; m < 4; ++m) { const int t = t0 + ai * HALF + m * 16;
#pragma unroll
                    for (int bj = 0; bj < 2; ++bj)
#pragma unroll
                        for (int n = 0; n < 2; ++n) { const f32x4 a = acc[ai][bj][m][n]; float* d = base + (size_t)(ch0 + bj * HALF + n * 16) * lx + t;
                            d[0] = a[0]; d[lx] = a[1]; d[2 * (size_t)lx] = a[2]; d[3 * (size_t)lx] = a[3]; } }
        }
    }
};
struct EpiGlu {
    static constexpr bool PERM = false, AFTER_DRAIN = false;
    const bf16_t* YG; const bf16_t* Psg; int ldp; const float* bg; bf16_t* Y; int ldy;
    __device__ __forceinline__ void operator()(const f32x4 (&acc)[2][2][4][2], const Unit& u, int wr, int wc, int fr, int fq) const {
        const int row0 = u.pm * BM + wr * 64 + fr, col0 = u.pn * BM + wc * 32 + 4 * fq;
#pragma unroll
        for (int ai = 0; ai < 2; ++ai)
#pragma unroll
            for (int m = 0; m < 4; ++m) { const size_t row = (size_t)(row0 + ai * HALF + m * 16);
#pragma unroll
                for (int bj = 0; bj < 2; ++bj)
#pragma unroll
                    for (int n = 0; n < 2; ++n) { const int col = col0 + bj * HALF + n * 16;
                        const f32x4 a = acc[ai][bj][m][n]; const f32x4 b = *(const f32x4*)(bg + col); const uint2 s2 = *(const uint2*)(Psg + row * ldp + col);
                        const float sg[4] = {bf2f((unsigned short)(s2.x & 0xffff)), bf2f((unsigned short)(s2.x >> 16)), bf2f((unsigned short)(s2.y & 0xffff)), bf2f((unsigned short)(s2.y >> 16))};
                        const uint2 y2 = *(const uint2*)(YG + row * 512 + col);
                        float yv[4] = {bf2f((unsigned short)(y2.x & 0xffff)), bf2f((unsigned short)(y2.x >> 16)), bf2f((unsigned short)(y2.y & 0xffff)), bf2f((unsigned short)(y2.y >> 16))};
                        float o[4];
#pragma unroll
                        for (int e = 0; e < 4; ++e) { const float z = a[e] + b[e]; const float s = 1.f / (1.f + __expf(-z)); const float g = sg[e]; const float sl = g / (1.f + __expf(-g)); o[e] = yv[e] * s * sl; }
                        uint2 w; w.x = cvt_pk_bf16(o[0], o[1]); w.y = cvt_pk_bf16(o[2], o[3]);
                        *(uint2*)(Y + row * ldy + col) = w; } }
    }
};
template <class Epi, class Sched, bool ALIGN_EPI = false, bool SP2 = false>
__device__ __forceinline__ void gemm_phase(PG8_LAS unsigned char* lds, const Gemm g, const Sched& S, const Epi& E) {
    int tid_o = threadIdx.x; asm volatile("" : "+v"(tid_o)); const int tid = tid_o, wid = __builtin_amdgcn_readfirstlane(tid >> 6), lane = tid & 63, wr = wid >> 2, wc = wid & 3, fr = lane & 15, fq = lane >> 4;
    const int K = g.K, nt = K / BK;
    unsigned voffA[2], voffB[2];
#pragma unroll
    for (int i = 0; i < 2; ++i) { int R, C; stage_rc(tid * 16 + i * 8192, R, C); const int Rb = Epi::PERM ? ((R & ~31) + perm32(R & 31)) : R;
        voffA[i] = (unsigned)(R * K + C) * 2u; voffB[i] = (unsigned)(Rb * K + C) * 2u; }
    const size_t kstep = (size_t)(BK * 2);
    const size_t hstep = (size_t)HALF * K * 2;
    const size_t tstep = 2 * hstep;
    const unsigned ldsw = (unsigned)wid * 1024u;
    const int aoff = lds_byte(wr * 64 + fr, fq * 8), boff = lds_byte(wc * 32 + fr, fq * 8);
#define PG8_SA(b, h) (((b) * 2 + (h)) * HTB)
#define PG8_SB(b, h) ((4 + (b) * 2 + (h)) * HTB)
#define PG8_STAGE(bufoff, gbase, voff) do { _Pragma("unroll") for (int _i = 0; _i < 2; ++_i) \
        __builtin_amdgcn_global_load_lds((const unsigned*)((const char*)(gbase) + (voff)[_i]), (PG8_LAS unsigned*)(lds + (bufoff) + ldsw + _i * 8192), 16, 0, 0); } while (0)
#define PG8_LDA(dst, b, h) do { _Pragma("unroll") for (int m = 0; m < 4; ++m) _Pragma("unroll") for (int k = 0; k < 2; ++k) dst[m][k] = *(const PG8_LAS bf16x8*)(lds + PG8_SA(b, h) + aoff + m * 2048 + k * 1024); } while (0)
#define PG8_LDB(dst, b, h) do { _Pragma("unroll") for (int n = 0; n < 2; ++n) _Pragma("unroll") for (int k = 0; k < 2; ++k) dst[n][k] = *(const PG8_LAS bf16x8*)(lds + PG8_SB(b, h) + boff + n * 2048 + k * 1024); } while (0)
#define PG8_MMA(ai, bj, At, Bt) do { __builtin_amdgcn_s_setprio(1); _Pragma("unroll") for (int m = 0; m < 4; ++m) _Pragma("unroll") for (int n = 0; n < 2; ++n) _Pragma("unroll") for (int k = 0; k < 2; ++k) \
        acc[ai][bj][m][n] = __builtin_amdgcn_mfma_f32_16x16x32_bf16(Bt[n][k], At[m][k], acc[ai][bj][m][n], 0, 0, 0); __builtin_amdgcn_s_setprio(0); } while (0)
#define PG8_WAIT_V(n) asm volatile("s_waitcnt vmcnt(" #n ")" ::: "memory")
#define PG8_WAIT_L(n) asm volatile("s_waitcnt lgkmcnt(" #n ")" ::: "memory")
#define PG8_BAR __builtin_amdgcn_s_barrier()
#define PG8_SCHED __builtin_amdgcn_sched_barrier(0)
    Unit cur, nxt; int ui = 0;
    if (!S.next(0, cur)) return;
    f32x4 acc[2][2][4][2];
#pragma unroll
    for (int a = 0; a < 2; ++a)
#pragma unroll
        for (int b = 0; b < 2; ++b)
#pragma unroll
            for (int m = 0; m < 4; ++m)
#pragma unroll
                for (int n = 0; n < 2; ++n) acc[a][b][m][n] = (f32x4){0.f, 0.f, 0.f, 0.f};
    bf16x8 At[4][2], B0[2][2], B1[2][2];
    const char* cA = (const char*)g.A + (size_t)cur.pm * tstep; const char* cB = (const char*)g.Bt + (size_t)cur.pn * tstep;
    S.a_ready(cur);
    if constexpr (SP2) {
        PG8_STAGE(PG8_SB(0, 0), cB, voffB); PG8_STAGE(PG8_SB(0, 1), cB + hstep, voffB); PG8_STAGE(PG8_SA(0, 0), cA, voffA); PG8_STAGE(PG8_SA(0, 1), cA + hstep, voffA);
        if (wr == 1) PG8_BAR;
        PG8_WAIT_V(2); PG8_BAR;
        PG8_STAGE(PG8_SB(1, 0), cB + kstep, voffB); PG8_STAGE(PG8_SA(1, 0), cA + kstep, voffA); PG8_STAGE(PG8_SB(1, 1), cB + hstep + kstep, voffB);
        PG8_WAIT_V(6); PG8_BAR;
    } else {
        PG8_STAGE(PG8_SB(0, 0), cB, voffB); PG8_STAGE(PG8_SA(0, 0), cA, voffA); PG8_STAGE(PG8_SB(0, 1), cB + hstep, voffB); PG8_STAGE(PG8_SA(0, 1), cA + hstep, voffA);
        if (wr == 1) PG8_BAR;
        PG8_WAIT_V(4); PG8_BAR;
        PG8_STAGE(PG8_SB(1, 0), cB + kstep, voffB); PG8_STAGE(PG8_SA(1, 0), cA + kstep, voffA); PG8_STAGE(PG8_SB(1, 1), cB + hstep + kstep, voffB);
        PG8_WAIT_V(6); PG8_BAR;
    }
    for (;;) {
        const bool has_next = S.next(ui + 1, nxt);
        const char* nA = has_next ? (const char*)g.A + (size_t)nxt.pm * tstep : cA; const char* nB = has_next ? (const char*)g.Bt + (size_t)nxt.pn * tstep : cB;
        for (int t = 0; t < nt; t += 2) {
            const bool last = (t == nt - 2);
            const char* a1 = cA + (size_t)(t + 1) * kstep;
            const char* a2 = last ? nA : cA + (size_t)(t + 2) * kstep; const char* b2 = last ? nB : cB + (size_t)(t + 2) * kstep;
            const char* a3 = a2 + kstep; const char* b3 = b2 + kstep;
            if (last && has_next) S.a_ready(nxt);
            if constexpr (SP2) {
            PG8_LDB(B0, 0, 0); PG8_LDB(B1, 0, 1); PG8_SCHED; PG8_LDA(At, 0, 0); PG8_STAGE(PG8_SA(1, 1), a1 + hstep, voffA);
            PG8_WAIT_V(8); PG8_WAIT_L(0); PG8_BAR; PG8_MMA(0, 0, At, B0); PG8_MMA(0, 1, At, B1); PG8_BAR; PG8_SCHED;
            PG8_LDA(At, 0, 1); PG8_STAGE(PG8_SB(0, 0), b2, voffB); PG8_STAGE(PG8_SB(0, 1), b2 + hstep, voffB); PG8_STAGE(PG8_SA(0, 0), a2, voffA);
            PG8_WAIT_V(8); PG8_WAIT_L(0); PG8_BAR; PG8_MMA(1, 0, At, B0); PG8_MMA(1, 1, At, B1); PG8_BAR; PG8_SCHED;
            PG8_LDB(B0, 1, 0); PG8_LDB(B1, 1, 1); PG8_SCHED; PG8_LDA(At, 1, 0); PG8_STAGE(PG8_SA(0, 1), a2 + hstep, voffA);
            PG8_WAIT_V(8); PG8_WAIT_L(0); PG8_BAR; PG8_MMA(0, 0, At, B0); PG8_MMA(0, 1, At, B1); PG8_BAR; PG8_SCHED;
            PG8_LDA(At, 1, 1); PG8_STAGE(PG8_SB(1, 0), b3, voffB); PG8_STAGE(PG8_SB(1, 1), b3 + hstep, voffB); PG8_STAGE(PG8_SA(1, 0), a3, voffA);
            PG8_WAIT_V(8); PG8_WAIT_L(0); PG8_BAR; PG8_MMA(1, 0, At, B0); PG8_MMA(1, 1, At, B1); PG8_BAR; PG8_SCHED;
            } else {
            PG8_LDB(B0, 0, 0); PG8_SCHED; PG8_LDA(At, 0, 0); PG8_STAGE(PG8_SA(1, 1), a1 + hstep, voffA);
            PG8_WAIT_L(8); PG8_BAR; PG8_WAIT_L(0); PG8_MMA(0, 0, At, B0); PG8_BAR; PG8_SCHED;
            PG8_LDB(B1, 0, 1); PG8_STAGE(PG8_SB(0, 0), b2, voffB);
            PG8_BAR; PG8_WAIT_L(0); PG8_MMA(0, 1, At, B1); PG8_BAR;
            PG8_LDA(At, 0, 1); PG8_STAGE(PG8_SA(0, 0), a2, voffA);
            PG8_BAR; PG8_WAIT_L(0); PG8_MMA(1, 0, At, B0); PG8_BAR; PG8_SCHED;
            PG8_STAGE(PG8_SB(0, 1), b2 + hstep, voffB);
            PG8_WAIT_V(6); PG8_BAR; PG8_MMA(1, 1, At, B1); PG8_BAR;
            PG8_LDB(B0, 1, 0); PG8_SCHED; PG8_LDA(At, 1, 0); PG8_STAGE(PG8_SA(0, 1), a2 + hstep, voffA);
            PG8_WAIT_L(8); PG8_BAR; PG8_WAIT_L(0); PG8_MMA(0, 0, At, B0); PG8_BAR; PG8_SCHED;
            PG8_LDB(B1, 1, 1); PG8_STAGE(PG8_SB(1, 0), b3, voffB);
            PG8_BAR; PG8_WAIT_L(0); PG8_MMA(0, 1, At, B1); PG8_BAR;
            PG8_LDA(At, 1, 1); PG8_STAGE(PG8_SA(1, 0), a3, voffA);
            PG8_BAR; PG8_WAIT_L(0); PG8_MMA(1, 0, At, B0); PG8_BAR; PG8_SCHED;
            PG8_STAGE(PG8_SB(1, 1), b3 + hstep, voffB);
            PG8_WAIT_V(6); PG8_BAR; PG8_MMA(1, 1, At, B1); PG8_BAR;
            }
        }
        if constexpr (ALIGN_EPI) { if (wr == 0) PG8_BAR; }
        if constexpr (!Epi::AFTER_DRAIN) { E(acc, cur, wr, wc, fr, fq); S.done(cur); }
        if (!has_next) break;
#pragma unroll
        for (int a = 0; a < 2; ++a)
#pragma unroll
            for (int b = 0; b < 2; ++b)
#pragma unroll
                for (int m = 0; m < 4; ++m)
#pragma unroll
                    for (int n = 0; n < 2; ++n) acc[a][b][m][n] = (f32x4){0.f, 0.f, 0.f, 0.f};
        cur = nxt; cA = nA; cB = nB; ++ui;
        if constexpr (ALIGN_EPI) { if (wr == 1) PG8_BAR; }
    }
    PG8_WAIT_V(0);
    if constexpr (!ALIGN_EPI) { if (wr == 0) PG8_BAR; }
    PG8_BAR;
    if constexpr (Epi::AFTER_DRAIN) { E.fused(acc, cur, wr, wc, fr, fq, lds, wid, lane); S.done(cur); }
#undef PG8_SA
#undef PG8_SB
#undef PG8_STAGE
#undef PG8_LDA
#undef PG8_LDB
#undef PG8_MMA
#undef PG8_WAIT_V
#undef PG8_WAIT_L
#undef PG8_BAR
#undef PG8_SCHED
}
}

using pg8::bf16_t; using pg8::f32x4;
#define LAS __attribute__((address_space(3)))
constexpr int DM = 2048, NB = 2, SEQ = 4096, LCX = 256, DEPTH = 4;
constexpr int NLAT = NB * SEQ;
constexpr int MROWS = NLAT + NB * LCX;
constexpr int NIN = 6176, NINP = 6400;
constexpr int PQ = 0, PK = 512, PV = 1024, PU = 2048, PGG = 2560, PSG = 3584, PLR = 4096, PP = 4352;
constexpr float EPS = 1e-6f;
constexpr int NT = 512;

__host__ __device__ __forceinline__ int in_col_map(int n) {
    if (n < 2048) return n;
    if (n < 6144) return n + 32;
    if (n < 6176) return n - 4096;
    return -1;
}

constexpr size_t al256(size_t x) { return (x + 255) & ~(size_t)255; }
constexpr size_t WS_WIN  = 0;
constexpr size_t WS_WOUT = WS_WIN  + al256((size_t)DEPTH * NINP * DM * 2);
constexpr size_t WS_WGLU = WS_WOUT + al256((size_t)DEPTH * DM * DM * 2);
constexpr size_t WS_MOD  = WS_WGLU + al256((size_t)DEPTH * 512 * 512 * 2);
constexpr size_t WS_H    = WS_MOD  + al256((size_t)DEPTH * 3 * 6144 * 4);
constexpr size_t WS_YCAT = WS_H    + al256((size_t)MROWS * DM * 2);
constexpr size_t WS_P    = WS_YCAT + al256((size_t)MROWS * DM * 2);
constexpr size_t WS_XC   = WS_P    + al256((size_t)MROWS * PP * 2);
static_assert((size_t)MROWS * PP * 2 >= (size_t)MROWS * DM * 4, "R aliases P16");
constexpr size_t WS_OG   = WS_XC   + al256((size_t)NB * LCX * DM * 4);
constexpr size_t WS_YS5  = WS_OG   + al256((size_t)2 * MROWS * 1024 * 4);
constexpr size_t WS_YG   = WS_YS5  + al256((size_t)MROWS * 512 * 4);
constexpr size_t WS_HT   = WS_YG   + al256((size_t)MROWS * 512 * 2);
constexpr size_t WS_TP   = WS_HT   + al256((size_t)MROWS * 2048 * 4);
constexpr size_t HO_C = (size_t)2 * 512 * SEQ, TPC_OFF = HO_C + (size_t)2 * 512 * LCX;
constexpr size_t WS_HS   = WS_TP   + al256((TPC_OFF + (size_t)2 * 512 * 2 * LCX) * 4);
constexpr size_t WS_H2   = WS_HS   + al256((size_t)2 * 512 * 8192 * 8);
constexpr size_t WS_GLA  = WS_H2   + al256((size_t)DEPTH * SEQ * 64 * 4);
constexpr size_t WS_S5W  = WS_GLA  + al256((size_t)72 * 1000 * 1000);
constexpr size_t WS_CTL  = WS_S5W  + al256((size_t)22 * 1000 * 1000);
constexpr size_t CTL_BYTES = 16384;
constexpr size_t WS_END  = WS_CTL  + CTL_BYTES;

struct Params {
    const float* in[33];
    float* out;
    unsigned char* ws;
};

#define KARG_AS __attribute__((address_space(4)))
__device__ __forceinline__ const void* karg_ptr(int byte_off) {
    asm volatile("" : "+s"(byte_off));
    const KARG_AS char* ka = (const KARG_AS char*)__builtin_amdgcn_kernarg_segment_ptr();
    return *(void* const KARG_AS*)(ka + byte_off);
}
#define INP(p, i) ((const float*)karg_ptr(8 * (i)))
#define OUTP(p) ((float*)karg_ptr(8 * 33))
#define WSP(p) ((unsigned char*)karg_ptr(8 * 34))
static_assert(sizeof(Params) == 35 * 8, "Params layout: in[33], out, ws");
enum { I_X = 0, I_C, I_CTX, I_CCTX, I_WMOD, I_BMOD, I_GPRE, I_GPOST, I_WIN, I_WOUT, I_GWG, I_GBG, I_GNORM,
       I_LRE, I_LIM, I_LSTEP, I_BRE, I_BIM, I_CRE, I_CIM, I_S5D, I_WGLU, I_BGLU, I_HCW, I_HCB, I_HW1, I_HB1, I_HF1, I_HW2, I_HB2, I_HF2, I_HW3, I_HD };

__device__ __forceinline__ float wave_sum(float v) {
#pragma unroll
    for (int o = 1; o < 64; o <<= 1) v += __shfl_xor(v, o);
    return v;
}
__device__ __forceinline__ float silu_f(float x) { return x / (1.f + expf(-x)); }
__device__ __forceinline__ float gelu_tanh(float x) { const float u = 0.7978845608028654f * (x + 0.044715f * x * x * x); return 0.5f * x * (1.f + tanhf(u)); }
__device__ __forceinline__ unsigned pk2(float lo, float hi) { return pg8::cvt_pk_bf16(lo, hi); }
typedef _Float16 h16x2 __attribute__((ext_vector_type(2)));
__device__ __forceinline__ unsigned pkh2(float lo, float hi) { h16x2 v = {(_Float16)lo, (_Float16)hi}; return __builtin_bit_cast(unsigned, v); }
__device__ __forceinline__ float h2f_lo(unsigned u) { return (float)__builtin_bit_cast(h16x2, u)[0]; }
__device__ __forceinline__ float h2f_hi(unsigned u) { return (float)__builtin_bit_cast(h16x2, u)[1]; }
__device__ __forceinline__ int otid() { int t = threadIdx.x; asm volatile("" : "+v"(t)); return t; }
__device__ __forceinline__ int permtok(int t) { return ((t & 63) << 6) | (t >> 6); }

template <bool MAPIN>
__device__ __forceinline__ void transpose_item(const float* __restrict__ W, int ldw, int K, bf16_t* __restrict__ WT, int k0, int n0, float* tile) {
    const int tid = otid();
#pragma unroll
    for (int j = 0; j < 32; ++j) { const int i = tid + NT * j, kk = i >> 8, nn = i & 255; int oc = n0 + nn; if (MAPIN) oc = in_col_map(oc);
        tile[kk * 257 + nn] = (oc >= 0) ? W[(size_t)(k0 + kk) * ldw + oc] : 0.f; }
    __syncthreads();
    { const int n = tid >> 1, kh = tid & 1; bf16_t* dst = WT + (size_t)(n0 + n) * K + k0 + 32 * kh;
#pragma unroll
      for (int c = 0; c < 4; ++c) { const float* s = tile + (32 * kh + 8 * c) * 257 + n;
          *(uint4*)(dst + 8 * c) = make_uint4(pk2(s[0], s[257]), pk2(s[2 * 257], s[3 * 257]), pk2(s[4 * 257], s[5 * 257]), pk2(s[6 * 257], s[7 * 257])); } }
    __syncthreads();
}
constexpr int TI_IN = (DM / 64) * (NINP / 256), TI_OUT = (DM / 64) * (DM / 256), TI_GLU = 8 * 2;
constexpr int N_TITEMS = TI_IN + TI_OUT + TI_GLU;
__device__ __forceinline__ void weights_item(const Params& p, int l, int r, float* smem) {
    if (r < TI_IN) { const int kb = r / (NINP / 256), nbk = r % (NINP / 256);
        transpose_item<true>(INP(p, I_WIN) + (size_t)l * DM * NIN, NIN, DM, (bf16_t*)(WSP(p) + WS_WIN) + (size_t)l * NINP * DM, kb * 64, nbk * 256, smem); return; }
    r -= TI_IN;
    if (r < TI_OUT) { const int kb = r / 8, nbk = r % 8;
        transpose_item<false>(INP(p, I_WOUT) + (size_t)l * DM * DM, DM, DM, (bf16_t*)(WSP(p) + WS_WOUT) + (size_t)l * DM * DM, kb * 64, nbk * 256, smem); return; }
    r -= TI_OUT;
    { const int kb = r / 2, nbk = r % 2;
        transpose_item<false>(INP(p, I_WGLU) + (size_t)l * 512 * 512, 512, 512, (bf16_t*)(WSP(p) + WS_WGLU) + (size_t)l * 512 * 512, kb * 64, nbk * 256, smem); }
}
constexpr int N_MODITEMS = 6144 / 64;
__device__ __forceinline__ void mod_item(const Params& p, int l, int jb, float* smem) {
    const int tid = otid(); float* sv = smem;   float* red = smem + 3 * 2048;
    for (int i = tid; i < 3 * 2048; i += NT) { const int r = i >> 11, k = i & 2047; const float c = (r < 2) ? INP(p, I_C)[r * 2048 + k] : INP(p, I_CCTX)[k]; sv[i] = silu_f(c); }
    __syncthreads();
    const int cl = tid & 15, kg = tid >> 4;
    const float* w = INP(p, I_WMOD) + (size_t)l * DM * 6144 + jb * 64 + cl * 4;
    f32x4 a0 = {0, 0, 0, 0}, a1 = a0, a2 = a0;
#pragma unroll 16
    for (int kk = 0; kk < 64; ++kk) { const int k = kg * 64 + kk; const f32x4 wv = *(const f32x4*)(w + (size_t)k * 6144);
        a0 += wv * sv[k]; a1 += wv * sv[2048 + k]; a2 += wv * sv[4096 + k]; }
    *(f32x4*)(red + (kg * 3 + 0) * 64 + cl * 4) = a0; *(f32x4*)(red + (kg * 3 + 1) * 64 + cl * 4) = a1; *(f32x4*)(red + (kg * 3 + 2) * 64 + cl * 4) = a2;
    __syncthreads();
    if (tid < 192) { const int r = tid >> 6, c = tid & 63; float s = INP(p, I_BMOD)[l * 6144 + jb * 64 + c];
        for (int g = 0; g < 32; ++g) s += red[(g * 3 + r) * 64 + c];
        ((float*)(WSP(p) + WS_MOD))[(size_t)(l * 3 + r) * 6144 + jb * 64 + c] = s; }
    __syncthreads();
}
__device__ __forceinline__ void taps_item(const Params& p, int l, int LX, float* TP, int tb, int cb, float* smem) {
    const int tid = otid();
    float* feats = smem;
    float* h1 = feats + 64 * 33;
    float* h2 = h1 + 64 * 64;
    float* T = h2 + 64 * 64;
    const float* w1 = INP(p, I_HW1) + l * 33 * 64; const float* b1 = INP(p, I_HB1) + l * 64; const float* f1 = INP(p, I_HF1) + l * 64;
    const float* w2 = INP(p, I_HW2) + l * 64 * 64; const float* b2 = INP(p, I_HB2) + l * 64; const float* f2 = INP(p, I_HF2) + l * 64;
    const float* w3 = INP(p, I_HW3) + (size_t)l * 64 * 2048;
#pragma unroll 1
    for (int i = tid; i < 64 * 33; i += NT) { const int tt = i / 33, f = i % 33; const int tau = tb * 64 + tt;
        const float ang = (6.283185307179586f / (float)LX) * (float)tau; float v;
        if (f == 0) v = (float)tau / (float)(LX - 1);
        else { const int bi = (f - 1) & 15; const float band = 1e-4f + (float)bi * ((15.0f - 1e-4f) / 15.0f); const float a = band * ang; v = (f <= 16) ? cosf(a) : -sinf(a); }
        feats[i] = v; }
    __syncthreads();
#pragma unroll 1
    for (int i = tid; i < 64 * 64; i += NT) { const int tt = i >> 6, j = i & 63; float s = b1[j];
#pragma unroll 3
        for (int f = 0; f < 33; ++f) s += feats[tt * 33 + f] * w1[f * 64 + j];
        h1[i] = sinf(f1[j] * s); }
    __syncthreads();
#pragma unroll 1
    for (int i = tid; i < 64 * 64; i += NT) { const int tt = i >> 6, j = i & 63; float s = b2[j];
#pragma unroll 4
        for (int f = 0; f < 64; ++f) s += h1[tt * 64 + f] * w2[f * 64 + j];
        h2[i] = sinf(f2[j] * s); }
    __syncthreads();
    { const int cc = tid & 255, th = tid >> 8, col = cb * 256 + cc; float w3r[64];
#pragma unroll
      for (int i = 0; i < 64; ++i) w3r[i] = w3[(size_t)i * 2048 + col];
      const int c = col & 511; const float delta = fabsf(-15.350567286626973f + (float)c * ((-3.0701134573253945f + 15.350567286626973f) / 511.0f));
#pragma unroll 2
      for (int e = 0; e < 32; ++e) { const float* hrow = h2 + (th * 32 + e) * 64; float a = 0.f;
#pragma unroll
          for (int i4 = 0; i4 < 16; ++i4) { const f32x4 hv = *(const f32x4*)(hrow + 4 * i4);
              a += w3r[4 * i4] * hv[0] + w3r[4 * i4 + 1] * hv[1] + w3r[4 * i4 + 2] * hv[2] + w3r[4 * i4 + 3] * hv[3]; }
          const int tau = tb * 64 + th * 32 + e; const float tl = (float)tau / (float)(LX - 1); T[cc * 65 + th * 32 + e] = a * expf(-tl * delta); } }
    __syncthreads();
    { const int tt = tid & 63, cg = tid >> 6; const int tau = tb * 64 + tt;
#pragma unroll 2
      for (int q = 0; q < 32; ++q) { const int cc = cg * 32 + q, col = cb * 256 + cc; const int o = col >> 10, dir = (col >> 9) & 1, c = col & 511;
          float* dst = TP + (size_t)(o * 512 + c) * (2 * LX);
          if (dir == 0) dst[LX - 1 + tau] = T[cc * 65 + tt];
          else if (tau >= 1) dst[LX - 1 - tau] = T[cc * 65 + tt]; } }
    __syncthreads();
}
constexpr int N_H2ITEMS = SEQ / 64;
__device__ __forceinline__ void h2_item(const Params& p, int it, float* smem) {
    const int tid = otid(); const int l = it / (SEQ / 64), tb = it % (SEQ / 64); constexpr int LX = SEQ;
    float* dst = (float*)(WSP(p) + WS_H2) + (size_t)l * 64 * SEQ + tb * 64;
    float* feats = smem; float* h1 = feats + 64 * 33;
    const float* w1 = INP(p, I_HW1) + l * 33 * 64; const float* b1 = INP(p, I_HB1) + l * 64; const float* f1 = INP(p, I_HF1) + l * 64;
    const float* w2 = INP(p, I_HW2) + l * 64 * 64; const float* b2 = INP(p, I_HB2) + l * 64; const float* f2 = INP(p, I_HF2) + l * 64;
#pragma unroll 1
    for (int i = tid; i < 64 * 33; i += NT) { const int tt = i / 33, f = i % 33; const int tau = tb * 64 + tt;
        const float ang = (6.283185307179586f / (float)LX) * (float)tau; float v;
        if (f == 0) v = (float)tau / (float)(LX - 1);
        else { const int bi = (f - 1) & 15; const float band = 1e-4f + (float)bi * ((15.0f - 1e-4f) / 15.0f); const float a = band * ang; v = (f <= 16) ? cosf(a) : -sinf(a); }
        feats[i] = v; }
    __syncthreads();
#pragma unroll 1
    for (int i = tid; i < 64 * 64; i += NT) { const int tt = i >> 6, j = i & 63; float s = b1[j];
#pragma unroll 3
        for (int f = 0; f < 33; ++f) s += feats[tt * 33 + f] * w1[f * 64 + j];
        h1[tt * 65 + j] = sinf(f1[j] * s); }
    __syncthreads();
#pragma unroll 1
    for (int i = tid; i < 64 * 64; i += NT) { const int j = i >> 6, tt = i & 63; float s = b2[j];
#pragma unroll 4
        for (int f = 0; f < 64; ++f) s += h1[tt * 65 + f] * w2[f * 64 + j];
        dst[(size_t)j * SEQ + tt] = sinf(f2[j] * s); }
    __syncthreads();
}
constexpr int N_CTAPITEMS = (LCX / 64) * 8;
__device__ __forceinline__ void ctaps_item(const Params& p, int l, int it, float* smem) { taps_item(p, l, LCX, (float*)(WSP(p) + WS_TP) + TPC_OFF, it >> 3, it & 7, smem); }

__device__ __forceinline__ void phase_row(const Params& p, int l, int bid, int nb) {
    const int tid_ = otid(); const int lane = tid_ & 63, wave = tid_ >> 6;
    const float* MOD = (const float*)(WSP(p) + WS_MOD); const float* R = (const float*)(WSP(p) + WS_P);
    float* XC = (float*)(WSP(p) + WS_XC); bf16_t* H = (bf16_t*)(WSP(p) + WS_H);
    const int nrows = (l == DEPTH) ? NLAT : MROWS;
    for (int r = bid * 8 + wave; r < nrows; r += nb * 8) {
        const bool lat = r < NLAT; const int b = lat ? (r >> 12) : 0, t = r & 4095, rb = lat ? b : 2;
        const float* xin; float* xout;
        if (lat) { xin = ((l <= 1) ? INP(p, I_X) : OUTP(p)) + (size_t)r * DM; xout = OUTP(p) + (size_t)r * DM; }
        else { xin = ((l <= 1) ? INP(p, I_CTX) : XC) + (size_t)(r - NLAT) * DM; xout = XC + (size_t)(r - NLAT) * DM; }
        f32x4 x[8];
#pragma unroll
        for (int j = 0; j < 8; ++j) x[j] = *(const f32x4*)(xin + 4 * lane + 256 * j);
        if (l > 0) {
            const int lp = l - 1; const int rr = (lat && (lp & 1)) ? (b * SEQ + permtok(t)) : r;
            const float* Rr = R + (size_t)rr * DM; f32x4 v[8]; float ss = 0.f;
#pragma unroll
            for (int j = 0; j < 8; ++j) { v[j] = *(const f32x4*)(Rr + 4 * lane + 256 * j); ss += v[j][0] * v[j][0] + v[j][1] * v[j][1] + v[j][2] * v[j][2] + v[j][3] * v[j][3]; }
            const float rs = rsqrtf(wave_sum(ss) * (1.f / DM) + EPS);
            const float* gate = MOD + (size_t)(lp * 3 + rb) * 6144 + 4096; const float* gp = INP(p, I_GPOST) + lp * DM;
#pragma unroll
            for (int j = 0; j < 8; ++j) { const f32x4 g = *(const f32x4*)(gate + 4 * lane + 256 * j), w = *(const f32x4*)(gp + 4 * lane + 256 * j);
                x[j] = x[j] + g * (v[j] * rs * w); *(f32x4*)(xout + 4 * lane + 256 * j) = x[j]; }
        }
        if (l < DEPTH) {
            float ss = 0.f;
#pragma unroll
            for (int j = 0; j < 8; ++j) ss += x[j][0] * x[j][0] + x[j][1] * x[j][1] + x[j][2] * x[j][2] + x[j][3] * x[j][3];
            const float rs = rsqrtf(wave_sum(ss) * (1.f / DM) + EPS);
            const float* shift = MOD + (size_t)(l * 3 + rb) * 6144; const float* scale = shift + 2048; const float* gp = INP(p, I_GPRE) + l * DM;
            const int hr = (lat && (l & 1)) ? (b * SEQ + permtok(t)) : r;
            bf16_t* hrow = H + (size_t)hr * DM;
#pragma unroll
            for (int j = 0; j < 8; ++j) { const f32x4 sh = *(const f32x4*)(shift + 4 * lane + 256 * j), sc = *(const f32x4*)(scale + 4 * lane + 256 * j), w = *(const f32x4*)(gp + 4 * lane + 256 * j);
                const f32x4 y = (x[j] * rs * w) * (sc + 1.f) + sh; uint2 o; o.x = pk2(y[0], y[1]); o.y = pk2(y[2], y[3]);
                *(uint2*)(hrow + 4 * lane + 256 * j) = o; }
        }
    }
}

template <int LX, int NTT>
__device__ __forceinline__ void hy_naive_item(const Params& p, int l, const float* TP, const float* HTb, float* HOb, int c, float* smem) {
    const int tid = otid();
    float* tp = smem; float* vb = tp + 2 * LX; float* zb = vb + 2 * LX;
    const float* cw = INP(p, I_HCW) + (size_t)l * 3 * 1536; const float* cb = INP(p, I_HCB) + (size_t)l * 1536; const float* hd = INP(p, I_HD) + (size_t)l * 2 * 512;
#define SHORTC(dst, chan) do { const float w0 = cw[chan], w1 = cw[1536 + (chan)], w2 = cw[2 * 1536 + (chan)], bb = cb[chan]; \
        for (int i = tid; i < 2 * LX; i += NT) { const int b = i / LX, t = i % LX; const float* s = HTb + ((size_t)(b * 2048 + (chan))) * LX; \
            const float a = s[t > 0 ? t - 1 : 0], m = s[t], n = s[t < LX - 1 ? t + 1 : LX - 1]; dst[i] = w0 * (t > 0 ? a : 0.f) + w1 * m + w2 * (t < LX - 1 ? n : 0.f) + bb; } } while (0)
    for (int i = tid; i < 2 * LX; i += NT) tp[i] = (i < 2 * LX - 1) ? TP[(size_t)(0 * 512 + c) * (2 * LX) + i] : 0.f;
    SHORTC(vb, c);
    __syncthreads();
    float acc[2][NTT];
#pragma unroll
    for (int e = 0; e < NTT; ++e) { acc[0][e] = 0.f; acc[1][e] = 0.f; }
    for (int s = 0; s < LX; ++s) { const float v0 = vb[s], v1 = vb[LX + s];
#pragma unroll
        for (int e = 0; e < NTT; ++e) { const int t = tid + NT * e; if (t < LX) { const float w = tp[LX - 1 + t - s]; acc[0][e] += w * v0; acc[1][e] += w * v1; } } }
    __syncthreads();
    {
        const int ch = 512 + c; const float w0 = cw[ch], w1 = cw[1536 + ch], w2 = cw[2 * 1536 + ch], bb = cb[ch]; const float d0 = hd[c];
#pragma unroll
        for (int e = 0; e < NTT; ++e) { const int t = tid + NT * e; if (t < LX) {
#pragma unroll
            for (int b = 0; b < 2; ++b) { const float* s = HTb + ((size_t)(b * 2048 + ch)) * LX; const float a = s[t > 0 ? t - 1 : 0], m = s[t], n = s[t < LX - 1 ? t + 1 : LX - 1];
                const float x1 = w0 * (t > 0 ? a : 0.f) + w1 * m + w2 * (t < LX - 1 ? n : 0.f) + bb; zb[b * LX + t] = x1 * (acc[b][e] + d0 * vb[b * LX + t]); } } }
    }
    for (int i = tid; i < 2 * LX; i += NT) tp[i] = (i < 2 * LX - 1) ? TP[(size_t)(1 * 512 + c) * (2 * LX) + i] : 0.f;
    __syncthreads();
#pragma unroll
    for (int e = 0; e < NTT; ++e) { acc[0][e] = 0.f; acc[1][e] = 0.f; }
    for (int s = 0; s < LX; ++s) { const float v0 = zb[s], v1 = zb[LX + s];
#pragma unroll
        for (int e = 0; e < NTT; ++e) { const int t = tid + NT * e; if (t < LX) { const float w = tp[LX - 1 + t - s]; acc[0][e] += w * v0; acc[1][e] += w * v1; } } }
    {
        const int ch = 1024 + c; const float w0 = cw[ch], w1 = cw[1536 + ch], w2 = cw[2 * 1536 + ch], bb = cb[ch]; const float d1 = hd[512 + c];
#pragma unroll
        for (int e = 0; e < NTT; ++e) { const int t = tid + NT * e; if (t < LX) {
#pragma unroll
            for (int b = 0; b < 2; ++b) { const float* s = HTb + ((size_t)(b * 2048 + ch)) * LX; const float a = s[t > 0 ? t - 1 : 0], m = s[t], n = s[t < LX - 1 ? t + 1 : LX - 1];
                const float x2 = w0 * (t > 0 ? a : 0.f) + w1 * m + w2 * (t < LX - 1 ? n : 0.f) + bb; const float gt = HTb[((size_t)(b * 2048 + 1536 + c)) * LX + t];
                HOb[((size_t)(b * 512 + c)) * LX + t] = x2 * (acc[b][e] + d1 * zb[b * LX + t]) * silu_f(gt); } } }
    }
    __syncthreads();
#undef SHORTC
}
constexpr int N_POSTT = NB * 8 * (SEQ / 64) + NB * 8 * (LCX / 64);
__device__ __forceinline__ void phase_post(const Params& p, int l, int bid, int nb, float* tile) {
    const int tid = otid(), lane = tid & 63, wave = tid >> 6;
    const bf16_t* P16 = (const bf16_t*)(WSP(p) + WS_P); const bf16_t* OG = (const bf16_t*)(WSP(p) + WS_OG);
    bf16_t* YC = (bf16_t*)(WSP(p) + WS_YCAT);
    const float* gn = INP(p, I_GNORM) + l * 256;
    for (int r = bid * 8 + wave; r < MROWS; r += nb * 8) {
        const bf16_t* pr = P16 + (size_t)r * PP;
#pragma unroll
        for (int hh = 0; hh < 4; ++hh) { const int col = hh * 256 + 4 * lane;
            const uint2 of = *(const uint2*)(OG + (size_t)r * 1024 + col), ob = *(const uint2*)(OG + ((size_t)MROWS + r) * 1024 + col);
            const f32x4 o = {h2f_lo(of.x) + h2f_lo(ob.x), h2f_hi(of.x) + h2f_hi(ob.x), h2f_lo(of.y) + h2f_lo(ob.y), h2f_hi(of.y) + h2f_hi(ob.y)};
            const float rs = rsqrtf(wave_sum(o[0] * o[0] + o[1] * o[1] + o[2] * o[2] + o[3] * o[3]) * (1.f / 256.f) + EPS);
            const f32x4 w = *(const f32x4*)(gn + 4 * lane); const uint2 g2 = *(const uint2*)(pr + PGG + col);
            const float g[4] = {pg8::bf2f((unsigned short)(g2.x & 0xffff)), pg8::bf2f((unsigned short)(g2.x >> 16)), pg8::bf2f((unsigned short)(g2.y & 0xffff)), pg8::bf2f((unsigned short)(g2.y >> 16))};
            uint2 q; q.x = pk2(o[0] * rs * w[0] * silu_f(g[0]), o[1] * rs * w[1] * silu_f(g[1])); q.y = pk2(o[2] * rs * w[2] * silu_f(g[2]), o[3] * rs * w[3] * silu_f(g[3]));
            *(uint2*)(YC + (size_t)r * DM + col) = q; }
    }
    const float* HT = (const float*)(WSP(p) + WS_TP); const float* HTC = HT + HO_C;
    for (int it = bid; it < N_POSTT; it += nb) {
        const float* src; int LX, b, cb, tb, rbase;
        if (it < NB * 8 * (SEQ / 64)) { LX = SEQ; b = it / (8 * 64); const int q = it % (8 * 64); cb = q >> 6; tb = q & 63; src = HT; rbase = b * SEQ; }
        else { const int i2 = it - NB * 8 * (SEQ / 64); LX = LCX; b = i2 / (8 * 4); const int q = i2 % (8 * 4); cb = q >> 2; tb = q & 3; src = HTC; rbase = NLAT + b * LCX; }
#pragma unroll
        for (int j = 0; j < 8; ++j) { const int i = tid + NT * j, cc = i >> 6, tt = i & 63; tile[tt * 65 + cc] = src[((size_t)(b * 512 + cb * 64 + cc)) * LX + tb * 64 + tt]; }
        __syncthreads();
        { const int tt = tid >> 3, cq = tid & 7; const float* s = tile + tt * 65 + cq * 8;
          uint4 o; o.x = pk2(s[0], s[1]); o.y = pk2(s[2], s[3]); o.z = pk2(s[4], s[5]); o.w = pk2(s[6], s[7]);
          *(uint4*)(YC + (size_t)(rbase + tb * 64 + tt) * DM + 1536 + cb * 64 + cq * 8) = o; }
        __syncthreads();
    }
}
#define XB_TMO      128
#define XB_XCNT(j)  (256  + 64 * (j))
#define XB_XSUB(j)  (1280 + 64 * (j))
#define XB_XGEN(j)  (2304 + 64 * (j))
#define XB_TOP      3328
#define XB_TOPGEN   3392
#define XCD_BAR_WORDS 3456
#define XB_SPIN_CAP (1u << 22)

__device__ __forceinline__ unsigned xb_ld(unsigned* p)              { return __hip_atomic_load(p, __ATOMIC_RELAXED, __HIP_MEMORY_SCOPE_AGENT); }
__device__ __forceinline__ unsigned xb_add(unsigned* p, unsigned v) { return __hip_atomic_fetch_add(p, v, __ATOMIC_RELAXED, __HIP_MEMORY_SCOPE_AGENT); }
__device__ __forceinline__ unsigned xb_xcc_id() { return (unsigned)__builtin_amdgcn_s_getreg((3 << 11) | 20) & 0xFu; }
#define XB_SPIN(cond, bar) do { unsigned _sp = 0; while (cond) { __builtin_amdgcn_s_sleep(1); \
    if ((++_sp & 255u) == 0u) { if (xb_ld(&(bar)[XB_TMO])) break; if (_sp > XB_SPIN_CAP) { atomicAdd(&(bar)[XB_TMO], 1u); break; } } } } while (0)

struct XcdBarrier {
    unsigned* bar; unsigned x;
    volatile LAS unsigned* st;
};

__device__ __forceinline__ XcdBarrier xcd_barrier_post(unsigned* bar, volatile LAS unsigned* st) {
    XcdBarrier b; b.bar = bar; b.x = xb_xcc_id(); b.st = st;
    if (threadIdx.x == 0) (void)xb_add(&bar[XB_XCNT(b.x)], 1u);
    return b;
}
__device__ __forceinline__ void xcd_barrier_complete(unsigned* bar, unsigned x, unsigned& nloc, unsigned& nx) {
    const unsigned G = gridDim.x * gridDim.y * gridDim.z;
    unsigned sum, cnt, mine, sp = 0u;
    for (;;) {
        sum = 0u; cnt = 0u; mine = 0u;
#pragma unroll
        for (unsigned j = 0; j < 16; ++j) { const unsigned c = xb_ld(&bar[XB_XCNT(j)]); sum += c; cnt += (c > 0u) ? 1u : 0u; mine = (j == x) ? c : mine; }
        if (sum == G) break;
        __builtin_amdgcn_s_sleep(1);
        if ((++sp & 255u) == 0u) { if (xb_ld(&bar[XB_TMO])) break; if (sp > XB_SPIN_CAP) { atomicAdd(&bar[XB_TMO], 1u); break; } }
    }
    nloc = mine > 0u ? mine : 1u; nx = cnt > 0u ? cnt : 1u;
}

__device__ __forceinline__ void xcd_barrier(const XcdBarrier& b) {
    asm volatile("s_waitcnt vmcnt(0)" ::: "memory");
    __syncthreads();
    if (threadIdx.x == 0) {
        unsigned* bar = b.bar; asm volatile("" : "+s"(bar));
        __builtin_amdgcn_s_waitcnt(0);
        unsigned nloc = b.st[0], nx = b.st[1];
        if (nloc == 0u) { xcd_barrier_complete(bar, b.x, nloc, nx); b.st[0] = nloc; b.st[1] = nx; }
        const unsigned old = xb_add(&bar[XB_XSUB(b.x)], 1u);
        const unsigned gen = old / nloc;
        if (old + 1u == (gen + 1u) * nloc) {
            __builtin_amdgcn_fence(__ATOMIC_RELEASE, "agent");
            asm volatile("s_waitcnt vmcnt(0)" ::: "memory");
            const unsigned og = xb_add(&bar[XB_TOP], 1u);
            const unsigned tg = og / nx;
            if (og + 1u == (tg + 1u) * nx) xb_add(&bar[XB_TOPGEN], 1u);
            else XB_SPIN(xb_ld(&bar[XB_TOPGEN]) == tg, bar);
            __builtin_amdgcn_fence(__ATOMIC_ACQUIRE, "agent");
            xb_add(&bar[XB_XGEN(b.x)], 1u);
            asm volatile("s_waitcnt vmcnt(0)" ::: "memory");
        } else {
            XB_SPIN(xb_ld(&bar[XB_XGEN(b.x)]) == gen, bar);
            __builtin_amdgcn_fence(__ATOMIC_ACQUIRE, "agent");
            asm volatile("s_waitcnt vmcnt(0)" ::: "memory");
        }
    }
    __syncthreads();
}

typedef short bf16x8_t __attribute__((ext_vector_type(8)));
constexpr int NCH = 68;
constexpr size_t GLA_QT = 0;
constexpr size_t GLA_KT = GLA_QT + (size_t)2 * MROWS * 512 * 2;
constexpr size_t GLA_KDT = GLA_KT + (size_t)2 * MROWS * 512 * 2;
constexpr size_t GLA_VT = GLA_KDT + (size_t)2 * NB * 4 * NCH * 8192 * 2;
constexpr size_t GLA_AG = GLA_VT + (size_t)NB * 4 * NCH * 16384 * 2;
constexpr size_t GLA_BYTES = GLA_AG + (size_t)2 * NB * 4 * NCH * 128 * 4;
__device__ __forceinline__ int chunk_row0(int b, int ch) { return ch < 4 ? (NLAT + b * LCX + 64 * ch) : (b * SEQ + 64 * (ch - 4)); }

constexpr int N_GLAPREP = 2 * NB * 4 * NCH;
__device__ __forceinline__ void gla_prep_item(const Params& p, int l, int it0, float* smem) {
    const int tid = otid(); const int dir = it0 / (NB * 4 * NCH), it = it0 % (NB * 4 * NCH); const int b = it / (4 * NCH), h = (it / NCH) & 3, ch = it % NCH; const int row0 = chunk_row0(b, ch);
    const bf16_t* P16 = (const bf16_t*)(WSP(p) + WS_P); unsigned char* GB = WSP(p) + WS_GLA;
    float* lrs = smem;
    float* tot = lrs + 64 * 32;
    float* vtile = tot + 2 * 4 * 128;
    for (int i = tid; i < 64 * 32; i += NT) lrs[i] = pg8::bf2f(P16[(size_t)(row0 + (i >> 5)) * PP + PLR + (i & 31)]);
    if (dir == 0) {
#pragma unroll 16
    for (int j = 0; j < 32; ++j) { const int i = tid + NT * j, r = i >> 8, v = i & 255; vtile[r * 257 + v] = pg8::bf2f(P16[(size_t)(row0 + r) * PP + PV + h * 256 + v]); } }
    __syncthreads();
    const int k = tid & 127, seg = tid >> 7;
    float G[16];
    {
        float wg[16];
#pragma unroll
        for (int r = 0; r < 16; ++r) wg[r] = INP(p, I_GWG)[((size_t)(l * 2 + dir) * 16 + r) * 512 + h * 128 + k];
        const float bias = INP(p, I_GBG)[(l * 2 + dir) * 512 + h * 128 + k];
#pragma unroll
        for (int e = 0; e < 16; ++e) { const float* lr = lrs + (16 * seg + e) * 32 + dir * 16; float z = bias;
#pragma unroll
            for (int r = 0; r < 16; ++r) z += lr[r] * wg[r];
            G[e] = (fminf(z, 0.f) - log1pf(expf(-fabsf(z)))) * (1.f / 16.f); }
        if (dir == 0) {
#pragma unroll
            for (int e = 1; e < 16; ++e) G[e] += G[e - 1];
            tot[seg * 128 + k] = G[15];
        } else {
#pragma unroll
            for (int e = 14; e >= 0; --e) G[e] += G[e + 1];
            tot[seg * 128 + k] = G[0];
        }
    }
    __syncthreads();
    {
        float off = 0.f, glast = 0.f;
#pragma unroll
        for (int s = 0; s < 4; ++s) { const float t = tot[s * 128 + k]; glast += t; if (dir == 0 ? (s < seg) : (s > seg)) off += t; }
        bf16_t* QT = (bf16_t*)(GB + GLA_QT) + ((size_t)dir * MROWS + row0) * 512 + h * 128 + k;
        bf16_t* KT = (bf16_t*)(GB + GLA_KT) + ((size_t)dir * MROWS + row0) * 512 + h * 128 + k;
        unsigned kd[8];
#pragma unroll
        for (int e = 0; e < 16; e += 2) { float kdv[2];
#pragma unroll
            for (int u = 0; u < 2; ++u) { const int i = 16 * seg + e + u; const float g = G[e + u] + off;
                const float q = pg8::bf2f(P16[(size_t)(row0 + i) * PP + PQ + h * 128 + k]) * 0.08838834764831845f, kk = pg8::bf2f(P16[(size_t)(row0 + i) * PP + PK + h * 128 + k]);
                QT[(size_t)i * 512] = (bf16_t)(pk2(q * expf(g), 0.f) & 0xffff); KT[(size_t)i * 512] = (bf16_t)(pk2(kk * expf(-g), 0.f) & 0xffff);
                kdv[u] = kk * expf(glast - g); }
            kd[e >> 1] = pk2(kdv[0], kdv[1]); }
        bf16_t* KD = (bf16_t*)(GB + GLA_KDT) + ((((size_t)dir * NB + b) * 4 + h) * NCH + ch) * 8192 + k * 64 + 16 * seg;
        *(uint4*)KD = make_uint4(kd[0], kd[1], kd[2], kd[3]); *(uint4*)(KD + 8) = make_uint4(kd[4], kd[5], kd[6], kd[7]);
        if (seg == 0) ((float*)(GB + GLA_AG))[((((size_t)dir * NB + b) * 4 + h) * NCH + ch) * 128 + k] = expf(glast);
    }
    if (dir == 0) {
        const int v = tid >> 1, hf = tid & 1; bf16_t* VT = (bf16_t*)(GB + GLA_VT) + (((size_t)b * 4 + h) * NCH + ch) * 16384 + v * 64 + 32 * hf;
#pragma unroll
        for (int c = 0; c < 4; ++c) { const float* s = vtile + (32 * hf + 8 * c) * 257 + v;
            *(uint4*)(VT + 8 * c) = make_uint4(pk2(s[0], s[257]), pk2(s[2 * 257], s[3 * 257]), pk2(s[4 * 257], s[5 * 257]), pk2(s[6 * 257], s[7 * 257])); }
    }
    __syncthreads();
}

constexpr int GQP = 136, GVP = 72;
__device__ __forceinline__ bf16x8_t ldfrag(const bf16_t* base, int pitch, int row0, int k0, int lane) {
    return *(const bf16x8_t*)(base + (row0 + (lane & 15)) * pitch + k0 + (lane >> 4) * 8);
}
__device__ __forceinline__ void gla_seq_item(const Params& p, int it, bf16_t* lds) {
    const int tid = otid(), lane = tid & 63, w = tid >> 6;
    const int b = it >> 5, dir = (it >> 4) & 1, h = (it >> 2) & 3, vs = it & 3;
    unsigned char* GB = WSP(p) + WS_GLA; bf16_t* OG = (bf16_t*)(WSP(p) + WS_OG);
    bf16_t* Qs = lds; bf16_t* Ks = Qs + 64 * GQP; bf16_t* STs = Ks + 64 * GQP; bf16_t* KdTs = STs + 64 * GQP; bf16_t* VTs = KdTs + 128 * GVP; bf16_t* Ps = VTs + 64 * GVP;
    const bf16_t* QTg = (const bf16_t*)(GB + GLA_QT) + (size_t)dir * MROWS * 512 + h * 128;
    const bf16_t* KTg = (const bf16_t*)(GB + GLA_KT) + (size_t)dir * MROWS * 512 + h * 128;
    const bf16_t* KDg = (const bf16_t*)(GB + GLA_KDT) + (((size_t)dir * NB + b) * 4 + h) * NCH * 8192;
    const bf16_t* VTg = (const bf16_t*)(GB + GLA_VT) + ((size_t)b * 4 + h) * NCH * 16384 + vs * 64 * 64;
    const float* AGg = (const float*)(GB + GLA_AG) + (((size_t)dir * NB + b) * 4 + h) * NCH * 128;
    f32x4 S_[4];
#pragma unroll
    for (int i = 0; i < 4; ++i) S_[i] = (f32x4){0.f, 0.f, 0.f, 0.f};
    uint4 rqA0, rqA1, rkA0, rkA1, rdA0, rdA1, rvA; f32x4 anA;
    uint4 rqB0, rqB1, rkB0, rkB1, rdB0, rdB1, rvB; f32x4 anB;
#define GLA_LOAD(S, cs_) do { const int ch_ = dir ? ((cs_) < 4 ? 3 - (cs_) : 71 - (cs_)) : (cs_); const int r0_ = chunk_row0(b, ch_); const int e0_ = tid, e1_ = tid + NT; \
        rq##S##0 = *(const uint4*)(QTg + (size_t)(r0_ + (e0_ >> 4)) * 512 + (e0_ & 15) * 8); rq##S##1 = *(const uint4*)(QTg + (size_t)(r0_ + (e1_ >> 4)) * 512 + (e1_ & 15) * 8); \
        rk##S##0 = *(const uint4*)(KTg + (size_t)(r0_ + (e0_ >> 4)) * 512 + (e0_ & 15) * 8); rk##S##1 = *(const uint4*)(KTg + (size_t)(r0_ + (e1_ >> 4)) * 512 + (e1_ & 15) * 8); \
        rd##S##0 = *(const uint4*)(KDg + (size_t)ch_ * 8192 + e0_ * 8); rd##S##1 = *(const uint4*)(KDg + (size_t)ch_ * 8192 + e1_ * 8); \
        rv##S = *(const uint4*)(VTg + (size_t)ch_ * 16384 + tid * 8); an##S = *(const f32x4*)(AGg + ch_ * 128 + 16 * w + (lane >> 4) * 4); } while (0)
#define GLA_BODY(S, cs) do { \
        const int ch = dir ? ((cs) < 4 ? 3 - (cs) : 71 - (cs)) : (cs); const int r0 = chunk_row0(b, ch); \
        { const int e0 = tid, e1 = tid + NT; \
            *(uint4*)(Qs + (e0 >> 4) * GQP + (e0 & 15) * 8) = rq##S##0; *(uint4*)(Qs + (e1 >> 4) * GQP + (e1 & 15) * 8) = rq##S##1; \
            *(uint4*)(Ks + (e0 >> 4) * GQP + (e0 & 15) * 8) = rk##S##0; *(uint4*)(Ks + (e1 >> 4) * GQP + (e1 & 15) * 8) = rk##S##1; \
            *(uint4*)(KdTs + (e0 >> 3) * GVP + (e0 & 7) * 8) = rd##S##0; *(uint4*)(KdTs + (e1 >> 3) * GVP + (e1 & 7) * 8) = rd##S##1; } \
        *(uint4*)(VTs + (tid >> 3) * GVP + (tid & 7) * 8) = rv##S; \
        const f32x4 ac = an##S; \
        _Pragma("unroll") for (int vt = 0; vt < 4; ++vt) *(uint2*)(STs + (16 * vt + (lane & 15)) * GQP + 16 * w + (lane >> 4) * 4) = make_uint2(pk2(S_[vt][0], S_[vt][1]), pk2(S_[vt][2], S_[vt][3])); \
        __syncthreads(); \
        if ((cs) + 2 < NCH) GLA_LOAD(S, (cs) + 2); \
        const int st = w & 3, tt0 = 2 * (w >> 2); \
        { f32x4 c0 = {0.f, 0.f, 0.f, 0.f}, c1 = c0; \
          _Pragma("unroll") for (int ks = 0; ks < 4; ++ks) { const bf16x8_t a = ldfrag(Ks, GQP, 16 * st, 32 * ks, lane); \
              c0 = __builtin_amdgcn_mfma_f32_16x16x32_bf16(a, ldfrag(Qs, GQP, 16 * tt0, 32 * ks, lane), c0, 0, 0, 0); \
              c1 = __builtin_amdgcn_mfma_f32_16x16x32_bf16(a, ldfrag(Qs, GQP, 16 * tt0 + 16, 32 * ks, lane), c1, 0, 0, 0); } \
          const int s0 = 16 * st + (lane >> 4) * 4; \
          _Pragma("unroll") for (int u = 0; u < 2; ++u) { const f32x4 c = u ? c1 : c0; const int t = 16 * (tt0 + u) + (lane & 15); float m[4]; \
              _Pragma("unroll") for (int r = 0; r < 4; ++r) { const bool keep = dir ? (s0 + r > t) : (s0 + r <= t); m[r] = keep ? c[r] : 0.f; } \
              *(uint2*)(Ps + t * GVP + s0) = make_uint2(pk2(m[0], m[1]), pk2(m[2], m[3])); } } \
        f32x4 o0 = {0.f, 0.f, 0.f, 0.f}, o1 = o0; \
        _Pragma("unroll") for (int ks = 0; ks < 4; ++ks) { const bf16x8_t a = ldfrag(STs, GQP, 16 * st, 32 * ks, lane); \
            o0 = __builtin_amdgcn_mfma_f32_16x16x32_bf16(a, ldfrag(Qs, GQP, 16 * tt0, 32 * ks, lane), o0, 0, 0, 0); \
            o1 = __builtin_amdgcn_mfma_f32_16x16x32_bf16(a, ldfrag(Qs, GQP, 16 * tt0 + 16, 32 * ks, lane), o1, 0, 0, 0); } \
        _Pragma("unroll") for (int vt = 0; vt < 4; ++vt) { S_[vt][0] *= ac[0]; S_[vt][1] *= ac[1]; S_[vt][2] *= ac[2]; S_[vt][3] *= ac[3]; } \
        _Pragma("unroll") for (int ks = 0; ks < 2; ++ks) { const bf16x8_t a = ldfrag(KdTs, GVP, 16 * w, 32 * ks, lane); \
            _Pragma("unroll") for (int vt = 0; vt < 4; ++vt) S_[vt] = __builtin_amdgcn_mfma_f32_16x16x32_bf16(a, ldfrag(VTs, GVP, 16 * vt, 32 * ks, lane), S_[vt], 0, 0, 0); } \
        __syncthreads(); \
        _Pragma("unroll") for (int ks = 0; ks < 2; ++ks) { const bf16x8_t a = ldfrag(VTs, GVP, 16 * st, 32 * ks, lane); \
            o0 = __builtin_amdgcn_mfma_f32_16x16x32_bf16(a, ldfrag(Ps, GVP, 16 * tt0, 32 * ks, lane), o0, 0, 0, 0); \
            o1 = __builtin_amdgcn_mfma_f32_16x16x32_bf16(a, ldfrag(Ps, GVP, 16 * tt0 + 16, 32 * ks, lane), o1, 0, 0, 0); } \
        { bf16_t* og = OG + ((size_t)dir * MROWS + r0 + 16 * tt0 + (lane & 15)) * 1024 + h * 256 + vs * 64 + 16 * st + (lane >> 4) * 4; \
          *(uint2*)og = make_uint2(pkh2(o0[0], o0[1]), pkh2(o0[2], o0[3])); *(uint2*)(og + 16 * 1024) = make_uint2(pkh2(o1[0], o1[1]), pkh2(o1[2], o1[3])); } \
        __syncthreads(); } while (0)
    GLA_LOAD(A, 0); GLA_LOAD(B, 1);
#pragma unroll 1
    for (int cs = 0; cs < NCH; cs += 2) { GLA_BODY(A, cs); GLA_BODY(B, cs + 1); }
#undef GLA_BODY
#undef GLA_LOAD
}
#ifndef FFT_HD
#define FFT_HD __device__ __forceinline__
#endif
#define PADI(i) ((i) + ((i) >> 5))
constexpr int FFT_N = 8192, FFT_BUF = FFT_N + FFT_N / 32, FFT_TW = 2048 + 512 + 128 + 32 + 8;
struct __attribute__((aligned(8))) cf { float x, y; };
FFT_HD cf cmul(cf a, cf b) { return cf{a.x * b.x - a.y * b.y, a.x * b.y + a.y * b.x}; }
FFT_HD cf cmulc(cf a, cf b) { return cf{a.x * b.x + a.y * b.y, a.y * b.x - a.x * b.y}; }
FFT_HD cf cadd(cf a, cf b) { return cf{a.x + b.x, a.y + b.y}; }
FFT_HD cf csub(cf a, cf b) { return cf{a.x - b.x, a.y - b.y}; }
FFT_HD int fft_twoff(int s) { return s == 0 ? 0 : s == 1 ? 2048 : s == 2 ? 2560 : s == 3 ? 2688 : 2720; }
template <bool INV> FFT_HD void fft_stage4(cf* buf, const cf* tw, int s, int tid) {
    const int lq = 11 - 2 * s, q4 = 1 << lq; const cf* t = tw + fft_twoff(s);
#pragma unroll
    for (int e = 0; e < 4; ++e) {
        const int bf = tid + 512 * e, blk = bf >> lq, j = bf & (q4 - 1), base = (blk << (lq + 2)) + j;
        const int i0 = PADI(base), i1 = PADI(base + q4), i2 = PADI(base + 2 * q4), i3 = PADI(base + 3 * q4);
        const cf w1 = t[j], w2 = cmul(w1, w1), w3 = cmul(w2, w1);
        cf x0 = buf[i0], x1 = buf[i1], x2 = buf[i2], x3 = buf[i3];
        if (INV) { x1 = cmulc(x1, w1); x2 = cmulc(x2, w2); x3 = cmulc(x3, w3); }
        const cf a = cadd(x0, x2), b = csub(x0, x2), c = cadd(x1, x3), d = csub(x1, x3);
        cf y0 = cadd(a, c), y2 = csub(a, c), y1, y3;
        if (!INV) { y1 = cf{b.x + d.y, b.y - d.x}; y3 = cf{b.x - d.y, b.y + d.x}; y1 = cmul(y1, w1); y2 = cmul(y2, w2); y3 = cmul(y3, w3); }
        else      { y1 = cf{b.x - d.y, b.y + d.x}; y3 = cf{b.x + d.y, b.y - d.x}; }
        buf[i0] = y0; buf[i1] = y1; buf[i2] = y2; buf[i3] = y3;
    }
}
template <bool INV> FFT_HD void fft_last8(cf* buf, int tid) {
    const float h = 0.70710678118654752f;
    const cf w[2][4] = {{{1.f, 0.f}, {1.f, 0.f}, {1.f, 0.f}, {1.f, 0.f}}, {{1.f, 0.f}, {h, -h}, {0.f, -1.f}, {-h, -h}}};
#pragma unroll
    for (int e = 0; e < 2; ++e) {
        const int base = PADI((tid + 512 * e) * 8); cf x[8];
#pragma unroll
        for (int i = 0; i < 8; ++i) x[i] = buf[base + i];
        if (!INV) {
#pragma unroll
            for (int j = 0; j < 2; ++j) { const cf a = cadd(x[j], x[j + 4]), b = csub(x[j], x[j + 4]), c = cadd(x[j + 2], x[j + 6]), d = csub(x[j + 2], x[j + 6]);
                x[j] = cadd(a, c); x[j + 2] = cmul(cf{b.x + d.y, b.y - d.x}, w[j][1]); x[j + 4] = cmul(csub(a, c), w[j][2]); x[j + 6] = cmul(cf{b.x - d.y, b.y + d.x}, w[j][3]); }
#pragma unroll
            for (int m = 0; m < 4; ++m) { const cf a = x[2 * m], b = x[2 * m + 1]; x[2 * m] = cadd(a, b); x[2 * m + 1] = csub(a, b); }
        } else {
#pragma unroll
            for (int m = 0; m < 4; ++m) { const cf a = x[2 * m], b = x[2 * m + 1]; x[2 * m] = cadd(a, b); x[2 * m + 1] = csub(a, b); }
#pragma unroll
            for (int j = 0; j < 2; ++j) { const cf u0 = x[j], u1 = cmulc(x[j + 2], w[j][1]), u2 = cmulc(x[j + 4], w[j][2]), u3 = cmulc(x[j + 6], w[j][3]);
                const cf a = cadd(u0, u2), b = csub(u0, u2), c = cadd(u1, u3), d = csub(u1, u3);
                x[j] = cadd(a, c); x[j + 4] = csub(a, c); x[j + 2] = cf{b.x - d.y, b.y + d.x}; x[j + 6] = cf{b.x + d.y, b.y - d.x}; }
        }
#pragma unroll
        for (int i = 0; i < 8; ++i) buf[base + i] = x[i];
    }
}

constexpr int HY_TW_OFF = 27136;
__device__ __forceinline__ void hy_twiddles(float* smem) {
    cf* tw = (cf*)(smem + HY_TW_OFF); const int tid = otid();
    for (int i = tid; i < FFT_TW; i += NT) { int s = 0, j = i; if (i >= 2720) { s = 4; j = i - 2720; } else if (i >= 2688) { s = 3; j = i - 2688; } else if (i >= 2560) { s = 2; j = i - 2560; } else if (i >= 2048) { s = 1; j = i - 2048; }
        const int Ls = 8192 >> (2 * s); float sn, cs; sincospif(-2.0f * (float)j / (float)Ls, &sn, &cs); tw[i] = cf{cs, sn}; }
    __syncthreads();
}
template <bool INV> __device__ __forceinline__ void hy_fft(cf* buf, const cf* tw, int tid) {
    if (!INV) {
#pragma unroll 1
        for (int s = 0; s < 5; ++s) { fft_stage4<false>(buf, tw, s, tid); __syncthreads(); }
        fft_last8<false>(buf, tid); __syncthreads();
    } else {
        fft_last8<true>(buf, tid); __syncthreads();
#pragma unroll 1
        for (int s = 4; s >= 0; --s) { fft_stage4<true>(buf, tw, s, tid); __syncthreads(); }
    }
}
__device__ __forceinline__ int fft_pos2freq(int p) {
    return ((p >> 11) & 3) | (((p >> 9) & 3) << 2) | (((p >> 7) & 3) << 4) | (((p >> 5) & 3) << 6) | (((p >> 3) & 3) << 8) | (((p >> 1) & 3) << 10) | ((p & 1) << 12);
}
__device__ __forceinline__ int fft_freq2pos(int k) {
    return ((k & 3) << 11) | (((k >> 2) & 3) << 9) | (((k >> 4) & 3) << 7) | (((k >> 6) & 3) << 5) | (((k >> 8) & 3) << 3) | (((k >> 10) & 3) << 1) | ((k >> 12) & 1);
}
__device__ __forceinline__ void hy_spec2_item(const Params& p, int l, int c, float* smem) {
    const int tid = otid(); cf* buf = (cf*)smem; float* w3c = smem + 2 * FFT_BUF; const cf* tw = (const cf*)(smem + HY_TW_OFF);
    const float* w3 = INP(p, I_HW3) + (size_t)l * 64 * 2048; const float* H2 = (const float*)(WSP(p) + WS_H2) + (size_t)l * 64 * SEQ; cf* HS = (cf*)(WSP(p) + WS_HS);
    if (tid < 256) { const int q = tid & 3, i = tid >> 2; w3c[i * 4 + q] = w3[(size_t)i * 2048 + (q >> 1) * 1024 + (q & 1) * 512 + c]; }
    const float delta = fabsf(-15.350567286626973f + (float)c * ((-3.0701134573253945f + 15.350567286626973f) / 511.0f));
    __syncthreads();
#pragma unroll 1
    for (int e = 0; e < 2; ++e) { const int tau0 = 4 * tid + 2048 * e; const float* hc = H2 + tau0;
        float t[4][4];
#pragma unroll
        for (int u = 0; u < 4; ++u) { t[u][0] = 0.f; t[u][1] = 0.f; t[u][2] = 0.f; t[u][3] = 0.f; }
#pragma unroll 16
        for (int i = 0; i < 64; ++i) { const f32x4 hv = *(const f32x4*)(hc + (size_t)i * SEQ); const f32x4 wv = *(const f32x4*)(w3c + 4 * i);
#pragma unroll
            for (int u = 0; u < 4; ++u) { t[u][0] += hv[u] * wv[0]; t[u][1] += hv[u] * wv[1]; t[u][2] += hv[u] * wv[2]; t[u][3] += hv[u] * wv[3]; } }
#pragma unroll
        for (int u = 0; u < 4; ++u) { const int tau = tau0 + u; const float dec = expf(-((float)tau / (float)(SEQ - 1)) * delta);
            buf[PADI(tau)] = cf{t[u][0] * dec, t[u][2] * dec};
            buf[PADI((8192 - tau) & 8191 ? 8192 - tau : 4096)] = (tau == 0) ? cf{0.f, 0.f} : cf{t[u][1] * dec, t[u][3] * dec}; } }
    __syncthreads();
    hy_fft<false>(buf, tw, tid);
#pragma unroll 4
    for (int e = 0; e < 16; ++e) { const int pp = tid + NT * e; const int p2 = fft_freq2pos((8192 - fft_pos2freq(pp)) & 8191);
        const cf F = buf[PADI(pp)], G = buf[PADI(p2)]; const float s = 0.5f / 8192.f;
        HS[(size_t)c * 8192 + pp] = cf{(F.x + G.x) * s, (F.y - G.y) * s};
        HS[(size_t)(512 + c) * 8192 + pp] = cf{(F.y + G.y) * s, -(F.x - G.x) * s}; }
    __syncthreads();
}
__device__ __forceinline__ float hy_short(const float* s, int t, float w0, float w1, float w2, float bb) {
    const float a = s[t > 0 ? t - 1 : 0], m = s[t], n = s[t < SEQ - 1 ? t + 1 : SEQ - 1];
    return w0 * (t > 0 ? a : 0.f) + w1 * m + w2 * (t < SEQ - 1 ? n : 0.f) + bb;
}
__device__ __forceinline__ void hy_fft_item(const Params& p, int l, int c, float* smem) {
    const int tid = otid(); cf* buf = (cf*)smem; const cf* tw = (const cf*)(smem + HY_TW_OFF);
    const float* HT = (const float*)(WSP(p) + WS_HT); float* HO = (float*)(WSP(p) + WS_TP); const cf* HS = (const cf*)(WSP(p) + WS_HS);
    const float* cw = INP(p, I_HCW) + (size_t)l * 3 * 1536; const float* cb = INP(p, I_HCB) + (size_t)l * 1536; const float* hd = INP(p, I_HD) + (size_t)l * 2 * 512;
    float v0[8], v1[8];
    { const float w0 = cw[c], w1 = cw[1536 + c], w2 = cw[2 * 1536 + c], bb = cb[c]; const float* s0 = HT + (size_t)c * SEQ; const float* s1 = HT + (size_t)(2048 + c) * SEQ;
#pragma unroll
      for (int e = 0; e < 8; ++e) { const int t = tid + NT * e; v0[e] = hy_short(s0, t, w0, w1, w2, bb); v1[e] = hy_short(s1, t, w0, w1, w2, bb);
          buf[PADI(t)] = cf{v0[e], v1[e]}; buf[PADI(4096 + t)] = cf{0.f, 0.f}; } }
    cf hreg[16];
    { const cf* H = HS + (size_t)c * 8192;
#pragma unroll
      for (int e = 0; e < 16; ++e) hreg[e] = H[tid + NT * e]; }
    __syncthreads();
    hy_fft<false>(buf, tw, tid);
#pragma unroll
    for (int e = 0; e < 16; ++e) { const int i = tid + NT * e; buf[PADI(i)] = cmul(buf[PADI(i)], hreg[e]); }
    float z0[8], z1[8];
    { const int ch = 512 + c; const float w0 = cw[ch], w1 = cw[1536 + ch], w2 = cw[2 * 1536 + ch], bb = cb[ch];
      const float* s0 = HT + (size_t)ch * SEQ; const float* s1 = HT + (size_t)(2048 + ch) * SEQ;
#pragma unroll
      for (int e = 0; e < 8; ++e) { const int t = tid + NT * e; z0[e] = hy_short(s0, t, w0, w1, w2, bb); z1[e] = hy_short(s1, t, w0, w1, w2, bb); } }
    __syncthreads();
    hy_fft<true>(buf, tw, tid);
    { const float d0 = hd[c];
#pragma unroll
      for (int e = 0; e < 8; ++e) { const int t = tid + NT * e; const cf y = buf[PADI(t)]; z0[e] *= (y.x + d0 * v0[e]); z1[e] *= (y.y + d0 * v1[e]); } }
    __syncthreads();
#pragma unroll
    for (int e = 0; e < 8; ++e) { const int t = tid + NT * e; buf[PADI(t)] = cf{z0[e], z1[e]}; buf[PADI(4096 + t)] = cf{0.f, 0.f}; }
    { const cf* H = HS + (size_t)(512 + c) * 8192;
#pragma unroll
      for (int e = 0; e < 16; ++e) hreg[e] = H[tid + NT * e]; }
    __syncthreads();
    hy_fft<false>(buf, tw, tid);
#pragma unroll
    for (int e = 0; e < 16; ++e) { const int i = tid + NT * e; buf[PADI(i)] = cmul(buf[PADI(i)], hreg[e]); }
    { const int ch = 1024 + c; const float w0 = cw[ch], w1 = cw[1536 + ch], w2 = cw[2 * 1536 + ch], bb = cb[ch];
      const float* s0 = HT + (size_t)ch * SEQ; const float* s1 = HT + (size_t)(2048 + ch) * SEQ;
      const float* g0 = HT + (size_t)(1536 + c) * SEQ; const float* g1 = HT + (size_t)(2048 + 1536 + c) * SEQ;
#pragma unroll
      for (int e = 0; e < 8; ++e) { const int t = tid + NT * e; v0[e] = hy_short(s0, t, w0, w1, w2, bb) * silu_f(g0[t]); v1[e] = hy_short(s1, t, w0, w1, w2, bb) * silu_f(g1[t]); } }
    __syncthreads();
    hy_fft<true>(buf, tw, tid);
    { const float d1 = hd[512 + c];
#pragma unroll
      for (int e = 0; e < 8; ++e) { const int t = tid + NT * e; const cf y = buf[PADI(t)];
          HO[(size_t)c * SEQ + t] = v0[e] * (y.x + d1 * z0[e]); HO[(size_t)(512 + c) * SEQ + t] = v1[e] * (y.y + d1 * z1[e]); } }
    __syncthreads();
}


constexpr size_t S5W_WA = 0;
constexpr size_t S5W_KW = S5W_WA + (size_t)32 * 2 * 128 * 256 * 2;
constexpr size_t S5W_L16 = S5W_KW + (size_t)32 * 256 * 512 * 2;
constexpr size_t S5W_XI = S5W_L16 + (size_t)32 * 2 * 64 * 2 * 4;
constexpr size_t S5W_BYTES = S5W_XI + (size_t)32 * NB * 272 * 256 * 2;
__device__ __forceinline__ int s5_row(int b, int n, int s) { return n < 16 ? (NLAT + b * LCX + 16 * n + s) : (b * SEQ + 16 * (n - 16) + s); }

__device__ __forceinline__ void s5_weights_item(const Params& p, int l, int g, float* smem) {
    const int tid = otid();
    cf* pw = (cf*)smem;
    cf* Bb = pw + 2 * 17 * 64;
    cf* Cc = Bb + 2 * 64 * 16;
    float* KT = (float*)(Cc + 2 * 16 * 64);
    float* dsk = KT + 2 * 16 * 256;
    if (tid < 16) dsk[tid] = INP(p, I_S5D)[l * 512 + g * 16 + tid];
    unsigned char* WB = WSP(p) + WS_S5W;
    for (int i = tid; i < 2 * 17 * 64; i += NT) { const int d = i / (17 * 64), e = (i / 64) % 17, q = i & 63; const size_t pg = ((size_t)(l * 2 + d) * 32 + g);
        const float lr = INP(p, I_LRE)[pg * 64 + q], li = INP(p, I_LIM)[pg * 64 + q], step = expf(INP(p, I_LSTEP)[pg]);
        const float em = expf((float)e * lr * step); float sn, cs; sincosf((float)e * li * step, &sn, &cs); pw[i] = cf{em * cs, em * sn}; }
    for (int i = tid; i < 2 * 64 * 16; i += NT) { const int d = i >> 10, q = (i >> 4) & 63, hh = i & 15; const size_t pg = ((size_t)(l * 2 + d) * 32 + g);
        const float lr = INP(p, I_LRE)[pg * 64 + q], li = INP(p, I_LIM)[pg * 64 + q], step = expf(INP(p, I_LSTEP)[pg]);
        const float em1 = expm1f(lr * step); float sn, cs; sincosf(li * step, &sn, &cs); const float shf = sinf(0.5f * li * step);
        const float nr = em1 * cs - 2.f * shf * shf, ni = (em1 + 1.f) * sn, den = lr * lr + li * li;
        const float cr = (nr * lr + ni * li) / den, ci = (ni * lr - nr * li) / den;
        const float br = INP(p, I_BRE)[(pg * 64 + q) * 16 + hh], bi = INP(p, I_BIM)[(pg * 64 + q) * 16 + hh];
        Bb[i] = cf{cr * br - ci * bi, cr * bi + ci * br}; }
    for (int i = tid; i < 2 * 16 * 64; i += NT) { const int d = i >> 10; const size_t pg = ((size_t)(l * 2 + d) * 32 + g); Cc[i] = cf{INP(p, I_CRE)[pg * 1024 + (i & 1023)], INP(p, I_CIM)[pg * 1024 + (i & 1023)]}; }
    __syncthreads();
    if (tid < 128) { const int d = tid >> 6, q = tid & 63; const cf v = pw[(d * 17 + 16) * 64 + q]; float* L16 = (float*)(WB + S5W_L16) + ((size_t)g * 2 + d) * 128 + 2 * q; L16[0] = v.x; L16[1] = v.y; }
#pragma unroll 1
    for (int i = tid; i < 2 * 16 * 256; i += NT) { const int d = i >> 12, tau = (i >> 8) & 15, hp = (i >> 4) & 15, hh = i & 15; float s = 0.f;
#pragma unroll 4
        for (int q = 0; q < 64; ++q) { const cf m = cmul(cmul(Cc[(d * 16 + hp) * 64 + q], pw[(d * 17 + tau) * 64 + q]), Bb[(d * 64 + q) * 16 + hh]); s += m.x; }
        KT[i] = s; }
    __syncthreads();
    bf16_t* WA = (bf16_t*)(WB + S5W_WA) + (size_t)g * 2 * 128 * 256; bf16_t* KW = (bf16_t*)(WB + S5W_KW) + (size_t)g * 256 * 512;
#pragma unroll 1
    for (int i = tid; i < 2 * 128 * 256 / 2; i += NT) { const int i2 = 2 * i; const int d = i2 >> 15, rq = (i2 >> 8) & 127, col = i2 & 255; const int ri = rq >> 6, q = rq & 63, s = col >> 4, hh = col & 15;
        const int e = d ? s : 15 - s; const cf w = pw[(d * 17 + e) * 64 + q]; const cf m0 = cmul(w, Bb[(d * 64 + q) * 16 + hh]), m1 = cmul(w, Bb[(d * 64 + q) * 16 + hh + 1]);
        *(unsigned*)(WA + i2) = pk2(ri ? m0.y : m0.x, ri ? m1.y : m1.x); }
#pragma unroll 1
    for (int i = tid; i < 256 * 512 / 2; i += NT) { const int i2 = 2 * i; const int row = i2 >> 9, col = i2 & 511; const int t = row >> 4, hp = row & 15; float v[2];
#pragma unroll
        for (int u = 0; u < 2; ++u) { const int c = col + u;
            if (c < 256) { const int s = c >> 4, hh = c & 15; float a = 0.f; if (s <= t) a += KT[(0 * 16 + (t - s)) * 256 + hp * 16 + hh]; if (s >= t) a += KT[(1 * 16 + (s - t)) * 256 + hp * 16 + hh];
                if (s == t && hh == hp) a += dsk[hp]; v[u] = a; }
            else { const int c2 = c - 256, d = c2 >> 7, ri = (c2 >> 6) & 1, q = c2 & 63; const int e = d ? 16 - t : t + 1; const cf m = cmul(Cc[(d * 16 + hp) * 64 + q], pw[(d * 17 + e) * 64 + q]); v[u] = ri ? -m.y : m.x; } }
        *(unsigned*)(KW + i2) = pk2(v[0], v[1]); }
    __syncthreads();
}

constexpr int S5P = 520;
__device__ __forceinline__ uint4 s5_fetch_u(const bf16_t* P16, int b, int g, int mt, int tid) {
    const int row = tid >> 5, part = tid & 31, s = part >> 1, h8 = (part & 1) * 8; return *(const uint4*)(P16 + (size_t)s5_row(b, 16 * mt + row, s) * PP + PU + 16 * g + h8);
}
__device__ __forceinline__ void s5_store_u(bf16_t* At, int tid, const uint4 v) {
    const int row = tid >> 5, part = tid & 31, s = part >> 1, h8 = (part & 1) * 8; *(uint4*)(At + row * S5P + 16 * s + h8) = v;
}
__device__ __forceinline__ void s5_item(const Params& p, int it, float* smem) {
    const int tid = otid(), lane = tid & 63, w = tid >> 6; const int g = it >> 1, b = it & 1;
    const bf16_t* P16 = (const bf16_t*)(WSP(p) + WS_P); unsigned char* WB = WSP(p) + WS_S5W; bf16_t* YG = (bf16_t*)(WSP(p) + WS_YG);
    bf16_t* At = (bf16_t*)smem;
    float* Et = smem + (16 * S5P) / 2;
    bf16_t* XI = (bf16_t*)(WB + S5W_XI) + ((size_t)g * NB + b) * 272 * 256;
#pragma unroll 1
    for (int d = 0; d < 2; ++d) {
        const bf16_t* WA = (const bf16_t*)(WB + S5W_WA) + ((size_t)g * 2 + d) * 128 * 256;
        bf16x8_t bfr[8];
#pragma unroll
        for (int ks = 0; ks < 8; ++ks) bfr[ks] = *(const bf16x8_t*)(WA + (size_t)(16 * w + (lane & 15)) * 256 + 32 * ks + (lane >> 4) * 8);
        float xr = 0.f, xi = 0.f, l16r = 0.f, l16i = 0.f;
        if (tid < 64) { const float* L16 = (const float*)(WB + S5W_L16) + ((size_t)g * 2 + d) * 128 + 2 * tid; l16r = L16[0]; l16i = L16[1]; }
        uint4 uv = s5_fetch_u(P16, b, g, 0, tid);
#pragma unroll 1
        for (int k = 0; k < 17; ++k) {
            const int mt = d ? (k == 0 ? 0 : 17 - k) : k;
            s5_store_u(At, tid, uv);
            __syncthreads();
            if (k + 1 < 17) uv = s5_fetch_u(P16, b, g, d ? 16 - k : k + 1, tid);
            f32x4 acc = {0.f, 0.f, 0.f, 0.f};
#pragma unroll
            for (int ks = 0; ks < 8; ++ks) acc = __builtin_amdgcn_mfma_f32_16x16x32_bf16(ldfrag(At, S5P, 0, 32 * ks, lane), bfr[ks], acc, 0, 0, 0);
#pragma unroll
            for (int r = 0; r < 4; ++r) Et[((lane >> 4) * 4 + r) * 132 + 16 * w + (lane & 15)] = acc[r];
            __syncthreads();
            if (tid < 64) { float er[16], ei[16];
#pragma unroll
                for (int i = 0; i < 16; ++i) { const int m = d ? 15 - i : i; er[i] = Et[m * 132 + tid]; ei[i] = Et[m * 132 + 64 + tid]; }
#pragma unroll
                for (int i = 0; i < 16; ++i) { const int m = d ? 15 - i : i; bf16_t* xo = XI + (size_t)(16 * mt + m) * 256 + d * 128 + tid;
                    xo[0] = (bf16_t)(pk2(xr, 0.f) & 0xffff); xo[64] = (bf16_t)(pk2(xi, 0.f) & 0xffff);
                    const float nr = l16r * xr - l16i * xi + er[i], ni = l16r * xi + l16i * xr + ei[i]; xr = nr; xi = ni; }
            }
            __syncthreads();
        }
    }
    {
        const bf16_t* KW = (const bf16_t*)(WB + S5W_KW) + (size_t)g * 256 * 512;
        bf16x8_t bw[2][16];
#pragma unroll
        for (int u = 0; u < 2; ++u)
#pragma unroll
            for (int ks = 0; ks < 16; ++ks) bw[u][ks] = *(const bf16x8_t*)(KW + (size_t)(32 * w + 16 * u + (lane & 15)) * 512 + 32 * ks + (lane >> 4) * 8);
        uint4 uv = s5_fetch_u(P16, b, g, 0, tid); uint4 xv; xv = *(const uint4*)(XI + (size_t)(tid >> 5) * 256 + (tid & 31) * 8);
#pragma unroll 1
        for (int mt = 0; mt < 17; ++mt) {
            s5_store_u(At, tid, uv);
            *(uint4*)(At + (tid >> 5) * S5P + 256 + (tid & 31) * 8) = xv;
            __syncthreads();
            if (mt + 1 < 17) { uv = s5_fetch_u(P16, b, g, mt + 1, tid); xv = *(const uint4*)(XI + (size_t)(16 * (mt + 1) + (tid >> 5)) * 256 + (tid & 31) * 8); }
            f32x4 a0 = {0.f, 0.f, 0.f, 0.f}, a1 = a0;
#pragma unroll
            for (int ks = 0; ks < 16; ++ks) { const bf16x8_t af = ldfrag(At, S5P, 0, 32 * ks, lane);
                a0 = __builtin_amdgcn_mfma_f32_16x16x32_bf16(af, bw[0][ks], a0, 0, 0, 0); a1 = __builtin_amdgcn_mfma_f32_16x16x32_bf16(af, bw[1][ks], a1, 0, 0, 0); }
#pragma unroll
            for (int r = 0; r < 4; ++r) { const int n = 16 * mt + (lane >> 4) * 4 + r;
                YG[(size_t)s5_row(b, n, 2 * w) * 512 + 16 * g + (lane & 15)] = (bf16_t)(pk2(gelu_tanh(a0[r]), 0.f) & 0xffff);
                YG[(size_t)s5_row(b, n, 2 * w + 1) * 512 + 16 * g + (lane & 15)] = (bf16_t)(pk2(gelu_tanh(a1[r]), 0.f) & 0xffff); }
            __syncthreads();
        }
    }
}


__device__ __forceinline__ void phase_inproj(const Params& p, int l, int bid, int nb, LAS unsigned char* lds) {
    pg8::Gemm g{(const bf16_t*)(WSP(p) + WS_H), (const bf16_t*)(WSP(p) + WS_WIN) + (size_t)l * NINP * DM, MROWS, NINP, DM};
    pg8::StaticOrder S; S.init(MROWS, NINP, nb, bid);
    float* HT = (float*)(WSP(p) + WS_HT);
    pg8::EpiIn E{(bf16_t*)(WSP(p) + WS_P), PP, HT, HT + (size_t)NB * 2048 * SEQ};
    pg8::gemm_phase<pg8::EpiIn, pg8::StaticOrder, true, true>(lds, g, S, E);
}
__device__ __forceinline__ void phase_glu(const Params& p, int l, int bid, int nb, LAS unsigned char* lds) {
    pg8::Gemm g{(const bf16_t*)(WSP(p) + WS_YG), (const bf16_t*)(WSP(p) + WS_WGLU) + (size_t)l * 512 * 512, MROWS, 512, 512};
    pg8::StaticOrder S; S.init(MROWS, 512, nb, bid);
    pg8::EpiGlu E{(const bf16_t*)(WSP(p) + WS_YG), (const bf16_t*)(WSP(p) + WS_P) + PSG, PP, INP(p, I_BGLU) + l * 512, (bf16_t*)(WSP(p) + WS_YCAT) + 1024, DM};
    pg8::gemm_phase<pg8::EpiGlu, pg8::StaticOrder, true, true>(lds, g, S, E);
}
__device__ __forceinline__ void phase_outproj(const Params& p, int l, int bid, int nb, LAS unsigned char* lds) {
    pg8::Gemm g{(const bf16_t*)(WSP(p) + WS_YCAT), (const bf16_t*)(WSP(p) + WS_WOUT) + (size_t)l * DM * DM, MROWS, DM, DM};
    pg8::StaticOrder S; S.init(MROWS, DM, nb, bid);
    pg8::EpiF32 E{(float*)(WSP(p) + WS_P), DM};
    pg8::gemm_phase<pg8::EpiF32, pg8::StaticOrder, true, true>(lds, g, S, E);
}

static_assert(GLA_BYTES <= (size_t)72 * 1000 * 1000 && S5W_BYTES <= (size_t)22 * 1000 * 1000 && WS_END <= (size_t)800 * 1000 * 1000, "workspace map");
constexpr int LDS_BYTES = 147456;
namespace cg = cooperative_groups;
#ifndef REP_PHASE
#define REP_PHASE -1
#endif
#if REP_PHASE < 0
#define REPEAT(k)
#else
#define REPEAT(k) for (int rep_ = 0; rep_ < ((REP_PHASE == (k)) ? 2 : 1); ++rep_)
#endif

#define QCTR(k) ((unsigned*)(WSP(p) + WS_CTL + 13824) + 32 * (k))
#define QSLOT ((volatile LAS unsigned*)((LAS unsigned char*)lds + 131072 + 128))
#define WQUEUE_A(ln) do { unsigned* qctr_ = QCTR(4 + (ln)); volatile LAS unsigned* qs_ = QSLOT; hy_twiddles(smem); \
        for (;;) { __syncthreads(); if (threadIdx.x == 0) qs_[0] = atomicAdd(qctr_, 1u); __syncthreads(); const unsigned item_ = qs_[0]; if (item_ >= 576u) break; \
            REPEAT(90) { if (item_ < 32u) s5_weights_item(p, (ln), (int)item_, smem); else if (item_ < 64u) ctaps_item(p, (ln), (int)item_ - 32, smem); else hy_spec2_item(p, (ln), (int)item_ - 64, smem); } } } while (0)
#define WQUEUE_B(ln) do { unsigned* qctr_ = QCTR(8 + (ln)); volatile LAS unsigned* qs_ = QSLOT; \
        for (;;) { __syncthreads(); if (threadIdx.x == 0) qs_[0] = atomicAdd(qctr_, 1u); __syncthreads(); const unsigned item_ = qs_[0]; if (item_ >= (unsigned)(N_MODITEMS + N_TITEMS)) break; \
            REPEAT(91) { if (item_ < (unsigned)N_MODITEMS) mod_item(p, (ln), (int)item_, smem); else weights_item(p, (ln), (int)item_ - N_MODITEMS, smem); } } } while (0)
__global__ void __launch_bounds__(NT, 2) k_mega(Params p) {
    extern __shared__ __attribute__((aligned(16))) unsigned char lds[];
    cg::grid_group grid = cg::this_grid();
    float* smem = (float*)lds;
    volatile LAS unsigned* bst = (volatile LAS unsigned*)((LAS unsigned char*)lds + 131072 + 64);
    if (threadIdx.x == 0) { bst[0] = 0u; bst[1] = 0u; }
    __syncthreads();
    const XcdBarrier xbar = xcd_barrier_post((unsigned*)(WSP(p) + WS_CTL), bst);
    { const int bid = blockIdx.x, nb = gridDim.x;
      REPEAT(0) { for (int it0 = bid; it0 < DEPTH * (N_TITEMS + N_MODITEMS + N_H2ITEMS); it0 += nb) {
            const int ll = it0 / (N_TITEMS + N_MODITEMS + N_H2ITEMS), it = it0 % (N_TITEMS + N_MODITEMS + N_H2ITEMS);
            if (it < N_TITEMS) weights_item(p, ll, it, smem); else if (it < N_TITEMS + N_MODITEMS) mod_item(p, ll, it - N_TITEMS, smem); else h2_item(p, ll * N_H2ITEMS + it - N_TITEMS - N_MODITEMS, smem); } } }
    grid.sync();
#pragma unroll 1
    for (int l0 = 0; l0 < DEPTH; ++l0) {
        int l = l0; asm volatile("" : "+s"(l));
        int bid = blockIdx.x, nb = gridDim.x; asm volatile("" : "+s"(bid), "+s"(nb));
        phase_row(p, l, bid, nb);
        if (l == 0) WQUEUE_A(0);
        xcd_barrier(xbar);
        REPEAT(2) phase_inproj(p, l, bid, nb, (LAS unsigned char*)lds);
        xcd_barrier(xbar);
        REPEAT(4) for (int it = bid; it < N_GLAPREP; it += nb) gla_prep_item(p, l, it, smem);
        xcd_barrier(xbar);
        if (bid < 64) { REPEAT(60) gla_seq_item(p, bid, (bf16_t*)lds); }
        else if (bid < 128) { REPEAT(61) s5_item(p, bid - 64, smem); }
        {
            unsigned* qctr = QCTR(l); volatile LAS unsigned* qs = QSLOT;
            hy_twiddles(smem);
            const float* HTC = (const float*)(WSP(p) + WS_HT) + (size_t)NB * 2048 * SEQ; float* HOb = (float*)(WSP(p) + WS_TP);
            for (;;) {
                __syncthreads();
                if (threadIdx.x == 0) qs[0] = atomicAdd(qctr, 1u);
                __syncthreads();
                const unsigned item = qs[0];
                if (item >= 1024u) break;
                REPEAT(62) { if (item < 512u) hy_fft_item(p, l, (int)item, smem);
                else hy_naive_item<LCX, 1>(p, l, HOb + TPC_OFF, HTC, HOb + HO_C, (int)item - 512, smem); }
            }
        }
        xcd_barrier(xbar);
        REPEAT(6) phase_glu(p, l, bid, nb, (LAS unsigned char*)lds);
        REPEAT(7) phase_post(p, l, bid, nb, smem);
        xcd_barrier(xbar);
        REPEAT(8) phase_outproj(p, l, bid, nb, (LAS unsigned char*)lds);
        if (l + 1 < DEPTH) WQUEUE_A(l + 1);
        xcd_barrier(xbar);
    }
    phase_row(p, DEPTH, blockIdx.x, gridDim.x);
}

extern "C" void kernel_launch(void* const* d_in, const int* in_sizes, int n_in, void* d_out, int out_size, void* d_ws, size_t ws_size, hipStream_t stream) {
    if (n_in != 33 || out_size != NLAT * DM || ws_size < WS_END) { fprintf(stderr, "kernel_launch: unexpected problem (n_in %d out %d ws %zu need %zu)\n", n_in, out_size, ws_size, (size_t)WS_END); return; }
    Params p{};
    for (int i = 0; i < 33; ++i) p.in[i] = (const float*)d_in[i];
    p.out = (float*)d_out; p.ws = (unsigned char*)d_ws;
    static int grid_blocks = 0;
    if (!grid_blocks) {
        int dev = 0, cus = 0, per_cu = 0;
        (void)hipGetDevice(&dev);
        (void)hipDeviceGetAttribute(&cus, hipDeviceAttributeMultiprocessorCount, dev);
        (void)hipFuncSetAttribute((const void*)k_mega, hipFuncAttributeMaxDynamicSharedMemorySize, LDS_BYTES);
        (void)hipOccupancyMaxActiveBlocksPerMultiprocessor(&per_cu, (const void*)k_mega, NT, LDS_BYTES);
        if (per_cu < 1) { fprintf(stderr, "kernel_launch: occupancy query says %d blocks per CU\n", per_cu); per_cu = 1; }
        grid_blocks = cus;
        fprintf(stderr, "kernel_launch: cus %d per_cu %d grid %d\n", cus, per_cu, grid_blocks);
    }
    (void)hipMemsetAsync((unsigned char*)d_ws + WS_CTL, 0, CTL_BYTES, stream);
    void* args[] = {&p};
    hipError_t e = hipLaunchCooperativeKernel((const void*)k_mega, dim3(grid_blocks), dim3(NT), args, LDS_BYTES, stream);
    if (e != hipSuccess) fprintf(stderr, "cooperative launch failed: %s (grid %d)\n", hipGetErrorString(e), grid_blocks);
}
```

```cpp
#include <hip/hip_runtime.h>
#include <hip/hip_cooperative_groups.h>
#include <cstdio>
#include <cstdint>
#include <cmath>
namespace pg8 {
#define PG8_LAS __attribute__((address_space(3)))
typedef unsigned short bf16_t;
typedef short bf16x8 __attribute__((ext_vector_type(8)));
typedef float f32x4 __attribute__((ext_vector_type(4)));
typedef unsigned u32x4 __attribute__((ext_vector_type(4)));
constexpr int BM = 256, BK = 64, HALF = 128, HTB = HALF * BK * 2  , STAGE_BYTES = 8 * HTB, NXCD = 8, WGM = 8;

__host__ __device__ __forceinline__ int lds_byte(int r, int c) { const int st = (r >> 4) * 2 + (c >> 5), rr = r & 15, cc = c & 31, ob = rr * 64 + cc * 2; return st * 1024 + (ob ^ (((ob >> 9) & 1) << 5)); }
__host__ __device__ __forceinline__ void stage_rc(int b, int& R, int& C) { const int st = b / 1024, sb = b % 1024, swz = sb ^ (((sb >> 9) & 1) << 5); R = (st >> 1) * 16 + swz / 64; C = (st & 1) * 32 + (swz % 64) / 2; }
__host__ __device__ __forceinline__ int perm32(int rho) { const int n = rho >> 4, i = rho & 15; return 8 * (i >> 2) + 4 * n + (i & 3); }

struct Unit { int pm, pn; };
struct Gemm { const bf16_t* A; const bf16_t* Bt; int M, N, K; };

struct StaticOrder {
    int nM, nN, nwg, G, c;
    __host__ __device__ void init(int M, int N, int G_, int c_) { nM = M / BM; nN = N / BM; nwg = nM * nN; G = G_; c = c_; }
    __host__ __device__ bool next(int i, Unit& u) const {
        const long L = (long)i * G + c; if (L >= nwg) return false;
        int wgid = (int)L; { const int q = nwg / NXCD, r = nwg % NXCD, xcd = wgid % NXCD, off = wgid / NXCD; wgid = (xcd < r ? xcd * (q + 1) : r * (q + 1) + (xcd - r) * q) + off; }
        const int nig = WGM * nN, gid = wgid / nig, fm = gid * WGM, gsz = (nM - fm) < WGM ? (nM - fm) : WGM;
        u.pm = fm + ((wgid % nig) % gsz); u.pn = (wgid % nig) / gsz; return true;
    }
    __device__ __forceinline__ void a_ready(const Unit&) const {}
    __device__ __forceinline__ void done(const Unit&) const {}
};


__device__ __forceinline__ unsigned cvt_pk_bf16(float lo, float hi) { unsigned r; asm volatile("v_cvt_pk_bf16_f32 %0, %1, %2" : "=v"(r) : "v"(lo), "v"(hi)); return r; }
__device__ __forceinline__ float bf2f(unsigned short h) { return __builtin_bit_cast(float, (unsigned)h << 16); }
typedef _Float16 f16x8 __attribute__((ext_vector_type(8)));
typedef _Float16 f16x2 __attribute__((ext_vector_type(2)));
__device__ __forceinline__ unsigned pk_f16(float lo, float hi) { f16x2 v = {(_Float16)lo, (_Float16)hi}; return __builtin_bit_cast(unsigned, v); }
__device__ __forceinline__ float f16lo(unsigned u) { return (float)__builtin_bit_cast(f16x2, u)[0]; }
__device__ __forceinline__ float f16hi(unsigned u) { return (float)__builtin_bit_cast(f16x2, u)[1]; }

struct EpiF32 {
    static constexpr bool PERM = false, AFTER_DRAIN = false;
    float* O; int ldc;
    __device__ __forceinline__ void operator()(const f32x4 (&acc)[2][2][4][2], const Unit& u, int wr, int wc, int fr, int fq) const {
        const int row0 = u.pm * BM + wr * 64 + fr, col0 = u.pn * BM + wc * 32 + 4 * fq;
#pragma unroll
        for (int ai = 0; ai < 2; ++ai)
#pragma unroll
            for (int m = 0; m < 4; ++m) { float* rowp = O + (size_t)(row0 + ai * HALF + m * 16) * ldc + col0;
#pragma unroll
                for (int bj = 0; bj < 2; ++bj)
#pragma unroll
                    for (int n = 0; n < 2; ++n) *(f32x4*)(rowp + bj * HALF + n * 16) = acc[ai][bj][m][n]; }
    }
};
struct EpiIn {
    static constexpr bool PERM = false, AFTER_DRAIN = false;
    bf16_t* P16; int pp; float* HT; float* HTC;
    __device__ __forceinline__ void operator()(const f32x4 (&acc)[2][2][4][2], const Unit& u, int wr, int wc, int fr, int fq) const {
        const int row0 = u.pm * BM + wr * 64 + fr;
        if (u.pn < 16 || u.pn == 24) {
            const int col0 = (u.pn < 16 ? u.pn : 16) * BM + wc * 32 + 4 * fq;
#pragma unroll
            for (int ai = 0; ai < 2; ++ai)
#pragma unroll
                for (int m = 0; m < 4; ++m) { bf16_t* rowp = P16 + (size_t)(row0 + ai * HALF + m * 16) * pp + col0;
#pragma unroll
                    for (int bj = 0; bj < 2; ++bj)
#pragma unroll
                        for (int n = 0; n < 2; ++n) { const f32x4 a = acc[ai][bj][m][n]; uint2 w; w.x = pk_f16(a[0], a[1]); w.y = pk_f16(a[2], a[3]); *(uint2*)(rowp + bj * HALF + n * 16) = w; } }
        } else {
            const int ch0 = (u.pn - 16) * BM + wc * 32 + 4 * fq; float* base; int lx, t0;
            if (u.pm < 32) { const int b = u.pm >> 4; lx = 4096; t0 = (u.pm & 15) * BM + wr * 64 + fr; base = HT + (size_t)b * 2048 * 4096; }
            else { const int b = u.pm - 32; lx = 256; t0 = wr * 64 + fr; base = HTC + (size_t)b * 2048 * 256; }
#pragma unroll
            for (int ai = 0; ai < 2; ++ai)
#pragma unroll
                for (int m = 0; m < 4; ++m) { const int t = t0 + ai * HALF + m * 16;
#pragma unroll
                    for (int bj = 0; bj < 2; ++bj)
#pragma unroll
                        for (int n = 0; n < 2; ++n) { const f32x4 a = acc[ai][bj][m][n]; float* d = base + (size_t)(ch0 + bj * HALF + n * 16) * lx + t;
                            d[0] = a[0]; d[lx] = a[1]; d[2 * (size_t)lx] = a[2]; d[3 * (size_t)lx] = a[3]; } }
        }
    }
};
struct EpiGlu {
    static constexpr bool PERM = false, AFTER_DRAIN = false;
    const bf16_t* YG; const bf16_t* Psg; int ldp; const float* bg; bf16_t* Y; int ldy;
    __device__ __forceinline__ void operator()(const f32x4 (&acc)[2][2][4][2], const Unit& u, int wr, int wc, int fr, int fq) const {
        const int row0 = u.pm * BM + wr * 64 + fr, col0 = u.pn * BM + wc * 32 + 4 * fq;
#pragma unroll
        for (int ai = 0; ai < 2; ++ai)
#pragma unroll
            for (int m = 0; m < 4; ++m) { const size_t row = (size_t)(row0 + ai * HALF + m * 16);
#pragma unroll
                for (int bj = 0; bj < 2; ++bj)
#pragma unroll
                    for (int n = 0; n < 2; ++n) { const int col = col0 + bj * HALF + n * 16;
                        const f32x4 a = acc[ai][bj][m][n]; const f32x4 b = *(const f32x4*)(bg + col); const uint2 s2 = *(const uint2*)(Psg + row * ldp + col);
                        const float sg[4] = {f16lo(s2.x), f16hi(s2.x), f16lo(s2.y), f16hi(s2.y)};
                        const uint2 y2 = *(const uint2*)(YG + row * 512 + col);
                        float yv[4] = {f16lo(y2.x), f16hi(y2.x), f16lo(y2.y), f16hi(y2.y)};
                        float o[4];
#pragma unroll
                        for (int e = 0; e < 4; ++e) { const float z = a[e] + b[e]; const float s = 1.f / (1.f + __expf(-z)); const float g = sg[e]; const float sl = g / (1.f + __expf(-g)); o[e] = yv[e] * s * sl; }
                        uint2 w; w.x = pk_f16(o[0], o[1]); w.y = pk_f16(o[2], o[3]);
                        *(uint2*)(Y + row * ldy + col) = w; } }
    }
};
template <class Epi, class Sched, bool ALIGN_EPI = false, bool SP2 = false>
__device__ __forceinline__ void gemm_phase(PG8_LAS unsigned char* lds, const Gemm g, const Sched& S, const Epi& E) {
    int tid_o = threadIdx.x; asm volatile("" : "+v"(tid_o)); const int tid = tid_o, wid = __builtin_amdgcn_readfirstlane(tid >> 6), lane = tid & 63, wr = wid >> 2, wc = wid & 3, fr = lane & 15, fq = lane >> 4;
    const int K = g.K, nt = K / BK;
    unsigned voffA[2], voffB[2];
#pragma unroll
    for (int i = 0; i < 2; ++i) { int R, C; stage_rc(tid * 16 + i * 8192, R, C); const int Rb = Epi::PERM ? ((R & ~31) + perm32(R & 31)) : R;
        voffA[i] = (unsigned)(R * K + C) * 2u; voffB[i] = (unsigned)(Rb * K + C) * 2u; }
    const size_t kstep = (size_t)(BK * 2);
    const size_t hstep = (size_t)HALF * K * 2;
    const size_t tstep = 2 * hstep;
    const unsigned ldsw = (unsigned)wid * 1024u;
    const int aoff = lds_byte(wr * 64 + fr, fq * 8), boff = lds_byte(wc * 32 + fr, fq * 8);
#define PG8_SA(b, h) (((b) * 2 + (h)) * HTB)
#define PG8_SB(b, h) ((4 + (b) * 2 + (h)) * HTB)
#define PG8_STAGE(bufoff, gbase, voff) do { _Pragma("unroll") for (int _i = 0; _i < 2; ++_i) \
        __builtin_amdgcn_global_load_lds((const unsigned*)((const char*)(gbase) + (voff)[_i]), (PG8_LAS unsigned*)(lds + (bufoff) + ldsw + _i * 8192), 16, 0, 0); } while (0)
#define PG8_LDA(dst, b, h) do { _Pragma("unroll") for (int m = 0; m < 4; ++m) _Pragma("unroll") for (int k = 0; k < 2; ++k) dst[m][k] = *(const PG8_LAS bf16x8*)(lds + PG8_SA(b, h) + aoff + m * 2048 + k * 1024); } while (0)
#define PG8_LDB(dst, b, h) do { _Pragma("unroll") for (int n = 0; n < 2; ++n) _Pragma("unroll") for (int k = 0; k < 2; ++k) dst[n][k] = *(const PG8_LAS bf16x8*)(lds + PG8_SB(b, h) + boff + n * 2048 + k * 1024); } while (0)
#define PG8_MMA(ai, bj, At, Bt) do { __builtin_amdgcn_s_setprio(1); _Pragma("unroll") for (int m = 0; m < 4; ++m) _Pragma("unroll") for (int n = 0; n < 2; ++n) _Pragma("unroll") for (int k = 0; k < 2; ++k) \
        acc[ai][bj][m][n] = __builtin_amdgcn_mfma_f32_16x16x32_f16(__builtin_bit_cast(f16x8, Bt[n][k]), __builtin_bit_cast(f16x8, At[m][k]), acc[ai][bj][m][n], 0, 0, 0); __builtin_amdgcn_s_setprio(0); } while (0)
#define PG8_WAIT_V(n) asm volatile("s_waitcnt vmcnt(" #n ")" ::: "memory")
#define PG8_WAIT_L(n) asm volatile("s_waitcnt lgkmcnt(" #n ")" ::: "memory")
#define PG8_BAR __builtin_amdgcn_s_barrier()
#define PG8_SCHED __builtin_amdgcn_sched_barrier(0)
    Unit cur, nxt; int ui = 0;
    if (!S.next(0, cur)) return;
    f32x4 acc[2][2][4][2];
#pragma unroll
    for (int a = 0; a < 2; ++a)
#pragma unroll
        for (int b = 0; b < 2; ++b)
#pragma unroll
            for (int m = 0; m < 4; ++m)
#pragma unroll
                for (int n = 0; n < 2; ++n) acc[a][b][m][n] = (f32x4){0.f, 0.f, 0.f, 0.f};
    bf16x8 At[4][2], B0[2][2], B1[2][2];
    const char* cA = (const char*)g.A + (size_t)cur.pm * tstep; const char* cB = (const char*)g.Bt + (size_t)cur.pn * tstep;
    S.a_ready(cur);
    if constexpr (SP2) {
        PG8_STAGE(PG8_SB(0, 0), cB, voffB); PG8_STAGE(PG8_SB(0, 1), cB + hstep, voffB); PG8_STAGE(PG8_SA(0, 0), cA, voffA); PG8_STAGE(PG8_SA(0, 1), cA + hstep, voffA);
        if (wr == 1) PG8_BAR;
        PG8_WAIT_V(2); PG8_BAR;
        PG8_STAGE(PG8_SB(1, 0), cB + kstep, voffB); PG8_STAGE(PG8_SA(1, 0), cA + kstep, voffA); PG8_STAGE(PG8_SB(1, 1), cB + hstep + kstep, voffB);
        PG8_WAIT_V(6); PG8_BAR;
    } else {
        PG8_STAGE(PG8_SB(0, 0), cB, voffB); PG8_STAGE(PG8_SA(0, 0), cA, voffA); PG8_STAGE(PG8_SB(0, 1), cB + hstep, voffB); PG8_STAGE(PG8_SA(0, 1), cA + hstep, voffA);
        if (wr == 1) PG8_BAR;
        PG8_WAIT_V(4); PG8_BAR;
        PG8_STAGE(PG8_SB(1, 0), cB + kstep, voffB); PG8_STAGE(PG8_SA(1, 0), cA + kstep, voffA); PG8_STAGE(PG8_SB(1, 1), cB + hstep + kstep, voffB);
        PG8_WAIT_V(6); PG8_BAR;
    }
    for (;;) {
        const bool has_next = S.next(ui + 1, nxt);
        const char* nA = has_next ? (const char*)g.A + (size_t)nxt.pm * tstep : cA; const char* nB = has_next ? (const char*)g.Bt + (size_t)nxt.pn * tstep : cB;
        for (int t = 0; t < nt; t += 2) {
            const bool last = (t == nt - 2);
            const char* a1 = cA + (size_t)(t + 1) * kstep;
            const char* a2 = last ? nA : cA + (size_t)(t + 2) * kstep; const char* b2 = last ? nB : cB + (size_t)(t + 2) * kstep;
            const char* a3 = a2 + kstep; const char* b3 = b2 + kstep;
            if (last && has_next) S.a_ready(nxt);
            if constexpr (SP2) {
            PG8_LDB(B0, 0, 0); PG8_LDB(B1, 0, 1); PG8_SCHED; PG8_LDA(At, 0, 0); PG8_STAGE(PG8_SA(1, 1), a1 + hstep, voffA);
            PG8_WAIT_V(8); PG8_WAIT_L(0); PG8_BAR; PG8_MMA(0, 0, At, B0); PG8_MMA(0, 1, At, B1); PG8_BAR; PG8_SCHED;
            PG8_LDA(At, 0, 1); PG8_STAGE(PG8_SB(0, 0), b2, voffB); PG8_STAGE(PG8_SB(0, 1), b2 + hstep, voffB); PG8_STAGE(PG8_SA(0, 0), a2, voffA);
            PG8_WAIT_V(8); PG8_WAIT_L(0); PG8_BAR; PG8_MMA(1, 0, At, B0); PG8_MMA(1, 1, At, B1); PG8_BAR; PG8_SCHED;
            PG8_LDB(B0, 1, 0); PG8_LDB(B1, 1, 1); PG8_SCHED; PG8_LDA(At, 1, 0); PG8_STAGE(PG8_SA(0, 1), a2 + hstep, voffA);
            PG8_WAIT_V(8); PG8_WAIT_L(0); PG8_BAR; PG8_MMA(0, 0, At, B0); PG8_MMA(0, 1, At, B1); PG8_BAR; PG8_SCHED;
            PG8_LDA(At, 1, 1); PG8_STAGE(PG8_SB(1, 0), b3, voffB); PG8_STAGE(PG8_SB(1, 1), b3 + hstep, voffB); PG8_STAGE(PG8_SA(1, 0), a3, voffA);
            PG8_WAIT_V(8); PG8_WAIT_L(0); PG8_BAR; PG8_MMA(1, 0, At, B0); PG8_MMA(1, 1, At, B1); PG8_BAR; PG8_SCHED;
            } else {
            PG8_LDB(B0, 0, 0); PG8_SCHED; PG8_LDA(At, 0, 0); PG8_STAGE(PG8_SA(1, 1), a1 + hstep, voffA);
            PG8_WAIT_L(8); PG8_BAR; PG8_WAIT_L(0); PG8_MMA(0, 0, At, B0); PG8_BAR; PG8_SCHED;
            PG8_LDB(B1, 0, 1); PG8_STAGE(PG8_SB(0, 0), b2, voffB);
            PG8_BAR; PG8_WAIT_L(0); PG8_MMA(0, 1, At, B1); PG8_BAR;
            PG8_LDA(At, 0, 1); PG8_STAGE(PG8_SA(0, 0), a2, voffA);
            PG8_BAR; PG8_WAIT_L(0); PG8_MMA(1, 0, At, B0); PG8_BAR; PG8_SCHED;
            PG8_STAGE(PG8_SB(0, 1), b2 + hstep, voffB);
            PG8_WAIT_V(6); PG8_BAR; PG8_MMA(1, 1, At, B1); PG8_BAR;
            PG8_LDB(B0, 1, 0); PG8_SCHED; PG8_LDA(At, 1, 0); PG8_STAGE(PG8_SA(0, 1), a2 + hstep, voffA);
            PG8_WAIT_L(8); PG8_BAR; PG8_WAIT_L(0); PG8_MMA(0, 0, At, B0); PG8_BAR; PG8_SCHED;
            PG8_LDB(B1, 1, 1); PG8_STAGE(PG8_SB(1, 0), b3, voffB);
            PG8_BAR; PG8_WAIT_L(0); PG8_MMA(0, 1, At, B1); PG8_BAR;
            PG8_LDA(At, 1, 1); PG8_STAGE(PG8_SA(1, 0), a3, voffA);
            PG8_BAR; PG8_WAIT_L(0); PG8_MMA(1, 0, At, B0); PG8_BAR; PG8_SCHED;
            PG8_STAGE(PG8_SB(1, 1), b3 + hstep, voffB);
            PG8_WAIT_V(6); PG8_BAR; PG8_MMA(1, 1, At, B1); PG8_BAR;
            }
        }
        if constexpr (ALIGN_EPI) { if (wr == 0) PG8_BAR; }
        if constexpr (!Epi::AFTER_DRAIN) { E(acc, cur, wr, wc, fr, fq); S.done(cur); }
        if (!has_next) break;
#pragma unroll
        for (int a = 0; a < 2; ++a)
#pragma unroll
            for (int b = 0; b < 2; ++b)
#pragma unroll
                for (int m = 0; m < 4; ++m)
#pragma unroll
                    for (int n = 0; n < 2; ++n) acc[a][b][m][n] = (f32x4){0.f, 0.f, 0.f, 0.f};
        cur = nxt; cA = nA; cB = nB; ++ui;
        if constexpr (ALIGN_EPI) { if (wr == 1) PG8_BAR; }
    }
    PG8_WAIT_V(0);
    if constexpr (!ALIGN_EPI) { if (wr == 0) PG8_BAR; }
    PG8_BAR;
    if constexpr (Epi::AFTER_DRAIN) { E.fused(acc, cur, wr, wc, fr, fq, lds, wid, lane); S.done(cur); }
#undef PG8_SA
#undef PG8_SB
#undef PG8_STAGE
#undef PG8_LDA
#undef PG8_LDB
#undef PG8_MMA
#undef PG8_WAIT_V
#undef PG8_WAIT_L
#undef PG8_BAR
#undef PG8_SCHED
}
}

using pg8::bf16_t; using pg8::f32x4;
#define LAS __attribute__((address_space(3)))
constexpr int DM = 2048, NB = 2, SEQ = 4096, LCX = 256, DEPTH = 4;
constexpr int NLAT = NB * SEQ;
constexpr int MROWS = NLAT + NB * LCX;
constexpr int NIN = 6176, NINP = 6400;
constexpr int PQ = 0, PK = 512, PV = 1024, PU = 2048, PGG = 2560, PSG = 3584, PLR = 4096, PP = 4352;
constexpr float EPS = 1e-6f;
constexpr int NT = 512;

__host__ __device__ __forceinline__ int in_col_map(int n) {
    if (n < 2048) return n;
    if (n < 6144) return n + 32;
    if (n < 6176) return n - 4096;
    return -1;
}

constexpr size_t al256(size_t x) { return (x + 255) & ~(size_t)255; }
constexpr size_t WS_WIN  = 0;
constexpr size_t WS_WOUT = WS_WIN  + al256((size_t)DEPTH * NINP * DM * 2);
constexpr size_t WS_WGLU = WS_WOUT + al256((size_t)DEPTH * DM * DM * 2);
constexpr size_t WS_MOD  = WS_WGLU + al256((size_t)DEPTH * 512 * 512 * 2);
constexpr size_t WS_H    = WS_MOD  + al256((size_t)DEPTH * 3 * 6144 * 4);
constexpr size_t WS_YCAT = WS_H    + al256((size_t)MROWS * DM * 2);
constexpr size_t WS_P    = WS_YCAT + al256((size_t)MROWS * DM * 2);
constexpr size_t WS_XC   = WS_P    + al256((size_t)MROWS * PP * 2);
static_assert((size_t)MROWS * PP * 2 >= (size_t)MROWS * DM * 4, "R aliases P16");
constexpr size_t WS_OG   = WS_XC   + al256((size_t)NB * LCX * DM * 4);
constexpr size_t WS_YS5  = WS_OG   + al256((size_t)2 * MROWS * 1024 * 4);
constexpr size_t WS_YG   = WS_YS5  + al256((size_t)MROWS * 512 * 4);
constexpr size_t WS_HT   = WS_YG   + al256((size_t)MROWS * 512 * 2);
constexpr size_t WS_TP   = WS_HT   + al256((size_t)MROWS * 2048 * 4);
constexpr size_t HO_C = (size_t)2 * 512 * SEQ, TPC_OFF = HO_C + (size_t)2 * 512 * LCX;
constexpr size_t TPC_SLOT = (size_t)2 * 512 * 2 * LCX;
constexpr size_t WS_HS   = WS_TP   + al256((TPC_OFF + 2 * TPC_SLOT) * 4);
constexpr size_t HS_SLOT = (size_t)2 * 512 * 8192;
constexpr size_t WS_H2   = WS_HS   + al256(2 * HS_SLOT * 8);
constexpr size_t WS_GLA  = WS_H2   + al256((size_t)DEPTH * SEQ * 64 * 4);
constexpr size_t WS_S5W  = WS_GLA  + al256((size_t)72 * 1000 * 1000);
constexpr size_t WS_CTL  = WS_S5W  + al256((size_t)36 * 1000 * 1000);
constexpr size_t CTL_BYTES = 16384;
constexpr size_t WS_END  = WS_CTL  + CTL_BYTES;

struct Params {
    const float* in[33];
    float* out;
    unsigned char* ws;
};

#define KARG_AS __attribute__((address_space(4)))
__device__ __forceinline__ const void* karg_ptr(int byte_off) {
    asm volatile("" : "+s"(byte_off));
    const KARG_AS char* ka = (const KARG_AS char*)__builtin_amdgcn_kernarg_segment_ptr();
    return *(void* const KARG_AS*)(ka + byte_off);
}
#define INP(p, i) ((const float*)karg_ptr(8 * (i)))
#define OUTP(p) ((float*)karg_ptr(8 * 33))
#define WSP(p) ((unsigned char*)karg_ptr(8 * 34))
static_assert(sizeof(Params) == 35 * 8, "Params layout: in[33], out, ws");
enum { I_X = 0, I_C, I_CTX, I_CCTX, I_WMOD, I_BMOD, I_GPRE, I_GPOST, I_WIN, I_WOUT, I_GWG, I_GBG, I_GNORM,
       I_LRE, I_LIM, I_LSTEP, I_BRE, I_BIM, I_CRE, I_CIM, I_S5D, I_WGLU, I_BGLU, I_HCW, I_HCB, I_HW1, I_HB1, I_HF1, I_HW2, I_HB2, I_HF2, I_HW3, I_HD };

__device__ __forceinline__ float wave_sum(float v) {
#pragma unroll
    for (int o = 1; o < 64; o <<= 1) v += __shfl_xor(v, o);
    return v;
}
__device__ __forceinline__ float silu_f(float x) { return x / (1.f + __expf(-x)); }
__device__ __forceinline__ float gelu_tanh(float x) { const float u = 0.7978845608028654f * (x + 0.044715f * x * x * x); return 0.5f * x * (1.f + tanhf(u)); }
__device__ __forceinline__ unsigned pk2(float lo, float hi) { return pg8::cvt_pk_bf16(lo, hi); }
__device__ __forceinline__ unsigned pkh2(float lo, float hi) { return pg8::pk_f16(lo, hi); }
__device__ __forceinline__ float h2f_lo(unsigned u) { return pg8::f16lo(u); }
__device__ __forceinline__ float h2f_hi(unsigned u) { return pg8::f16hi(u); }
__device__ __forceinline__ int otid() { int t = threadIdx.x; asm volatile("" : "+v"(t)); return t; }
__device__ __forceinline__ int permtok(int t) { return ((t & 63) << 6) | (t >> 6); }

template <bool MAPIN>
__device__ __forceinline__ void transpose_item(const float* __restrict__ W, int ldw, int K, bf16_t* __restrict__ WT, int k0, int n0, float* tile) {
    const int tid = otid();
#pragma unroll
    for (int j = 0; j < 32; ++j) { const int i = tid + NT * j, kk = i >> 8, nn = i & 255; int oc = n0 + nn; if (MAPIN) oc = in_col_map(oc);
        tile[kk * 257 + nn] = (oc >= 0) ? W[(size_t)(k0 + kk) * ldw + oc] : 0.f; }
    __syncthreads();
    { const int n = tid >> 1, kh = tid & 1; bf16_t* dst = WT + (size_t)(n0 + n) * K + k0 + 32 * kh;
#pragma unroll
      for (int c = 0; c < 4; ++c) { const float* s = tile + (32 * kh + 8 * c) * 257 + n;
          *(uint4*)(dst + 8 * c) = make_uint4(pkh2(s[0], s[257]), pkh2(s[2 * 257], s[3 * 257]), pkh2(s[4 * 257], s[5 * 257]), pkh2(s[6 * 257], s[7 * 257])); } }
    __syncthreads();
}
constexpr int TI_IN = (DM / 64) * (NINP / 256), TI_OUT = (DM / 64) * (DM / 256), TI_GLU = 8 * 2;
constexpr int N_TITEMS = TI_IN + TI_OUT + TI_GLU;
__device__ __forceinline__ void weights_item(const Params& p, int l, int r, float* smem) {
    if (r < TI_IN) { const int kb = r / (NINP / 256), nbk = r % (NINP / 256);
        transpose_item<true>(INP(p, I_WIN) + (size_t)l * DM * NIN, NIN, DM, (bf16_t*)(WSP(p) + WS_WIN) + (size_t)l * NINP * DM, kb * 64, nbk * 256, smem); return; }
    r -= TI_IN;
    if (r < TI_OUT) { const int kb = r / 8, nbk = r % 8;
        transpose_item<false>(INP(p, I_WOUT) + (size_t)l * DM * DM, DM, DM, (bf16_t*)(WSP(p) + WS_WOUT) + (size_t)l * DM * DM, kb * 64, nbk * 256, smem); return; }
    r -= TI_OUT;
    { const int kb = r / 2, nbk = r % 2;
        transpose_item<false>(INP(p, I_WGLU) + (size_t)l * 512 * 512, 512, 512, (bf16_t*)(WSP(p) + WS_WGLU) + (size_t)l * 512 * 512, kb * 64, nbk * 256, smem); }
}
constexpr int N_MODITEMS = 6144 / 64;
__device__ __forceinline__ void mod_item(const Params& p, int l, int jb, float* smem) {
    const int tid = otid(); float* sv = smem;   float* red = smem + 3 * 2048;
    for (int i = tid; i < 3 * 2048; i += NT) { const int r = i >> 11, k = i & 2047; const float c = (r < 2) ? INP(p, I_C)[r * 2048 + k] : INP(p, I_CCTX)[k]; sv[i] = silu_f(c); }
    __syncthreads();
    const int cl = tid & 15, kg = tid >> 4;
    const float* w = INP(p, I_WMOD) + (size_t)l * DM * 6144 + jb * 64 + cl * 4;
    f32x4 a0 = {0, 0, 0, 0}, a1 = a0, a2 = a0;
#pragma unroll 16
    for (int kk = 0; kk < 64; ++kk) { const int k = kg * 64 + kk; const f32x4 wv = *(const f32x4*)(w + (size_t)k * 6144);
        a0 += wv * sv[k]; a1 += wv * sv[2048 + k]; a2 += wv * sv[4096 + k]; }
    *(f32x4*)(red + (kg * 3 + 0) * 64 + cl * 4) = a0; *(f32x4*)(red + (kg * 3 + 1) * 64 + cl * 4) = a1; *(f32x4*)(red + (kg * 3 + 2) * 64 + cl * 4) = a2;
    __syncthreads();
    if (tid < 192) { const int r = tid >> 6, c = tid & 63; float s = INP(p, I_BMOD)[l * 6144 + jb * 64 + c];
        for (int g = 0; g < 32; ++g) s += red[(g * 3 + r) * 64 + c];
        ((float*)(WSP(p) + WS_MOD))[(size_t)(l * 3 + r) * 6144 + jb * 64 + c] = s; }
    __syncthreads();
}
__device__ __forceinline__ void taps_item(const Params& p, int l, int LX, float* TP, int tb, int cb, float* smem) {
    const int tid = otid();
    float* feats = smem;
    float* h1 = feats + 64 * 33;
    float* h2 = h1 + 64 * 64;
    float* T = h2 + 64 * 64;
    const float* w1 = INP(p, I_HW1) + l * 33 * 64; const float* b1 = INP(p, I_HB1) + l * 64; const float* f1 = INP(p, I_HF1) + l * 64;
    const float* w2 = INP(p, I_HW2) + l * 64 * 64; const float* b2 = INP(p, I_HB2) + l * 64; const float* f2 = INP(p, I_HF2) + l * 64;
    const float* w3 = INP(p, I_HW3) + (size_t)l * 64 * 2048;
#pragma unroll 1
    for (int i = tid; i < 64 * 33; i += NT) { const int tt = i / 33, f = i % 33; const int tau = tb * 64 + tt;
        const float ang = (6.283185307179586f / (float)LX) * (float)tau; float v;
        if (f == 0) v = (float)tau / (float)(LX - 1);
        else { const int bi = (f - 1) & 15; const float band = 1e-4f + (float)bi * ((15.0f - 1e-4f) / 15.0f); const float a = band * ang; v = (f <= 16) ? cosf(a) : -sinf(a); }
        feats[i] = v; }
    __syncthreads();
#pragma unroll 1
    for (int i = tid; i < 64 * 64; i += NT) { const int tt = i >> 6, j = i & 63; float s = b1[j];
#pragma unroll 3
        for (int f = 0; f < 33; ++f) s += feats[tt * 33 + f] * w1[f * 64 + j];
        h1[i] = sinf(f1[j] * s); }
    __syncthreads();
#pragma unroll 1
    for (int i = tid; i < 64 * 64; i += NT) { const int tt = i >> 6, j = i & 63; float s = b2[j];
#pragma unroll 4
        for (int f = 0; f < 64; ++f) s += h1[tt * 64 + f] * w2[f * 64 + j];
        h2[i] = sinf(f2[j] * s); }
    __syncthreads();
    { const int cc = tid & 255, th = tid >> 8, col = cb * 256 + cc; float w3r[64];
#pragma unroll
      for (int i = 0; i < 64; ++i) w3r[i] = w3[(size_t)i * 2048 + col];
      const int c = col & 511; const float delta = fabsf(-15.350567286626973f + (float)c * ((-3.0701134573253945f + 15.350567286626973f) / 511.0f));
#pragma unroll 2
      for (int e = 0; e < 32; ++e) { const float* hrow = h2 + (th * 32 + e) * 64; float a = 0.f;
#pragma unroll
          for (int i4 = 0; i4 < 16; ++i4) { const f32x4 hv = *(const f32x4*)(hrow + 4 * i4);
              a += w3r[4 * i4] * hv[0] + w3r[4 * i4 + 1] * hv[1] + w3r[4 * i4 + 2] * hv[2] + w3r[4 * i4 + 3] * hv[3]; }
          const int tau = tb * 64 + th * 32 + e; const float tl = (float)tau / (float)(LX - 1); T[cc * 65 + th * 32 + e] = a * expf(-tl * delta); } }
    __syncthreads();
    { const int tt = tid & 63, cg = tid >> 6; const int tau = tb * 64 + tt;
#pragma unroll 2
      for (int q = 0; q < 32; ++q) { const int cc = cg * 32 + q, col = cb * 256 + cc; const int o = col >> 10, dir = (col >> 9) & 1, c = col & 511;
          float* dst = TP + (size_t)(o * 512 + c) * (2 * LX);
          if (dir == 0) dst[LX - 1 + tau] = T[cc * 65 + tt];
          else if (tau >= 1) dst[LX - 1 - tau] = T[cc * 65 + tt]; } }
    __syncthreads();
}
constexpr int N_H2ITEMS = SEQ / 64;
__device__ __forceinline__ void h2_item(const Params& p, int it, float* smem) {
    const int tid = otid(); const int l = it / (SEQ / 64), tb = it % (SEQ / 64); constexpr int LX = SEQ;
    float* dst = (float*)(WSP(p) + WS_H2) + (size_t)l * 64 * SEQ + tb * 64;
    float* feats = smem; float* h1 = feats + 64 * 33;
    const float* w1 = INP(p, I_HW1) + l * 33 * 64; const float* b1 = INP(p, I_HB1) + l * 64; const float* f1 = INP(p, I_HF1) + l * 64;
    const float* w2 = INP(p, I_HW2) + l * 64 * 64; const float* b2 = INP(p, I_HB2) + l * 64; const float* f2 = INP(p, I_HF2) + l * 64;
#pragma unroll 1
    for (int i = tid; i < 64 * 33; i += NT) { const int tt = i / 33, f = i % 33; const int tau = tb * 64 + tt;
        const float ang = (6.283185307179586f / (float)LX) * (float)tau; float v;
        if (f == 0) v = (float)tau / (float)(LX - 1);
        else { const int bi = (f - 1) & 15; const float band = 1e-4f + (float)bi * ((15.0f - 1e-4f) / 15.0f); const float a = band * ang; v = (f <= 16) ? cosf(a) : -sinf(a); }
        feats[i] = v; }
    __syncthreads();
#pragma unroll 1
    for (int i = tid; i < 64 * 64; i += NT) { const int tt = i >> 6, j = i & 63; float s = b1[j];
#pragma unroll 3
        for (int f = 0; f < 33; ++f) s += feats[tt * 33 + f] * w1[f * 64 + j];
        h1[tt * 65 + j] = sinf(f1[j] * s); }
    __syncthreads();
#pragma unroll 1
    for (int i = tid; i < 64 * 64; i += NT) { const int j = i >> 6, tt = i & 63; float s = b2[j];
#pragma unroll 4
        for (int f = 0; f < 64; ++f) s += h1[tt * 65 + f] * w2[f * 64 + j];
        dst[(size_t)j * SEQ + tt] = sinf(f2[j] * s); }
    __syncthreads();
}
constexpr int N_CTAPITEMS = (LCX / 64) * 8;
__device__ __forceinline__ void ctaps_item(const Params& p, int l, int it, float* smem) { taps_item(p, l, LCX, (float*)(WSP(p) + WS_TP) + TPC_OFF + (l & 1) * TPC_SLOT, it >> 3, it & 7, smem); }

__device__ __forceinline__ void phase_row(const Params& p, int l, int bid, int nb) {
    const int tid_ = otid(); const int lane = tid_ & 63, wave = tid_ >> 6;
    const float* MOD = (const float*)(WSP(p) + WS_MOD); const float* R = (const float*)(WSP(p) + WS_P);
    float* XC = (float*)(WSP(p) + WS_XC); bf16_t* H = (bf16_t*)(WSP(p) + WS_H);
    const int nrows = (l == DEPTH) ? NLAT : MROWS;
    for (int r = bid * 8 + wave; r < nrows; r += nb * 8) {
        const bool lat = r < NLAT; const int b = lat ? (r >> 12) : 0, t = r & 4095, rb = lat ? b : 2;
        const float* xin; float* xout;
        if (lat) { xin = ((l <= 1) ? INP(p, I_X) : OUTP(p)) + (size_t)r * DM; xout = OUTP(p) + (size_t)r * DM; }
        else { xin = ((l <= 1) ? INP(p, I_CTX) : XC) + (size_t)(r - NLAT) * DM; xout = XC + (size_t)(r - NLAT) * DM; }
        f32x4 x[8];
#pragma unroll
        for (int j = 0; j < 8; ++j) x[j] = *(const f32x4*)(xin + 4 * lane + 256 * j);
        if (l > 0) {
            const int lp = l - 1; const int rr = (lat && (lp & 1)) ? (b * SEQ + permtok(t)) : r;
            const float* Rr = R + (size_t)rr * DM; f32x4 v[8]; float ss = 0.f;
#pragma unroll
            for (int j = 0; j < 8; ++j) { v[j] = *(const f32x4*)(Rr + 4 * lane + 256 * j); ss += v[j][0] * v[j][0] + v[j][1] * v[j][1] + v[j][2] * v[j][2] + v[j][3] * v[j][3]; }
            const float rs = rsqrtf(wave_sum(ss) * (1.f / DM) + EPS);
            const float* gate = MOD + (size_t)(lp * 3 + rb) * 6144 + 4096; const float* gp = INP(p, I_GPOST) + lp * DM;
#pragma unroll
            for (int j = 0; j < 8; ++j) { const f32x4 g = *(const f32x4*)(gate + 4 * lane + 256 * j), w = *(const f32x4*)(gp + 4 * lane + 256 * j);
                x[j] = x[j] + g * (v[j] * rs * w); *(f32x4*)(xout + 4 * lane + 256 * j) = x[j]; }
        }
        if (l < DEPTH) {
            float ss = 0.f;
#pragma unroll
            for (int j = 0; j < 8; ++j) ss += x[j][0] * x[j][0] + x[j][1] * x[j][1] + x[j][2] * x[j][2] + x[j][3] * x[j][3];
            const float rs = rsqrtf(wave_sum(ss) * (1.f / DM) + EPS);
            const float* shift = MOD + (size_t)(l * 3 + rb) * 6144; const float* scale = shift + 2048; const float* gp = INP(p, I_GPRE) + l * DM;
            const int hr = (lat && (l & 1)) ? (b * SEQ + permtok(t)) : r;
            bf16_t* hrow = H + (size_t)hr * DM;
#pragma unroll
            for (int j = 0; j < 8; ++j) { const f32x4 sh = *(const f32x4*)(shift + 4 * lane + 256 * j), sc = *(const f32x4*)(scale + 4 * lane + 256 * j), w = *(const f32x4*)(gp + 4 * lane + 256 * j);
                const f32x4 y = (x[j] * rs * w) * (sc + 1.f) + sh; uint2 o; o.x = pkh2(y[0], y[1]); o.y = pkh2(y[2], y[3]);
                *(uint2*)(hrow + 4 * lane + 256 * j) = o; }
        }
    }
}

template <int LX, int NTT>
__device__ __forceinline__ void hy_naive_item(const Params& p, int l, const float* TP, const float* HTb, float* HOb, int c, float* smem) {
    const int tid = otid();
    float* tp = smem; float* vb = tp + 2 * LX; float* zb = vb + 2 * LX;
    const float* cw = INP(p, I_HCW) + (size_t)l * 3 * 1536; const float* cb = INP(p, I_HCB) + (size_t)l * 1536; const float* hd = INP(p, I_HD) + (size_t)l * 2 * 512;
#define SHORTC(dst, chan) do { const float w0 = cw[chan], w1 = cw[1536 + (chan)], w2 = cw[2 * 1536 + (chan)], bb = cb[chan]; \
        for (int i = tid; i < 2 * LX; i += NT) { const int b = i / LX, t = i % LX; const float* s = HTb + ((size_t)(b * 2048 + (chan))) * LX; \
            const float a = s[t > 0 ? t - 1 : 0], m = s[t], n = s[t < LX - 1 ? t + 1 : LX - 1]; dst[i] = w0 * (t > 0 ? a : 0.f) + w1 * m + w2 * (t < LX - 1 ? n : 0.f) + bb; } } while (0)
    for (int i = tid; i < 2 * LX; i += NT) tp[i] = (i < 2 * LX - 1) ? TP[(size_t)(0 * 512 + c) * (2 * LX) + i] : 0.f;
    SHORTC(vb, c);
    __syncthreads();
    float acc[2][NTT];
#pragma unroll
    for (int e = 0; e < NTT; ++e) { acc[0][e] = 0.f; acc[1][e] = 0.f; }
    for (int s = 0; s < LX; ++s) { const float v0 = vb[s], v1 = vb[LX + s];
#pragma unroll
        for (int e = 0; e < NTT; ++e) { const int t = tid + NT * e; if (t < LX) { const float w = tp[LX - 1 + t - s]; acc[0][e] += w * v0; acc[1][e] += w * v1; } } }
    __syncthreads();
    {
        const int ch = 512 + c; const float w0 = cw[ch], w1 = cw[1536 + ch], w2 = cw[2 * 1536 + ch], bb = cb[ch]; const float d0 = hd[c];
#pragma unroll
        for (int e = 0; e < NTT; ++e) { const int t = tid + NT * e; if (t < LX) {
#pragma unroll
            for (int b = 0; b < 2; ++b) { const float* s = HTb + ((size_t)(b * 2048 + ch)) * LX; const float a = s[t > 0 ? t - 1 : 0], m = s[t], n = s[t < LX - 1 ? t + 1 : LX - 1];
                const float x1 = w0 * (t > 0 ? a : 0.f) + w1 * m + w2 * (t < LX - 1 ? n : 0.f) + bb; zb[b * LX + t] = x1 * (acc[b][e] + d0 * vb[b * LX + t]); } } }
    }
    for (int i = tid; i < 2 * LX; i += NT) tp[i] = (i < 2 * LX - 1) ? TP[(size_t)(1 * 512 + c) * (2 * LX) + i] : 0.f;
    __syncthreads();
#pragma unroll
    for (int e = 0; e < NTT; ++e) { acc[0][e] = 0.f; acc[1][e] = 0.f; }
    for (int s = 0; s < LX; ++s) { const float v0 = zb[s], v1 = zb[LX + s];
#pragma unroll
        for (int e = 0; e < NTT; ++e) { const int t = tid + NT * e; if (t < LX) { const float w = tp[LX - 1 + t - s]; acc[0][e] += w * v0; acc[1][e] += w * v1; } } }
    {
        const int ch = 1024 + c; const float w0 = cw[ch], w1 = cw[1536 + ch], w2 = cw[2 * 1536 + ch], bb = cb[ch]; const float d1 = hd[512 + c];
#pragma unroll
        for (int e = 0; e < NTT; ++e) { const int t = tid + NT * e; if (t < LX) {
#pragma unroll
            for (int b = 0; b < 2; ++b) { const float* s = HTb + ((size_t)(b * 2048 + ch)) * LX; const float a = s[t > 0 ? t - 1 : 0], m = s[t], n = s[t < LX - 1 ? t + 1 : LX - 1];
                const float x2 = w0 * (t > 0 ? a : 0.f) + w1 * m + w2 * (t < LX - 1 ? n : 0.f) + bb; const float gt = HTb[((size_t)(b * 2048 + 1536 + c)) * LX + t];
                HOb[((size_t)(b * 512 + c)) * LX + t] = x2 * (acc[b][e] + d1 * zb[b * LX + t]) * silu_f(gt); } } }
    }
    __syncthreads();
#undef SHORTC
}
constexpr int N_POSTT = NB * 8 * (SEQ / 64) + NB * 8 * (LCX / 64);
__device__ __forceinline__ void phase_post(const Params& p, int l, int bid, int nb, float* tile) {
    const int tid = otid(), lane = tid & 63, wave = tid >> 6;
    const bf16_t* P16 = (const bf16_t*)(WSP(p) + WS_P); const bf16_t* OG = (const bf16_t*)(WSP(p) + WS_OG);
    bf16_t* YC = (bf16_t*)(WSP(p) + WS_YCAT);
    const float* gn = INP(p, I_GNORM) + l * 256;
    for (int r = bid * 8 + wave; r < MROWS; r += nb * 8) {
        const bf16_t* pr = P16 + (size_t)r * PP;
#pragma unroll
        for (int hh = 0; hh < 4; ++hh) { const int col = hh * 256 + 4 * lane;
            const uint2 of = *(const uint2*)(OG + (size_t)r * 1024 + col), ob = *(const uint2*)(OG + ((size_t)MROWS + r) * 1024 + col);
            const f32x4 o = {h2f_lo(of.x) + h2f_lo(ob.x), h2f_hi(of.x) + h2f_hi(ob.x), h2f_lo(of.y) + h2f_lo(ob.y), h2f_hi(of.y) + h2f_hi(ob.y)};
            const float rs = rsqrtf(wave_sum(o[0] * o[0] + o[1] * o[1] + o[2] * o[2] + o[3] * o[3]) * (1.f / 256.f) + EPS);
            const f32x4 w = *(const f32x4*)(gn + 4 * lane); const uint2 g2 = *(const uint2*)(pr + PGG + col);
            const float g[4] = {h2f_lo(g2.x), h2f_hi(g2.x), h2f_lo(g2.y), h2f_hi(g2.y)};
            uint2 q; q.x = pkh2(o[0] * rs * w[0] * silu_f(g[0]), o[1] * rs * w[1] * silu_f(g[1])); q.y = pkh2(o[2] * rs * w[2] * silu_f(g[2]), o[3] * rs * w[3] * silu_f(g[3]));
            *(uint2*)(YC + (size_t)r * DM + col) = q; }
    }
    const float* HT = (const float*)(WSP(p) + WS_TP); const float* HTC = HT + HO_C;
    for (int it = bid; it < N_POSTT; it += nb) {
        const float* src; int LX, b, cb, tb, rbase;
        if (it < NB * 8 * (SEQ / 64)) { LX = SEQ; b = it / (8 * 64); const int q = it % (8 * 64); cb = q >> 6; tb = q & 63; src = HT; rbase = b * SEQ; }
        else { const int i2 = it - NB * 8 * (SEQ / 64); LX = LCX; b = i2 / (8 * 4); const int q = i2 % (8 * 4); cb = q >> 2; tb = q & 3; src = HTC; rbase = NLAT + b * LCX; }
#pragma unroll
        for (int j = 0; j < 8; ++j) { const int i = tid + NT * j, cc = i >> 6, tt = i & 63; tile[tt * 65 + cc] = src[((size_t)(b * 512 + cb * 64 + cc)) * LX + tb * 64 + tt]; }
        __syncthreads();
        { const int tt = tid >> 3, cq = tid & 7; const float* s = tile + tt * 65 + cq * 8;
          uint4 o; o.x = pkh2(s[0], s[1]); o.y = pkh2(s[2], s[3]); o.z = pkh2(s[4], s[5]); o.w = pkh2(s[6], s[7]);
          *(uint4*)(YC + (size_t)(rbase + tb * 64 + tt) * DM + 1536 + cb * 64 + cq * 8) = o; }
        __syncthreads();
    }
}
#define XB_TMO      128
#define XB_XCNT(j)  (256  + 64 * (j))
#define XB_XSUB(j)  (1280 + 64 * (j))
#define XB_XGEN(j)  (2304 + 64 * (j))
#define XB_TOP      3328
#define XB_TOPGEN   3392
#define XCD_BAR_WORDS 3456
#define XB_SPIN_CAP (1u << 22)

__device__ __forceinline__ unsigned xb_ld(unsigned* p)              { return __hip_atomic_load(p, __ATOMIC_RELAXED, __HIP_MEMORY_SCOPE_AGENT); }
__device__ __forceinline__ unsigned xb_add(unsigned* p, unsigned v) { return __hip_atomic_fetch_add(p, v, __ATOMIC_RELAXED, __HIP_MEMORY_SCOPE_AGENT); }
__device__ __forceinline__ unsigned xb_xcc_id() { return (unsigned)__builtin_amdgcn_s_getreg((3 << 11) | 20) & 0xFu; }
#define XB_SPIN(cond, bar) do { unsigned _sp = 0; while (cond) { __builtin_amdgcn_s_sleep(1); \
    if ((++_sp & 255u) == 0u) { if (xb_ld(&(bar)[XB_TMO])) break; if (_sp > XB_SPIN_CAP) { atomicAdd(&(bar)[XB_TMO], 1u); break; } } } } while (0)

struct XcdBarrier {
    unsigned* bar; unsigned x;
    volatile LAS unsigned* st;
};

__device__ __forceinline__ XcdBarrier xcd_barrier_post(unsigned* bar, volatile LAS unsigned* st) {
    XcdBarrier b; b.bar = bar; b.x = xb_xcc_id(); b.st = st;
    if (threadIdx.x == 0) (void)xb_add(&bar[XB_XCNT(b.x)], 1u);
    return b;
}
__device__ __forceinline__ void xcd_barrier_complete(unsigned* bar, unsigned x, unsigned& nloc, unsigned& nx) {
    const unsigned G = gridDim.x * gridDim.y * gridDim.z;
    unsigned sum, cnt, mine, sp = 0u;
    for (;;) {
        sum = 0u; cnt = 0u; mine = 0u;
#pragma unroll
        for (unsigned j = 0; j < 16; ++j) { const unsigned c = xb_ld(&bar[XB_XCNT(j)]); sum += c; cnt += (c > 0u) ? 1u : 0u; mine = (j == x) ? c : mine; }
        if (sum == G) break;
        __builtin_amdgcn_s_sleep(1);
        if ((++sp & 255u) == 0u) { if (xb_ld(&bar[XB_TMO])) break; if (sp > XB_SPIN_CAP) { atomicAdd(&bar[XB_TMO], 1u); break; } }
    }
    nloc = mine > 0u ? mine : 1u; nx = cnt > 0u ? cnt : 1u;
}

__device__ __forceinline__ void xcd_barrier(const XcdBarrier& b) {
    asm volatile("s_waitcnt vmcnt(0)" ::: "memory");
    __syncthreads();
    if (threadIdx.x == 0) {
        unsigned* bar = b.bar; asm volatile("" : "+s"(bar));
        __builtin_amdgcn_s_waitcnt(0);
        unsigned nloc = b.st[0], nx = b.st[1];
        if (nloc == 0u) { xcd_barrier_complete(bar, b.x, nloc, nx); b.st[0] = nloc; b.st[1] = nx; }
        const unsigned old = xb_add(&bar[XB_XSUB(b.x)], 1u);
        const unsigned gen = old / nloc;
        if (old + 1u == (gen + 1u) * nloc) {
            __builtin_amdgcn_fence(__ATOMIC_RELEASE, "agent");
            asm volatile("s_waitcnt vmcnt(0)" ::: "memory");
            const unsigned og = xb_add(&bar[XB_TOP], 1u);
            const unsigned tg = og / nx;
            if (og + 1u == (tg + 1u) * nx) xb_add(&bar[XB_TOPGEN], 1u);
            else XB_SPIN(xb_ld(&bar[XB_TOPGEN]) == tg, bar);
            __builtin_amdgcn_fence(__ATOMIC_ACQUIRE, "agent");
            xb_add(&bar[XB_XGEN(b.x)], 1u);
            asm volatile("s_waitcnt vmcnt(0)" ::: "memory");
        } else {
            XB_SPIN(xb_ld(&bar[XB_XGEN(b.x)]) == gen, bar);
            __builtin_amdgcn_fence(__ATOMIC_ACQUIRE, "agent");
            asm volatile("s_waitcnt vmcnt(0)" ::: "memory");
        }
    }
    __syncthreads();
}

typedef short bf16x8_t __attribute__((ext_vector_type(8)));
constexpr int NCH = 68;
constexpr size_t GLA_QT = 0;
constexpr size_t GLA_KT = GLA_QT + (size_t)2 * MROWS * 512 * 2;
constexpr size_t GLA_KDT = GLA_KT + (size_t)2 * MROWS * 512 * 2;
constexpr size_t GLA_VT = GLA_KDT + (size_t)2 * NB * 4 * NCH * 8192 * 2;
constexpr size_t GLA_AG = GLA_VT + (size_t)NB * 4 * NCH * 16384 * 2;
constexpr size_t GLA_BYTES = GLA_AG + (size_t)2 * NB * 4 * NCH * 128 * 4;
__device__ __forceinline__ int chunk_row0(int b, int ch) { return ch < 4 ? (NLAT + b * LCX + 64 * ch) : (b * SEQ + 64 * (ch - 4)); }

constexpr int N_GLAPREP = 2 * NB * 4 * NCH;
__device__ __forceinline__ void gla_prep_item(const Params& p, int l, int it0, float* smem) {
    const int tid = otid(); const int dir = it0 / (NB * 4 * NCH), it = it0 % (NB * 4 * NCH); const int b = it / (4 * NCH), h = (it / NCH) & 3, ch = it % NCH; const int row0 = chunk_row0(b, ch);
    const bf16_t* P16 = (const bf16_t*)(WSP(p) + WS_P); unsigned char* GB = WSP(p) + WS_GLA;
    float* lrs = smem;
    float* tot = lrs + 64 * 32;
    float* vtile = tot + 2 * 4 * 128;
    for (int i = tid; i < 64 * 32; i += NT) lrs[i] = (float)__builtin_bit_cast(_Float16, P16[(size_t)(row0 + (i >> 5)) * PP + PLR + (i & 31)]);
    if (dir == 0) {
#pragma unroll 16
    for (int j = 0; j < 32; ++j) { const int i = tid + NT * j, r = i >> 8, v = i & 255; vtile[r * 257 + v] = (float)__builtin_bit_cast(_Float16, P16[(size_t)(row0 + r) * PP + PV + h * 256 + v]); } }
    __syncthreads();
    const int k = tid & 127, seg = tid >> 7;
    float G[16];
    {
        float wg[16];
#pragma unroll
        for (int r = 0; r < 16; ++r) wg[r] = INP(p, I_GWG)[((size_t)(l * 2 + dir) * 16 + r) * 512 + h * 128 + k];
        const float bias = INP(p, I_GBG)[(l * 2 + dir) * 512 + h * 128 + k];
#pragma unroll
        for (int e = 0; e < 16; ++e) { const float* lr = lrs + (16 * seg + e) * 32 + dir * 16; float z = bias;
#pragma unroll
            for (int r = 0; r < 16; ++r) z += lr[r] * wg[r];
            G[e] = (fminf(z, 0.f) - __logf(1.f + __expf(-fabsf(z)))) * (1.f / 16.f); }
        if (dir == 0) {
#pragma unroll
            for (int e = 1; e < 16; ++e) G[e] += G[e - 1];
            tot[seg * 128 + k] = G[15];
        } else {
#pragma unroll
            for (int e = 14; e >= 0; --e) G[e] += G[e + 1];
            tot[seg * 128 + k] = G[0];
        }
    }
    __syncthreads();
    {
        float off = 0.f, glast = 0.f;
#pragma unroll
        for (int s = 0; s < 4; ++s) { const float t = tot[s * 128 + k]; glast += t; if (dir == 0 ? (s < seg) : (s > seg)) off += t; }
        bf16_t* QT = (bf16_t*)(GB + GLA_QT) + ((size_t)dir * MROWS + row0) * 512 + h * 128 + k;
        bf16_t* KT = (bf16_t*)(GB + GLA_KT) + ((size_t)dir * MROWS + row0) * 512 + h * 128 + k;
        unsigned kd[8];
#pragma unroll
        for (int e = 0; e < 16; e += 2) { float kdv[2];
#pragma unroll
            for (int u = 0; u < 2; ++u) { const int i = 16 * seg + e + u; const float g = G[e + u] + off;
                const float q = (float)__builtin_bit_cast(_Float16, P16[(size_t)(row0 + i) * PP + PQ + h * 128 + k]) * 0.08838834764831845f, kk = (float)__builtin_bit_cast(_Float16, P16[(size_t)(row0 + i) * PP + PK + h * 128 + k]);
                QT[(size_t)i * 512] = (bf16_t)(pk2(q * __expf(g), 0.f) & 0xffff); KT[(size_t)i * 512] = (bf16_t)(pk2(kk * __expf(-g), 0.f) & 0xffff);
                kdv[u] = kk * __expf(glast - g); }
            kd[e >> 1] = pk2(kdv[0], kdv[1]); }
        bf16_t* KD = (bf16_t*)(GB + GLA_KDT) + ((((size_t)dir * NB + b) * 4 + h) * NCH + ch) * 8192 + k * 64 + 16 * seg;
        *(uint4*)KD = make_uint4(kd[0], kd[1], kd[2], kd[3]); *(uint4*)(KD + 8) = make_uint4(kd[4], kd[5], kd[6], kd[7]);
        if (seg == 0) ((float*)(GB + GLA_AG))[((((size_t)dir * NB + b) * 4 + h) * NCH + ch) * 128 + k] = __expf(glast);
    }
    if (dir == 0) {
        const int v = tid >> 1, hf = tid & 1; bf16_t* VT = (bf16_t*)(GB + GLA_VT) + (((size_t)b * 4 + h) * NCH + ch) * 16384 + v * 64 + 32 * hf;
#pragma unroll
        for (int c = 0; c < 4; ++c) { const float* s = vtile + (32 * hf + 8 * c) * 257 + v;
            *(uint4*)(VT + 8 * c) = make_uint4(pk2(s[0], s[257]), pk2(s[2 * 257], s[3 * 257]), pk2(s[4 * 257], s[5 * 257]), pk2(s[6 * 257], s[7 * 257])); }
    }
    __syncthreads();
}

constexpr int GQP = 136, GVP = 72;
__device__ __forceinline__ bf16x8_t ldfrag(const bf16_t* base, int pitch, int row0, int k0, int lane) {
    return *(const bf16x8_t*)(base + (row0 + (lane & 15)) * pitch + k0 + (lane >> 4) * 8);
}
__device__ __forceinline__ void gla_seq_item(const Params& p, int it, bf16_t* lds) {
    const int tid = otid(), lane = tid & 63, w = tid >> 6;
    const int b = it >> 5, dir = (it >> 4) & 1, h = (it >> 2) & 3, vs = it & 3;
    unsigned char* GB = WSP(p) + WS_GLA; bf16_t* OG = (bf16_t*)(WSP(p) + WS_OG);
    bf16_t* Qs = lds; bf16_t* Ks = Qs + 64 * GQP; bf16_t* STs = Ks + 64 * GQP; bf16_t* KdTs = STs + 64 * GQP; bf16_t* VTs = KdTs + 128 * GVP; bf16_t* Ps = VTs + 64 * GVP;
    const bf16_t* QTg = (const bf16_t*)(GB + GLA_QT) + (size_t)dir * MROWS * 512 + h * 128;
    const bf16_t* KTg = (const bf16_t*)(GB + GLA_KT) + (size_t)dir * MROWS * 512 + h * 128;
    const bf16_t* KDg = (const bf16_t*)(GB + GLA_KDT) + (((size_t)dir * NB + b) * 4 + h) * NCH * 8192;
    const bf16_t* VTg = (const bf16_t*)(GB + GLA_VT) + ((size_t)b * 4 + h) * NCH * 16384 + vs * 64 * 64;
    const float* AGg = (const float*)(GB + GLA_AG) + (((size_t)dir * NB + b) * 4 + h) * NCH * 128;
    f32x4 S_[4];
#pragma unroll
    for (int i = 0; i < 4; ++i) S_[i] = (f32x4){0.f, 0.f, 0.f, 0.f};
    uint4 rqA0, rqA1, rkA0, rkA1, rdA0, rdA1, rvA; f32x4 anA;
    uint4 rqB0, rqB1, rkB0, rkB1, rdB0, rdB1, rvB; f32x4 anB;
#define GLA_LOAD(S, cs_) do { const int ch_ = dir ? ((cs_) < 4 ? 3 - (cs_) : 71 - (cs_)) : (cs_); const int r0_ = chunk_row0(b, ch_); const int e0_ = tid, e1_ = tid + NT; \
        rq##S##0 = *(const uint4*)(QTg + (size_t)(r0_ + (e0_ >> 4)) * 512 + (e0_ & 15) * 8); rq##S##1 = *(const uint4*)(QTg + (size_t)(r0_ + (e1_ >> 4)) * 512 + (e1_ & 15) * 8); \
        rk##S##0 = *(const uint4*)(KTg + (size_t)(r0_ + (e0_ >> 4)) * 512 + (e0_ & 15) * 8); rk##S##1 = *(const uint4*)(KTg + (size_t)(r0_ + (e1_ >> 4)) * 512 + (e1_ & 15) * 8); \
        rd##S##0 = *(const uint4*)(KDg + (size_t)ch_ * 8192 + e0_ * 8); rd##S##1 = *(const uint4*)(KDg + (size_t)ch_ * 8192 + e1_ * 8); \
        rv##S = *(const uint4*)(VTg + (size_t)ch_ * 16384 + tid * 8); an##S = *(const f32x4*)(AGg + ch_ * 128 + 16 * w + (lane >> 4) * 4); } while (0)
#define GLA_BODY(S, cs) do { \
        const int ch = dir ? ((cs) < 4 ? 3 - (cs) : 71 - (cs)) : (cs); const int r0 = chunk_row0(b, ch); \
        { const int e0 = tid, e1 = tid + NT; \
            *(uint4*)(Qs + (e0 >> 4) * GQP + (e0 & 15) * 8) = rq##S##0; *(uint4*)(Qs + (e1 >> 4) * GQP + (e1 & 15) * 8) = rq##S##1; \
            *(uint4*)(Ks + (e0 >> 4) * GQP + (e0 & 15) * 8) = rk##S##0; *(uint4*)(Ks + (e1 >> 4) * GQP + (e1 & 15) * 8) = rk##S##1; \
            *(uint4*)(KdTs + (e0 >> 3) * GVP + (e0 & 7) * 8) = rd##S##0; *(uint4*)(KdTs + (e1 >> 3) * GVP + (e1 & 7) * 8) = rd##S##1; } \
        *(uint4*)(VTs + (tid >> 3) * GVP + (tid & 7) * 8) = rv##S; \
        const f32x4 ac = an##S; \
        _Pragma("unroll") for (int vt = 0; vt < 4; ++vt) *(uint2*)(STs + (16 * vt + (lane & 15)) * GQP + 16 * w + (lane >> 4) * 4) = make_uint2(pk2(S_[vt][0], S_[vt][1]), pk2(S_[vt][2], S_[vt][3])); \
        __syncthreads(); \
        if ((cs) + 2 < NCH) GLA_LOAD(S, (cs) + 2); \
        const int st = w & 3, tt0 = 2 * (w >> 2); \
        { f32x4 c0 = {0.f, 0.f, 0.f, 0.f}, c1 = c0; \
          _Pragma("unroll") for (int ks = 0; ks < 4; ++ks) { const bf16x8_t a = ldfrag(Ks, GQP, 16 * st, 32 * ks, lane); \
              c0 = __builtin_amdgcn_mfma_f32_16x16x32_bf16(a, ldfrag(Qs, GQP, 16 * tt0, 32 * ks, lane), c0, 0, 0, 0); \
              c1 = __builtin_amdgcn_mfma_f32_16x16x32_bf16(a, ldfrag(Qs, GQP, 16 * tt0 + 16, 32 * ks, lane), c1, 0, 0, 0); } \
          const int s0 = 16 * st + (lane >> 4) * 4; \
          _Pragma("unroll") for (int u = 0; u < 2; ++u) { const f32x4 c = u ? c1 : c0; const int t = 16 * (tt0 + u) + (lane & 15); float m[4]; \
              _Pragma("unroll") for (int r = 0; r < 4; ++r) { const bool keep = dir ? (s0 + r > t) : (s0 + r <= t); m[r] = keep ? c[r] : 0.f; } \
              *(uint2*)(Ps + t * GVP + s0) = make_uint2(pk2(m[0], m[1]), pk2(m[2], m[3])); } } \
        f32x4 o0 = {0.f, 0.f, 0.f, 0.f}, o1 = o0; \
        _Pragma("unroll") for (int ks = 0; ks < 4; ++ks) { const bf16x8_t a = ldfrag(STs, GQP, 16 * st, 32 * ks, lane); \
            o0 = __builtin_amdgcn_mfma_f32_16x16x32_bf16(a, ldfrag(Qs, GQP, 16 * tt0, 32 * ks, lane), o0, 0, 0, 0); \
            o1 = __builtin_amdgcn_mfma_f32_16x16x32_bf16(a, ldfrag(Qs, GQP, 16 * tt0 + 16, 32 * ks, lane), o1, 0, 0, 0); } \
        _Pragma("unroll") for (int vt = 0; vt < 4; ++vt) { S_[vt][0] *= ac[0]; S_[vt][1] *= ac[1]; S_[vt][2] *= ac[2]; S_[vt][3] *= ac[3]; } \
        _Pragma("unroll") for (int ks = 0; ks < 2; ++ks) { const bf16x8_t a = ldfrag(KdTs, GVP, 16 * w, 32 * ks, lane); \
            _Pragma("unroll") for (int vt = 0; vt < 4; ++vt) S_[vt] = __builtin_amdgcn_mfma_f32_16x16x32_bf16(a, ldfrag(VTs, GVP, 16 * vt, 32 * ks, lane), S_[vt], 0, 0, 0); } \
        __syncthreads(); \
        _Pragma("unroll") for (int ks = 0; ks < 2; ++ks) { const bf16x8_t a = ldfrag(VTs, GVP, 16 * st, 32 * ks, lane); \
            o0 = __builtin_amdgcn_mfma_f32_16x16x32_bf16(a, ldfrag(Ps, GVP, 16 * tt0, 32 * ks, lane), o0, 0, 0, 0); \
            o1 = __builtin_amdgcn_mfma_f32_16x16x32_bf16(a, ldfrag(Ps, GVP, 16 * tt0 + 16, 32 * ks, lane), o1, 0, 0, 0); } \
        { bf16_t* og = OG + ((size_t)dir * MROWS + r0 + 16 * tt0 + (lane & 15)) * 1024 + h * 256 + vs * 64 + 16 * st + (lane >> 4) * 4; \
          *(uint2*)og = make_uint2(pkh2(o0[0], o0[1]), pkh2(o0[2], o0[3])); *(uint2*)(og + 16 * 1024) = make_uint2(pkh2(o1[0], o1[1]), pkh2(o1[2], o1[3])); } \
        __syncthreads(); } while (0)
    GLA_LOAD(A, 0); GLA_LOAD(B, 1);
#pragma unroll 1
    for (int cs = 0; cs < NCH; cs += 2) { GLA_BODY(A, cs); GLA_BODY(B, cs + 1); }
#undef GLA_BODY
#undef GLA_LOAD
}
#ifndef FFT_HD
#define FFT_HD __device__ __forceinline__
#endif
#define PADI(i) ((i) + ((i) >> 5))
constexpr int FFT_N = 8192, FFT_BUF = FFT_N + FFT_N / 32, FFT_TW = 2048 + 512 + 128 + 32 + 8;
struct __attribute__((aligned(8))) cf { float x, y; };
FFT_HD cf cmul(cf a, cf b) { return cf{a.x * b.x - a.y * b.y, a.x * b.y + a.y * b.x}; }
FFT_HD cf cmulc(cf a, cf b) { return cf{a.x * b.x + a.y * b.y, a.y * b.x - a.x * b.y}; }
FFT_HD cf cadd(cf a, cf b) { return cf{a.x + b.x, a.y + b.y}; }
FFT_HD cf csub(cf a, cf b) { return cf{a.x - b.x, a.y - b.y}; }
FFT_HD int fft_twoff(int s) { return s == 0 ? 0 : s == 1 ? 2048 : s == 2 ? 2560 : s == 3 ? 2688 : 2720; }
template <bool INV> FFT_HD void fft_stage4(cf* buf, const cf* tw, int s, int tid) {
    const int lq = 11 - 2 * s, q4 = 1 << lq; const cf* t = tw + fft_twoff(s);
#pragma unroll
    for (int e = 0; e < 4; ++e) {
        const int bf = tid + 512 * e, blk = bf >> lq, j = bf & (q4 - 1), base = (blk << (lq + 2)) + j;
        const int i0 = PADI(base), i1 = PADI(base + q4), i2 = PADI(base + 2 * q4), i3 = PADI(base + 3 * q4);
        const cf w1 = t[j], w2 = cmul(w1, w1), w3 = cmul(w2, w1);
        cf x0 = buf[i0], x1 = buf[i1], x2 = buf[i2], x3 = buf[i3];
        if (INV) { x1 = cmulc(x1, w1); x2 = cmulc(x2, w2); x3 = cmulc(x3, w3); }
        const cf a = cadd(x0, x2), b = csub(x0, x2), c = cadd(x1, x3), d = csub(x1, x3);
        cf y0 = cadd(a, c), y2 = csub(a, c), y1, y3;
        if (!INV) { y1 = cf{b.x + d.y, b.y - d.x}; y3 = cf{b.x - d.y, b.y + d.x}; y1 = cmul(y1, w1); y2 = cmul(y2, w2); y3 = cmul(y3, w3); }
        else      { y1 = cf{b.x - d.y, b.y + d.x}; y3 = cf{b.x + d.y, b.y - d.x}; }
        buf[i0] = y0; buf[i1] = y1; buf[i2] = y2; buf[i3] = y3;
    }
}
template <bool INV> FFT_HD void fft_last8(cf* buf, int tid) {
    const float h = 0.70710678118654752f;
    const cf w[2][4] = {{{1.f, 0.f}, {1.f, 0.f}, {1.f, 0.f}, {1.f, 0.f}}, {{1.f, 0.f}, {h, -h}, {0.f, -1.f}, {-h, -h}}};
#pragma unroll
    for (int e = 0; e < 2; ++e) {
        const int base = PADI((tid + 512 * e) * 8); cf x[8];
#pragma unroll
        for (int i = 0; i < 8; ++i) x[i] = buf[base + i];
        if (!INV) {
#pragma unroll
            for (int j = 0; j < 2; ++j) { const cf a = cadd(x[j], x[j + 4]), b = csub(x[j], x[j + 4]), c = cadd(x[j + 2], x[j + 6]), d = csub(x[j + 2], x[j + 6]);
                x[j] = cadd(a, c); x[j + 2] = cmul(cf{b.x + d.y, b.y - d.x}, w[j][1]); x[j + 4] = cmul(csub(a, c), w[j][2]); x[j + 6] = cmul(cf{b.x - d.y, b.y + d.x}, w[j][3]); }
#pragma unroll
            for (int m = 0; m < 4; ++m) { const cf a = x[2 * m], b = x[2 * m + 1]; x[2 * m] = cadd(a, b); x[2 * m + 1] = csub(a, b); }
        } else {
#pragma unroll
            for (int m = 0; m < 4; ++m) { const cf a = x[2 * m], b = x[2 * m + 1]; x[2 * m] = cadd(a, b); x[2 * m + 1] = csub(a, b); }
#pragma unroll
            for (int j = 0; j < 2; ++j) { const cf u0 = x[j], u1 = cmulc(x[j + 2], w[j][1]), u2 = cmulc(x[j + 4], w[j][2]), u3 = cmulc(x[j + 6], w[j][3]);
                const cf a = cadd(u0, u2), b = csub(u0, u2), c = cadd(u1, u3), d = csub(u1, u3);
                x[j] = cadd(a, c); x[j + 4] = csub(a, c); x[j + 2] = cf{b.x - d.y, b.y + d.x}; x[j + 6] = cf{b.x + d.y, b.y - d.x}; }
        }
#pragma unroll
        for (int i = 0; i < 8; ++i) buf[base + i] = x[i];
    }
}

constexpr int HY_TW_OFF = 27136;
__device__ __forceinline__ void hy_twiddles(float* smem) {
    cf* tw = (cf*)(smem + HY_TW_OFF); const int tid = otid();
    for (int i = tid; i < FFT_TW; i += NT) { int s = 0, j = i; if (i >= 2720) { s = 4; j = i - 2720; } else if (i >= 2688) { s = 3; j = i - 2688; } else if (i >= 2560) { s = 2; j = i - 2560; } else if (i >= 2048) { s = 1; j = i - 2048; }
        const int Ls = 8192 >> (2 * s); float sn, cs; sincospif(-2.0f * (float)j / (float)Ls, &sn, &cs); tw[i] = cf{cs, sn}; }
    __syncthreads();
}
template <bool INV> __device__ __forceinline__ void hy_fft(cf* buf, const cf* tw, int tid) {
    if (!INV) {
#pragma unroll 1
        for (int s = 0; s < 5; ++s) { fft_stage4<false>(buf, tw, s, tid); __syncthreads(); }
        fft_last8<false>(buf, tid); __syncthreads();
    } else {
        fft_last8<true>(buf, tid); __syncthreads();
#pragma unroll 1
        for (int s = 4; s >= 0; --s) { fft_stage4<true>(buf, tw, s, tid); __syncthreads(); }
    }
}
__device__ __forceinline__ int fft_pos2freq(int p) {
    return ((p >> 11) & 3) | (((p >> 9) & 3) << 2) | (((p >> 7) & 3) << 4) | (((p >> 5) & 3) << 6) | (((p >> 3) & 3) << 8) | (((p >> 1) & 3) << 10) | ((p & 1) << 12);
}
__device__ __forceinline__ int fft_freq2pos(int k) {
    return ((k & 3) << 11) | (((k >> 2) & 3) << 9) | (((k >> 4) & 3) << 7) | (((k >> 6) & 3) << 5) | (((k >> 8) & 3) << 3) | (((k >> 10) & 3) << 1) | ((k >> 12) & 1);
}
__device__ __forceinline__ void hy_spec2_item(const Params& p, int l, int c, float* smem) {
    const int tid = otid(); cf* buf = (cf*)smem; float* w3c = smem + 2 * FFT_BUF; const cf* tw = (const cf*)(smem + HY_TW_OFF);
    const float* w3 = INP(p, I_HW3) + (size_t)l * 64 * 2048; const float* H2 = (const float*)(WSP(p) + WS_H2) + (size_t)l * 64 * SEQ; cf* HS = (cf*)(WSP(p) + WS_HS) + (l & 1) * HS_SLOT;
    if (tid < 256) { const int q = tid & 3, i = tid >> 2; w3c[i * 4 + q] = w3[(size_t)i * 2048 + (q >> 1) * 1024 + (q & 1) * 512 + c]; }
    const float delta = fabsf(-15.350567286626973f + (float)c * ((-3.0701134573253945f + 15.350567286626973f) / 511.0f));
    __syncthreads();
#pragma unroll 1
    for (int e = 0; e < 2; ++e) { const int tau0 = 4 * tid + 2048 * e; const float* hc = H2 + tau0;
        float t[4][4];
#pragma unroll
        for (int u = 0; u < 4; ++u) { t[u][0] = 0.f; t[u][1] = 0.f; t[u][2] = 0.f; t[u][3] = 0.f; }
#pragma unroll 16
        for (int i = 0; i < 64; ++i) { const f32x4 hv = *(const f32x4*)(hc + (size_t)i * SEQ); const f32x4 wv = *(const f32x4*)(w3c + 4 * i);
#pragma unroll
            for (int u = 0; u < 4; ++u) { t[u][0] += hv[u] * wv[0]; t[u][1] += hv[u] * wv[1]; t[u][2] += hv[u] * wv[2]; t[u][3] += hv[u] * wv[3]; } }
#pragma unroll
        for (int u = 0; u < 4; ++u) { const int tau = tau0 + u; const float dec = expf(-((float)tau / (float)(SEQ - 1)) * delta);
            buf[PADI(tau)] = cf{t[u][0] * dec, t[u][2] * dec};
            buf[PADI((8192 - tau) & 8191 ? 8192 - tau : 4096)] = (tau == 0) ? cf{0.f, 0.f} : cf{t[u][1] * dec, t[u][3] * dec}; } }
    __syncthreads();
    hy_fft<false>(buf, tw, tid);
#pragma unroll 4
    for (int e = 0; e < 16; ++e) { const int pp = tid + NT * e; const int p2 = fft_freq2pos((8192 - fft_pos2freq(pp)) & 8191);
        const cf F = buf[PADI(pp)], G = buf[PADI(p2)]; const float s = 0.5f / 8192.f;
        HS[(size_t)c * 8192 + pp] = cf{(F.x + G.x) * s, (F.y - G.y) * s};
        HS[(size_t)(512 + c) * 8192 + pp] = cf{(F.y + G.y) * s, -(F.x - G.x) * s}; }
    __syncthreads();
}
__device__ __forceinline__ float hy_short(const float* s, int t, float w0, float w1, float w2, float bb) {
    const float a = s[t > 0 ? t - 1 : 0], m = s[t], n = s[t < SEQ - 1 ? t + 1 : SEQ - 1];
    return w0 * (t > 0 ? a : 0.f) + w1 * m + w2 * (t < SEQ - 1 ? n : 0.f) + bb;
}
__device__ __forceinline__ void hy_fft_item(const Params& p, int l, int c, float* smem) {
    const int tid = otid(); cf* buf = (cf*)smem; const cf* tw = (const cf*)(smem + HY_TW_OFF);
    const float* HT = (const float*)(WSP(p) + WS_HT); float* HO = (float*)(WSP(p) + WS_TP); const cf* HS = (const cf*)(WSP(p) + WS_HS) + (l & 1) * HS_SLOT;
    const float* cw = INP(p, I_HCW) + (size_t)l * 3 * 1536; const float* cb = INP(p, I_HCB) + (size_t)l * 1536; const float* hd = INP(p, I_HD) + (size_t)l * 2 * 512;
    float v0[8], v1[8];
    { const float w0 = cw[c], w1 = cw[1536 + c], w2 = cw[2 * 1536 + c], bb = cb[c]; const float* s0 = HT + (size_t)c * SEQ; const float* s1 = HT + (size_t)(2048 + c) * SEQ;
#pragma unroll
      for (int e = 0; e < 8; ++e) { const int t = tid + NT * e; v0[e] = hy_short(s0, t, w0, w1, w2, bb); v1[e] = hy_short(s1, t, w0, w1, w2, bb);
          buf[PADI(t)] = cf{v0[e], v1[e]}; buf[PADI(4096 + t)] = cf{0.f, 0.f}; } }
    cf hreg[16];
    { const cf* H = HS + (size_t)c * 8192;
#pragma unroll
      for (int e = 0; e < 16; ++e) hreg[e] = H[tid + NT * e]; }
    __syncthreads();
    hy_fft<false>(buf, tw, tid);
#pragma unroll
    for (int e = 0; e < 16; ++e) { const int i = tid + NT * e; buf[PADI(i)] = cmul(buf[PADI(i)], hreg[e]); }
    float z0[8], z1[8];
    { const int ch = 512 + c; const float w0 = cw[ch], w1 = cw[1536 + ch], w2 = cw[2 * 1536 + ch], bb = cb[ch];
      const float* s0 = HT + (size_t)ch * SEQ; const float* s1 = HT + (size_t)(2048 + ch) * SEQ;
#pragma unroll
      for (int e = 0; e < 8; ++e) { const int t = tid + NT * e; z0[e] = hy_short(s0, t, w0, w1, w2, bb); z1[e] = hy_short(s1, t, w0, w1, w2, bb); } }
    __syncthreads();
    hy_fft<true>(buf, tw, tid);
    { const float d0 = hd[c];
#pragma unroll
      for (int e = 0; e < 8; ++e) { const int t = tid + NT * e; const cf y = buf[PADI(t)]; z0[e] *= (y.x + d0 * v0[e]); z1[e] *= (y.y + d0 * v1[e]); } }
    __syncthreads();
#pragma unroll
    for (int e = 0; e < 8; ++e) { const int t = tid + NT * e; buf[PADI(t)] = cf{z0[e], z1[e]}; buf[PADI(4096 + t)] = cf{0.f, 0.f}; }
    { const cf* H = HS + (size_t)(512 + c) * 8192;
#pragma unroll
      for (int e = 0; e < 16; ++e) hreg[e] = H[tid + NT * e]; }
    __syncthreads();
    hy_fft<false>(buf, tw, tid);
#pragma unroll
    for (int e = 0; e < 16; ++e) { const int i = tid + NT * e; buf[PADI(i)] = cmul(buf[PADI(i)], hreg[e]); }
    { const int ch = 1024 + c; const float w0 = cw[ch], w1 = cw[1536 + ch], w2 = cw[2 * 1536 + ch], bb = cb[ch];
      const float* s0 = HT + (size_t)ch * SEQ; const float* s1 = HT + (size_t)(2048 + ch) * SEQ;
      const float* g0 = HT + (size_t)(1536 + c) * SEQ; const float* g1 = HT + (size_t)(2048 + 1536 + c) * SEQ;
#pragma unroll
      for (int e = 0; e < 8; ++e) { const int t = tid + NT * e; v0[e] = hy_short(s0, t, w0, w1, w2, bb) * silu_f(g0[t]); v1[e] = hy_short(s1, t, w0, w1, w2, bb) * silu_f(g1[t]); } }
    __syncthreads();
    hy_fft<true>(buf, tw, tid);
    { const float d1 = hd[512 + c];
#pragma unroll
      for (int e = 0; e < 8; ++e) { const int t = tid + NT * e; const cf y = buf[PADI(t)];
          HO[(size_t)c * SEQ + t] = v0[e] * (y.x + d1 * z0[e]); HO[(size_t)(512 + c) * SEQ + t] = v1[e] * (y.y + d1 * z1[e]); } }
    __syncthreads();
}


constexpr size_t S5W_WA = 0;
constexpr size_t S5W_KW = S5W_WA + (size_t)32 * 2 * 128 * 256 * 2;
constexpr size_t S5W_L16 = S5W_KW + (size_t)32 * 256 * 512 * 2;
constexpr size_t S5W_SLOT = S5W_L16 + (size_t)32 * 2 * 64 * 2 * 4;
constexpr size_t S5W_XI = 2 * S5W_SLOT;
constexpr size_t S5W_BYTES = S5W_XI + (size_t)32 * NB * 272 * 256 * 2;
__device__ __forceinline__ int s5_row(int b, int n, int s) { return n < 16 ? (NLAT + b * LCX + 16 * n + s) : (b * SEQ + 16 * (n - 16) + s); }

__device__ __forceinline__ void s5_weights_item(const Params& p, int l, int g, float* smem) {
    const int tid = otid();
    cf* pw = (cf*)smem;
    cf* Bb = pw + 2 * 17 * 64;
    cf* Cc = Bb + 2 * 64 * 16;
    float* KT = (float*)(Cc + 2 * 16 * 64);
    float* dsk = KT + 2 * 16 * 256;
    if (tid < 16) dsk[tid] = INP(p, I_S5D)[l * 512 + g * 16 + tid];
    unsigned char* WB = WSP(p) + WS_S5W + (l & 1) * S5W_SLOT;
    for (int i = tid; i < 2 * 17 * 64; i += NT) { const int d = i / (17 * 64), e = (i / 64) % 17, q = i & 63; const size_t pg = ((size_t)(l * 2 + d) * 32 + g);
        const float lr = INP(p, I_LRE)[pg * 64 + q], li = INP(p, I_LIM)[pg * 64 + q], step = expf(INP(p, I_LSTEP)[pg]);
        const float em = expf((float)e * lr * step); float sn, cs; sincosf((float)e * li * step, &sn, &cs); pw[i] = cf{em * cs, em * sn}; }
    for (int i = tid; i < 2 * 64 * 16; i += NT) { const int d = i >> 10, q = (i >> 4) & 63, hh = i & 15; const size_t pg = ((size_t)(l * 2 + d) * 32 + g);
        const float lr = INP(p, I_LRE)[pg * 64 + q], li = INP(p, I_LIM)[pg * 64 + q], step = expf(INP(p, I_LSTEP)[pg]);
        const float em1 = expm1f(lr * step); float sn, cs; sincosf(li * step, &sn, &cs); const float shf = sinf(0.5f * li * step);
        const float nr = em1 * cs - 2.f * shf * shf, ni = (em1 + 1.f) * sn, den = lr * lr + li * li;
        const float cr = (nr * lr + ni * li) / den, ci = (ni * lr - nr * li) / den;
        const float br = INP(p, I_BRE)[(pg * 64 + q) * 16 + hh], bi = INP(p, I_BIM)[(pg * 64 + q) * 16 + hh];
        Bb[i] = cf{cr * br - ci * bi, cr * bi + ci * br}; }
    for (int i = tid; i < 2 * 16 * 64; i += NT) { const int d = i >> 10; const size_t pg = ((size_t)(l * 2 + d) * 32 + g); Cc[i] = cf{INP(p, I_CRE)[pg * 1024 + (i & 1023)], INP(p, I_CIM)[pg * 1024 + (i & 1023)]}; }
    __syncthreads();
    if (tid < 128) { const int d = tid >> 6, q = tid & 63; const cf v = pw[(d * 17 + 16) * 64 + q]; float* L16 = (float*)(WB + S5W_L16) + ((size_t)g * 2 + d) * 128 + 2 * q; L16[0] = v.x; L16[1] = v.y; }
#pragma unroll 1
    for (int i = tid; i < 2 * 16 * 256; i += NT) { const int d = i >> 12, tau = (i >> 8) & 15, hp = (i >> 4) & 15, hh = i & 15; float s = 0.f;
#pragma unroll 4
        for (int q = 0; q < 64; ++q) { const cf m = cmul(cmul(Cc[(d * 16 + hp) * 64 + q], pw[(d * 17 + tau) * 64 + q]), Bb[(d * 64 + q) * 16 + hh]); s += m.x; }
        KT[i] = s; }
    __syncthreads();
    bf16_t* WA = (bf16_t*)(WB + S5W_WA) + (size_t)g * 2 * 128 * 256; bf16_t* KW = (bf16_t*)(WB + S5W_KW) + (size_t)g * 256 * 512;
#pragma unroll 1
    for (int i = tid; i < 2 * 128 * 256 / 2; i += NT) { const int i2 = 2 * i; const int d = i2 >> 15, rq = (i2 >> 8) & 127, col = i2 & 255; const int ri = rq >> 6, q = rq & 63, s = col >> 4, hh = col & 15;
        const int e = d ? s : 15 - s; const cf w = pw[(d * 17 + e) * 64 + q]; const cf m0 = cmul(w, Bb[(d * 64 + q) * 16 + hh]), m1 = cmul(w, Bb[(d * 64 + q) * 16 + hh + 1]);
        *(unsigned*)(WA + i2) = pkh2(ri ? m0.y : m0.x, ri ? m1.y : m1.x); }
#pragma unroll 1
    for (int i = tid; i < 256 * 512 / 2; i += NT) { const int i2 = 2 * i; const int row = i2 >> 9, col = i2 & 511; const int t = row >> 4, hp = row & 15; float v[2];
#pragma unroll
        for (int u = 0; u < 2; ++u) { const int c = col + u;
            if (c < 256) { const int s = c >> 4, hh = c & 15; float a = 0.f; if (s <= t) a += KT[(0 * 16 + (t - s)) * 256 + hp * 16 + hh]; if (s >= t) a += KT[(1 * 16 + (s - t)) * 256 + hp * 16 + hh];
                if (s == t && hh == hp) a += dsk[hp]; v[u] = a; }
            else { const int c2 = c - 256, d = c2 >> 7, ri = (c2 >> 6) & 1, q = c2 & 63; const int e = d ? 16 - t : t + 1; const cf m = cmul(Cc[(d * 16 + hp) * 64 + q], pw[(d * 17 + e) * 64 + q]); v[u] = ri ? -m.y : m.x; } }
        *(unsigned*)(KW + i2) = pkh2(v[0], v[1]); }
    __syncthreads();
}

constexpr int S5P = 520;
__device__ __forceinline__ uint4 s5_fetch_u(const bf16_t* P16, int b, int g, int mt, int tid) {
    const int row = tid >> 5, part = tid & 31, s = part >> 1, h8 = (part & 1) * 8; return *(const uint4*)(P16 + (size_t)s5_row(b, 16 * mt + row, s) * PP + PU + 16 * g + h8);
}
__device__ __forceinline__ void s5_store_u(bf16_t* At, int tid, const uint4 v) {
    const int row = tid >> 5, part = tid & 31, s = part >> 1, h8 = (part & 1) * 8; *(uint4*)(At + row * S5P + 16 * s + h8) = v;
}
__device__ __forceinline__ void s5_item(const Params& p, int l, int it, float* smem) {
    const int tid = otid(), lane = tid & 63, w = tid >> 6; const int g = it >> 1, b = it & 1;
    const bf16_t* P16 = (const bf16_t*)(WSP(p) + WS_P); unsigned char* WB = WSP(p) + WS_S5W + (l & 1) * S5W_SLOT; bf16_t* YG = (bf16_t*)(WSP(p) + WS_YG);
    bf16_t* At = (bf16_t*)smem;
    float* Et = smem + (16 * S5P) / 2;
    bf16_t* XI = (bf16_t*)(WSP(p) + WS_S5W + S5W_XI) + ((size_t)g * NB + b) * 272 * 256;
#pragma unroll 1
    for (int d = 0; d < 2; ++d) {
        const bf16_t* WA = (const bf16_t*)(WB + S5W_WA) + ((size_t)g * 2 + d) * 128 * 256;
        bf16x8_t bfr[8];
#pragma unroll
        for (int ks = 0; ks < 8; ++ks) bfr[ks] = *(const bf16x8_t*)(WA + (size_t)(16 * w + (lane & 15)) * 256 + 32 * ks + (lane >> 4) * 8);
        float xr = 0.f, xi = 0.f, l16r = 0.f, l16i = 0.f;
        if (tid < 64) { const float* L16 = (const float*)(WB + S5W_L16) + ((size_t)g * 2 + d) * 128 + 2 * tid; l16r = L16[0]; l16i = L16[1]; }
        uint4 uv = s5_fetch_u(P16, b, g, 0, tid);
#pragma unroll 1
        for (int k = 0; k < 17; ++k) {
            const int mt = d ? (k == 0 ? 0 : 17 - k) : k;
            s5_store_u(At, tid, uv);
            __syncthreads();
            if (k + 1 < 17) uv = s5_fetch_u(P16, b, g, d ? 16 - k : k + 1, tid);
            f32x4 acc = {0.f, 0.f, 0.f, 0.f};
#pragma unroll
            for (int ks = 0; ks < 8; ++ks) acc = __builtin_amdgcn_mfma_f32_16x16x32_f16(__builtin_bit_cast(pg8::f16x8, ldfrag(At, S5P, 0, 32 * ks, lane)), __builtin_bit_cast(pg8::f16x8, bfr[ks]), acc, 0, 0, 0);
#pragma unroll
            for (int r = 0; r < 4; ++r) Et[((lane >> 4) * 4 + r) * 132 + 16 * w + (lane & 15)] = acc[r];
            __syncthreads();
            if (tid < 64) { float er[16], ei[16];
#pragma unroll
                for (int i = 0; i < 16; ++i) { const int m = d ? 15 - i : i; er[i] = Et[m * 132 + tid]; ei[i] = Et[m * 132 + 64 + tid]; }
#pragma unroll
                for (int i = 0; i < 16; ++i) { const int m = d ? 15 - i : i; bf16_t* xo = XI + (size_t)(16 * mt + m) * 256 + d * 128 + tid;
                    xo[0] = (bf16_t)(pkh2(xr, 0.f) & 0xffff); xo[64] = (bf16_t)(pkh2(xi, 0.f) & 0xffff);
                    const float nr = l16r * xr - l16i * xi + er[i], ni = l16r * xi + l16i * xr + ei[i]; xr = nr; xi = ni; }
            }
            __syncthreads();
        }
    }
    {
        const bf16_t* KW = (const bf16_t*)(WB + S5W_KW) + (size_t)g * 256 * 512;
        bf16x8_t bw[2][16];
#pragma unroll
        for (int u = 0; u < 2; ++u)
#pragma unroll
            for (int ks = 0; ks < 16; ++ks) bw[u][ks] = *(const bf16x8_t*)(KW + (size_t)(32 * w + 16 * u + (lane & 15)) * 512 + 32 * ks + (lane >> 4) * 8);
        uint4 uv = s5_fetch_u(P16, b, g, 0, tid); uint4 xv; xv = *(const uint4*)(XI + (size_t)(tid >> 5) * 256 + (tid & 31) * 8);
#pragma unroll 1
        for (int mt = 0; mt < 17; ++mt) {
            s5_store_u(At, tid, uv);
            *(uint4*)(At + (tid >> 5) * S5P + 256 + (tid & 31) * 8) = xv;
            __syncthreads();
            if (mt + 1 < 17) { uv = s5_fetch_u(P16, b, g, mt + 1, tid); xv = *(const uint4*)(XI + (size_t)(16 * (mt + 1) + (tid >> 5)) * 256 + (tid & 31) * 8); }
            f32x4 a0 = {0.f, 0.f, 0.f, 0.f}, a1 = a0;
#pragma unroll
            for (int ks = 0; ks < 16; ++ks) { const bf16x8_t af = ldfrag(At, S5P, 0, 32 * ks, lane);
                a0 = __builtin_amdgcn_mfma_f32_16x16x32_f16(__builtin_bit_cast(pg8::f16x8, af), __builtin_bit_cast(pg8::f16x8, bw[0][ks]), a0, 0, 0, 0); a1 = __builtin_amdgcn_mfma_f32_16x16x32_f16(__builtin_bit_cast(pg8::f16x8, af), __builtin_bit_cast(pg8::f16x8, bw[1][ks]), a1, 0, 0, 0); }
#pragma unroll
            for (int r = 0; r < 4; ++r) { const int n = 16 * mt + (lane >> 4) * 4 + r;
                YG[(size_t)s5_row(b, n, 2 * w) * 512 + 16 * g + (lane & 15)] = (bf16_t)(pkh2(gelu_tanh(a0[r]), 0.f) & 0xffff);
                YG[(size_t)s5_row(b, n, 2 * w + 1) * 512 + 16 * g + (lane & 15)] = (bf16_t)(pkh2(gelu_tanh(a1[r]), 0.f) & 0xffff); }
            __syncthreads();
        }
    }
}


__device__ __forceinline__ void phase_inproj(const Params& p, int l, int bid, int nb, LAS unsigned char* lds) {
    pg8::Gemm g{(const bf16_t*)(WSP(p) + WS_H), (const bf16_t*)(WSP(p) + WS_WIN) + (size_t)l * NINP * DM, MROWS, NINP, DM};
    pg8::StaticOrder S; S.init(MROWS, NINP, nb, bid);
    float* HT = (float*)(WSP(p) + WS_HT);
    pg8::EpiIn E{(bf16_t*)(WSP(p) + WS_P), PP, HT, HT + (size_t)NB * 2048 * SEQ};
    pg8::gemm_phase<pg8::EpiIn, pg8::StaticOrder, true, true>(lds, g, S, E);
}
__device__ __forceinline__ void phase_glu(const Params& p, int l, int bid, int nb, LAS unsigned char* lds) {
    pg8::Gemm g{(const bf16_t*)(WSP(p) + WS_YG), (const bf16_t*)(WSP(p) + WS_WGLU) + (size_t)l * 512 * 512, MROWS, 512, 512};
    pg8::StaticOrder S; S.init(MROWS, 512, nb, bid);
    pg8::EpiGlu E{(const bf16_t*)(WSP(p) + WS_YG), (const bf16_t*)(WSP(p) + WS_P) + PSG, PP, INP(p, I_BGLU) + l * 512, (bf16_t*)(WSP(p) + WS_YCAT) + 1024, DM};
    pg8::gemm_phase<pg8::EpiGlu, pg8::StaticOrder, true, true>(lds, g, S, E);
}
__device__ __forceinline__ void phase_outproj(const Params& p, int l, int bid, int nb, LAS unsigned char* lds) {
    pg8::Gemm g{(const bf16_t*)(WSP(p) + WS_YCAT), (const bf16_t*)(WSP(p) + WS_WOUT) + (size_t)l * DM * DM, MROWS, DM, DM};
    pg8::StaticOrder S; S.init(MROWS, DM, nb, bid);
    pg8::EpiF32 E{(float*)(WSP(p) + WS_P), DM};
    pg8::gemm_phase<pg8::EpiF32, pg8::StaticOrder, true, true>(lds, g, S, E);
}

static_assert(GLA_BYTES <= (size_t)72 * 1000 * 1000 && S5W_BYTES <= (size_t)36 * 1000 * 1000 && WS_END <= (size_t)800 * 1000 * 1000, "workspace map");
constexpr int LDS_BYTES = 147456;
namespace cg = cooperative_groups;
#ifndef REP_PHASE
#define REP_PHASE -1
#endif
#if REP_PHASE < 0
#define REPEAT(k)
#else
#define REPEAT(k) for (int rep_ = 0; rep_ < ((REP_PHASE == (k)) ? 2 : 1); ++rep_)
#endif

#ifndef IN_TAIL_PULLS
#define IN_TAIL_PULLS 0
#endif
#define QCTR(k) ((unsigned*)(WSP(p) + WS_CTL + 13824) + 32 * (k))
#define QSLOT ((volatile LAS unsigned*)((LAS unsigned char*)lds + 131072 + 128))
#define WQUEUE_A2(ln) do { unsigned* qctr_ = QCTR(4 + (ln)); volatile LAS unsigned* qs_ = QSLOT; \
        for (;;) { __syncthreads(); if (threadIdx.x == 0) qs_[0] = atomicAdd(qctr_, 1u); __syncthreads(); const unsigned item_ = qs_[0]; if (item_ >= 64u) break; \
            if (item_ < 32u) s5_weights_item(p, (ln), (int)item_, smem); else ctaps_item(p, (ln), (int)item_ - 32, smem); } } while (0)
#define WQUEUE_A1(ln, MAXPULL) do { unsigned* qctr_ = QCTR(12 + (ln)); volatile LAS unsigned* qs_ = QSLOT; hy_twiddles(smem); \
        for (int np_ = 0; np_ < (MAXPULL); ++np_) { __syncthreads(); if (threadIdx.x == 0) qs_[0] = atomicAdd(qctr_, 1u); __syncthreads(); const unsigned item_ = qs_[0]; if (item_ >= 512u) break; \
            REPEAT(90) hy_spec2_item(p, (ln), (int)item_, smem); } } while (0)
#define WQUEUE_B(ln) do { unsigned* qctr_ = QCTR(8 + (ln)); volatile LAS unsigned* qs_ = QSLOT; \
        for (;;) { __syncthreads(); if (threadIdx.x == 0) qs_[0] = atomicAdd(qctr_, 1u); __syncthreads(); const unsigned item_ = qs_[0]; if (item_ >= (unsigned)(N_MODITEMS + N_TITEMS)) break; \
            REPEAT(91) { if (item_ < (unsigned)N_MODITEMS) mod_item(p, (ln), (int)item_, smem); else weights_item(p, (ln), (int)item_ - N_MODITEMS, smem); } } } while (0)
__global__ void __launch_bounds__(NT, 2) k_mega(Params p) {
    extern __shared__ __attribute__((aligned(16))) unsigned char lds[];
    cg::grid_group grid = cg::this_grid();
    float* smem = (float*)lds;
    volatile LAS unsigned* bst = (volatile LAS unsigned*)((LAS unsigned char*)lds + 131072 + 64);
    if (threadIdx.x == 0) { bst[0] = 0u; bst[1] = 0u; }
    __syncthreads();
    const XcdBarrier xbar = xcd_barrier_post((unsigned*)(WSP(p) + WS_CTL), bst);
    { const int bid = blockIdx.x, nb = gridDim.x;
      REPEAT(0) { for (int it0 = bid; it0 < DEPTH * (N_TITEMS + N_MODITEMS + N_H2ITEMS); it0 += nb) {
            const int ll = it0 / (N_TITEMS + N_MODITEMS + N_H2ITEMS), it = it0 % (N_TITEMS + N_MODITEMS + N_H2ITEMS);
            if (it < N_TITEMS) weights_item(p, ll, it, smem); else if (it < N_TITEMS + N_MODITEMS) mod_item(p, ll, it - N_TITEMS, smem); else h2_item(p, ll * N_H2ITEMS + it - N_TITEMS - N_MODITEMS, smem); } } }
    grid.sync();
#pragma unroll 1
    for (int l0 = 0; l0 < DEPTH; ++l0) {
        int l = l0; asm volatile("" : "+s"(l));
        int bid = blockIdx.x, nb = gridDim.x; asm volatile("" : "+s"(bid), "+s"(nb));
        phase_row(p, l, bid, nb);
        if (l == 0) { WQUEUE_A2(0); WQUEUE_A1(0, 1 << 20); }
        xcd_barrier(xbar);
        REPEAT(2) phase_inproj(p, l, bid, nb, (LAS unsigned char*)lds);
        if (IN_TAIL_PULLS > 0 && l + 1 < DEPTH && bid >= (MROWS / 256) * (NINP / 256) - 3 * nb) WQUEUE_A1(l + 1, IN_TAIL_PULLS);
        xcd_barrier(xbar);
        REPEAT(4) for (int it = bid; it < N_GLAPREP; it += nb) gla_prep_item(p, l, it, smem);
        xcd_barrier(xbar);
        if (bid < 64) { REPEAT(60) gla_seq_item(p, bid, (bf16_t*)lds); }
        else if (bid < 128) { REPEAT(61) s5_item(p, l, bid - 64, smem); }
        {
            unsigned* qctr = QCTR(l); volatile LAS unsigned* qs = QSLOT;
            hy_twiddles(smem);
            const float* HTC = (const float*)(WSP(p) + WS_HT) + (size_t)NB * 2048 * SEQ; float* HOb = (float*)(WSP(p) + WS_TP);
            for (;;) {
                __syncthreads();
                if (threadIdx.x == 0) qs[0] = atomicAdd(qctr, 1u);
                __syncthreads();
                const unsigned item = qs[0];
                if (item >= 1024u) break;
                REPEAT(62) { if (item < 512u) hy_fft_item(p, l, (int)item, smem);
                else hy_naive_item<LCX, 1>(p, l, HOb + TPC_OFF + (l & 1) * TPC_SLOT, HTC, HOb + HO_C, (int)item - 512, smem); }
            }
        }
        xcd_barrier(xbar);
        REPEAT(6) phase_glu(p, l, bid, nb, (LAS unsigned char*)lds);
        REPEAT(7) phase_post(p, l, bid, nb, smem);
        xcd_barrier(xbar);
        REPEAT(8) phase_outproj(p, l, bid, nb, (LAS unsigned char*)lds);
        if (l + 1 < DEPTH) { WQUEUE_A2(l + 1); WQUEUE_A1(l + 1, 1 << 20); }
        xcd_barrier(xbar);
    }
    phase_row(p, DEPTH, blockIdx.x, gridDim.x);
}

extern "C" void kernel_launch(void* const* d_in, const int* in_sizes, int n_in, void* d_out, int out_size, void* d_ws, size_t ws_size, hipStream_t stream) {
    if (n_in != 33 || out_size != NLAT * DM || ws_size < WS_END) { fprintf(stderr, "kernel_launch: unexpected problem (n_in %d out %d ws %zu need %zu)\n", n_in, out_size, ws_size, (size_t)WS_END); return; }
    Params p{};
    for (int i = 0; i < 33; ++i) p.in[i] = (const float*)d_in[i];
    p.out = (float*)d_out; p.ws = (unsigned char*)d_ws;
    static int grid_blocks = 0;
    if (!grid_blocks) {
        int dev = 0, cus = 0, per_cu = 0;
        (void)hipGetDevice(&dev);
        (void)hipDeviceGetAttribute(&cus, hipDeviceAttributeMultiprocessorCount, dev);
        (void)hipFuncSetAttribute((const void*)k_mega, hipFuncAttributeMaxDynamicSharedMemorySize, LDS_BYTES);
        (void)hipOccupancyMaxActiveBlocksPerMultiprocessor(&per_cu, (const void*)k_mega, NT, LDS_BYTES);
        if (per_cu < 1) { fprintf(stderr, "kernel_launch: occupancy query says %d blocks per CU\n", per_cu); per_cu = 1; }
        grid_blocks = cus;
        fprintf(stderr, "kernel_launch: cus %d per_cu %d grid %d\n", cus, per_cu, grid_blocks);
    }
    (void)hipMemsetAsync((unsigned char*)d_ws + WS_CTL, 0, CTL_BYTES, stream);
    void* args[] = {&p};
    hipError_t e = hipLaunchCooperativeKernel((const void*)k_mega, dim3(grid_blocks), dim3(NT), args, LDS_BYTES, stream);
    if (e != hipSuccess) fprintf(stderr, "cooperative launch failed: %s (grid %d)\n", hipGetErrorString(e), grid_blocks);
}
```
